# Optimizing an MI355X kernel written in HIP

```python
import jax, jax.numpy as jnp
from jax import lax
import numpy as np

D_MODEL = 2048
BATCH = 4
SEQ = 2048
DEPTH = 1

NSA_HEAD_DIM = 64
NSA_WIDTH = D_MODEL // 2
N_NSA_HEADS = NSA_WIDTH // NSA_HEAD_DIM
N_KV_HEADS = N_NSA_HEADS // 4
GQA_GROUP = N_NSA_HEADS // N_KV_HEADS
KV_WIDTH = N_KV_HEADS * NSA_HEAD_DIM
N_BRANCHES = 3
GMLP_WIDTH = D_MODEL - NSA_WIDTH
GMLP_GROUP_DIM = 128
N_GMLP_GROUPS = GMLP_WIDTH // GMLP_GROUP_DIM
GMLP_CHUNK = 128
CMP_BLOCK = 32
CMP_STRIDE = 16
CMP_HIDDEN = 256
SLC_BLOCK = 64
SLC_TOPK = 16
WINDOW = 512
Q_BLOCK = 64
FORCE_BONUS = 100.0
ROPE_THETA = 10000.0
N_EXPERTS = 64
N_EXPERT_GROUPS = 8
TOPK_GROUPS = 4
TOPK_EXPERTS = 8
EXPERT_DIM = 512
SHARED_DIM = 512
ROUTED_SCALE = 2.5
MOE_BLOCK = 128
EPS = 1e-6
NEG = -1e30
IN_COLS = NSA_WIDTH + 6 * KV_WIDTH + N_NSA_HEADS * N_BRANCHES + 2 * GMLP_WIDTH

kernel_name = "hymba_nsa_gmlp_moe_adaln_layer"

F32 = jnp.float32


def rms_norm(x, g):
    xf = x.astype(F32)
    y = xf * lax.rsqrt(jnp.mean(xf * xf, axis=-1, keepdims=True) + EPS)
    return (y * g.astype(F32)).astype(x.dtype)


def rope(x, pos):
    half = x.shape[-1] // 2
    freqs = ROPE_THETA ** (-jnp.arange(half, dtype=F32) / half)
    ang = pos[:, None] * freqs[None, :]
    cos, sin = jnp.cos(ang), jnp.sin(ang)
    xf = x.astype(F32)
    x1, x2 = xf[..., :half], xf[..., half:]
    return jnp.concatenate([x1 * cos - x2 * sin, x2 * cos + x1 * sin], axis=-1).astype(x.dtype)


def masked_softmax(s, mask):
    p = jax.nn.softmax(jnp.where(mask, s, NEG), axis=-1)
    return p * mask


def compress(kv, pos_emb, w1, w2):
    T = kv.shape[2]
    n_cmp = (T - CMP_BLOCK) // CMP_STRIDE + 1
    idx = jnp.arange(n_cmp)[:, None] * CMP_STRIDE + jnp.arange(CMP_BLOCK)[None, :]
    blocks = kv[:, :, idx, :] + pos_emb
    flat = blocks.reshape(blocks.shape[0], blocks.shape[1], n_cmp, CMP_BLOCK * NSA_HEAD_DIM)
    return jax.nn.gelu(flat @ w1) @ w2


def nsa(q, k_c, v_c, k_s, v_s, k_w, v_w, gate, g_q, g_k,
        cmp_pos_k, cmp_pos_v, cmp_w1_k, cmp_w2_k, cmp_w1_v, cmp_w2_v):
    B, H, T, hd = q.shape
    scale = hd ** -0.5
    pos = jnp.arange(T, dtype=F32)
    t_idx = jnp.arange(T)
    q = rope(rms_norm(q, g_q), pos)
    k_s = rope(rms_norm(k_s, g_k), pos)
    k_w = rope(rms_norm(k_w, g_k), pos)
    qf = q.reshape(B, N_KV_HEADS, GQA_GROUP, T, hd).astype(F32) * scale

    n_cmp = (T - CMP_BLOCK) // CMP_STRIDE + 1
    cmp_start = jnp.arange(n_cmp) * CMP_STRIDE
    kc = compress(k_c, cmp_pos_k, cmp_w1_k, cmp_w2_k)
    vc = compress(v_c, cmp_pos_v, cmp_w1_v, cmp_w2_v)
    kc = rope(rms_norm(kc, g_k), cmp_start.astype(F32) + (CMP_BLOCK - 1) / 2)
    cmp_mask = (cmp_start + CMP_BLOCK - 1)[None, :] <= t_idx[:, None]
    s_c = jnp.einsum('bhgtd,bhnd->bhgtn', qf, kc.astype(F32))
    p_c = masked_softmax(s_c, cmp_mask)
    o_c = jnp.einsum('bhgtn,bhnd->bhgtd', p_c.astype(vc.dtype), vc)

    n_slc = T // SLC_BLOCK
    slc_start = jnp.arange(n_slc) * SLC_BLOCK
    overlap = ((cmp_start[:, None] <= slc_start[None, :] + SLC_BLOCK - 1)
               & (cmp_start[:, None] + CMP_BLOCK - 1 >= slc_start[None, :])).astype(F32)
    imp = jnp.einsum('bhgtn,nj->bhtj', p_c, overlap)
    cur = t_idx // SLC_BLOCK
    j = jnp.arange(n_slc)
    visible = j[None, :] <= cur[:, None]
    forced = (j[None, :] == 0) | (j[None, :] == cur[:, None]) | (j[None, :] == cur[:, None] - 1)
    score = jnp.where(visible, imp + jnp.where(forced, FORCE_BONUS, 0.0), -1.0)
    k_sel = min(SLC_TOPK, n_slc)
    top_val, top_idx = lax.top_k(score, k_sel)
    top_ok = top_val >= 0.0

    ks_blocks = k_s.reshape(B, N_KV_HEADS, n_slc, SLC_BLOCK, hd)
    vs_blocks = v_s.reshape(B, N_KV_HEADS, n_slc, SLC_BLOCK, hd)
    kw_pad = jnp.pad(k_w, ((0, 0), (0, 0), (WINDOW, 0), (0, 0)))
    vw_pad = jnp.pad(v_w, ((0, 0), (0, 0), (WINDOW, 0), (0, 0)))
    b_ix = jnp.arange(B)[:, None, None, None]
    h_ix = jnp.arange(N_KV_HEADS)[None, :, None, None]
    n_sel_keys = k_sel * SLC_BLOCK

    def query_block(i):
        t0 = i * Q_BLOCK
        tq = t0 + jnp.arange(Q_BLOCK)
        q_b = lax.dynamic_slice_in_dim(qf, t0, Q_BLOCK, axis=3)
        idx = lax.dynamic_slice_in_dim(top_idx, t0, Q_BLOCK, axis=2)
        ok = lax.dynamic_slice_in_dim(top_ok, t0, Q_BLOCK, axis=2)
        k_g = ks_blocks[b_ix, h_ix, idx].reshape(B, N_KV_HEADS, Q_BLOCK, n_sel_keys, hd)
        v_g = vs_blocks[b_ix, h_ix, idx].reshape(B, N_KV_HEADS, Q_BLOCK, n_sel_keys, hd)
        key_pos = idx[..., None] * SLC_BLOCK + jnp.arange(SLC_BLOCK)
        sel_mask = (ok[..., None] & (key_pos <= tq[:, None, None])).reshape(B, N_KV_HEADS, Q_BLOCK, n_sel_keys)
        s_s = jnp.einsum('bhgqd,bhqmd->bhgqm', q_b, k_g.astype(F32))
        p_s = masked_softmax(s_s, sel_mask[:, :, None])
        o_s = jnp.einsum('bhgqm,bhqmd->bhgqd', p_s.astype(v_g.dtype), v_g)
        kw_b = lax.dynamic_slice_in_dim(kw_pad, t0, Q_BLOCK + WINDOW, axis=2)
        vw_b = lax.dynamic_slice_in_dim(vw_pad, t0, Q_BLOCK + WINDOW, axis=2)
        kpos = t0 - WINDOW + jnp.arange(Q_BLOCK + WINDOW)
        win_mask = ((kpos[None, :] >= 0) & (kpos[None, :] <= tq[:, None])
                    & (kpos[None, :] > tq[:, None] - WINDOW))
        s_w = jnp.einsum('bhgqd,bhkd->bhgqk', q_b, kw_b.astype(F32))
        p_w = masked_softmax(s_w, win_mask)
        o_w = jnp.einsum('bhgqk,bhkd->bhgqd', p_w.astype(vw_b.dtype), vw_b)
        return o_s, o_w

    o_s, o_w = lax.map(query_block, jnp.arange(T // Q_BLOCK))

    def unblock(o):
        return jnp.moveaxis(o, 0, 3).reshape(B, N_KV_HEADS, GQA_GROUP, T, hd)

    g = jax.nn.sigmoid(gate.astype(F32)).transpose(0, 2, 1, 3).reshape(B, N_KV_HEADS, GQA_GROUP, T, N_BRANCHES)
    o = g[..., 0:1] * o_c + g[..., 1:2] * unblock(o_s) + g[..., 2:3] * unblock(o_w)
    return o.reshape(B, H, T, hd).transpose(0, 2, 1, 3).reshape(B, T, H * hd).astype(q.dtype)


def chunked_gmlp(u, v, g_v, w_spatial, b_spatial):
    B, T, _ = u.shape
    n_chunk = T // GMLP_CHUNK
    u = jax.nn.gelu(u)
    v = rms_norm(jax.nn.gelu(v).reshape(B, n_chunk, GMLP_CHUNK, N_GMLP_GROUPS, GMLP_GROUP_DIM), g_v)
    causal = jnp.tril(jnp.ones((GMLP_CHUNK, GMLP_CHUNK), dtype=bool))
    w = jnp.where(causal, w_spatial, 0.0)
    mixed = jnp.einsum('gts,bcsgd->bctgd', w, v) + b_spatial.T[None, None, :, :, None]
    return u * mixed.reshape(B, T, GMLP_WIDTH)


def moe(h, w_router, router_bias, w_gate, w_up, w_down, ws_gate, ws_up, ws_down):
    N, D = h.shape
    s = jax.nn.sigmoid(h.astype(F32) @ w_router.astype(F32))
    sb = s + router_bias.astype(F32)
    grp_score = lax.top_k(sb.reshape(N, N_EXPERT_GROUPS, N_EXPERTS // N_EXPERT_GROUPS), 2)[0].sum(-1)
    _, gidx = lax.top_k(grp_score, TOPK_GROUPS)
    gmask = jnp.any(gidx[..., None] == jnp.arange(N_EXPERT_GROUPS), axis=-2)
    emask = jnp.repeat(gmask, N_EXPERTS // N_EXPERT_GROUPS, axis=-1)
    _, eidx = lax.top_k(jnp.where(emask, sb, NEG), TOPK_EXPERTS)
    w = jnp.take_along_axis(s, eidx, axis=-1)
    w = w / jnp.sum(w, axis=-1, keepdims=True) * ROUTED_SCALE

    nk = N * TOPK_EXPERTS
    flat_e = eidx.reshape(-1).astype(jnp.int32)
    order = jnp.argsort(flat_e, stable=True)
    e_sorted = flat_e[order]
    tok_sorted = (order // TOPK_EXPERTS).astype(jnp.int32)
    w_sorted = w.reshape(-1)[order]
    counts = jnp.zeros(N_EXPERTS, jnp.int32).at[flat_e].add(1)
    padded = (counts + MOE_BLOCK - 1) // MOE_BLOCK * MOE_BLOCK
    start = jnp.cumsum(counts) - counts
    pend = jnp.cumsum(padded)
    pstart = pend - padded
    dest = pstart[e_sorted] + jnp.arange(nk, dtype=jnp.int32) - start[e_sorted]
    cap = nk + N_EXPERTS * MOE_BLOCK
    n_blk = cap // MOE_BLOCK
    buf_tok = jnp.zeros(cap, jnp.int32).at[dest].set(tok_sorted)
    buf_w = jnp.zeros(cap, F32).at[dest].set(w_sorted)
    blk_e = jnp.minimum(jnp.searchsorted(pend, jnp.arange(n_blk, dtype=jnp.int32) * MOE_BLOCK, side='right'),
                        N_EXPERTS - 1)

    def expert_block(args):
        tok, e = args
        xb = h[tok]
        hid = jax.nn.silu(xb @ w_gate[e]) * (xb @ w_up[e])
        return hid @ w_down[e]

    out = lax.map(expert_block, (buf_tok.reshape(n_blk, MOE_BLOCK), blk_e))
    routed = jax.ops.segment_sum(out.reshape(cap, D) * buf_w[:, None].astype(out.dtype), buf_tok,
                                 num_segments=N)
    shared = (jax.nn.silu(h @ ws_gate) * (h @ ws_up)) @ ws_down
    return routed + shared


def hybrid_layer(x, c, w_ada, b_ada, g_norm1, w_in, g_q, g_k, cmp_pos_k, cmp_pos_v, cmp_w1_k, cmp_w2_k,
                 cmp_w1_v, cmp_w2_v, g_gmlp_v, w_spatial, b_spatial, g_out_nsa, g_out_gmlp, w_out, g_norm2,
                 w_router, router_bias, w_gate, w_up, w_down, ws_gate, ws_up, ws_down):
    B, T, D = x.shape
    mod = jax.nn.silu(c) @ w_ada + b_ada
    sh1, sc1, gt1, sh2, sc2, gt2 = jnp.split(mod[:, None, :], 6, axis=-1)

    h = rms_norm(x, g_norm1) * (1 + sc1) + sh1
    p = h @ w_in
    widths = [NSA_WIDTH] + [KV_WIDTH] * 6 + [N_NSA_HEADS * N_BRANCHES, GMLP_WIDTH]
    q, kc, vc, ks, vs, kw, vw, gate, u, v = jnp.split(p, [int(o) for o in np.cumsum(widths)], axis=-1)

    def heads(t, n):
        return t.reshape(B, T, n, NSA_HEAD_DIM).transpose(0, 2, 1, 3)

    o_nsa = nsa(heads(q, N_NSA_HEADS), heads(kc, N_KV_HEADS), heads(vc, N_KV_HEADS),
                heads(ks, N_KV_HEADS), heads(vs, N_KV_HEADS), heads(kw, N_KV_HEADS), heads(vw, N_KV_HEADS),
                gate.reshape(B, T, N_NSA_HEADS, N_BRANCHES), g_q, g_k,
                cmp_pos_k, cmp_pos_v, cmp_w1_k, cmp_w2_k, cmp_w1_v, cmp_w2_v)
    o_gmlp = chunked_gmlp(u, v, g_gmlp_v, w_spatial, b_spatial)
    mix = jnp.concatenate([rms_norm(o_nsa, g_out_nsa), rms_norm(o_gmlp, g_out_gmlp)], axis=-1) @ w_out
    x = x + gt1 * mix

    h2 = rms_norm(x, g_norm2) * (1 + sc2) + sh2
    y = moe(h2.reshape(B * T, D), w_router, router_bias, w_gate, w_up, w_down, ws_gate, ws_up, ws_down)
    return x + gt2 * y.reshape(B, T, D)


def setup_inputs(seed: int = 0) -> dict:
    key = jax.random.key(seed)
    keys = iter(jax.random.split(key, 32))
    L = DEPTH
    hd = NSA_HEAD_DIM

    def normal(shape, scale):
        return scale * jax.random.normal(next(keys), shape, F32)

    def gain(shape, noise=0.02):
        return 1.0 + noise * jax.random.normal(next(keys), shape, F32)

    return {
        "x": normal((BATCH, SEQ, D_MODEL), 1.0),
        "c": normal((BATCH, D_MODEL), 1.0),
        "w_ada": normal((L, D_MODEL, 6 * D_MODEL), 0.5 * D_MODEL ** -0.5),
        "b_ada": normal((L, 6 * D_MODEL), 0.02),
        "g_norm1": gain((L, D_MODEL)),
        "w_in": normal((L, D_MODEL, IN_COLS), D_MODEL ** -0.5),
        "g_q": gain((L, hd)),
        "g_k": gain((L, hd)),
        "cmp_pos_k": normal((L, CMP_BLOCK, hd), 0.1),
        "cmp_pos_v": normal((L, CMP_BLOCK, hd), 0.1),
        "cmp_w1_k": normal((L, CMP_BLOCK * hd, CMP_HIDDEN), (CMP_BLOCK * hd) ** -0.5),
        "cmp_w2_k": normal((L, CMP_HIDDEN, hd), CMP_HIDDEN ** -0.5),
        "cmp_w1_v": normal((L, CMP_BLOCK * hd, CMP_HIDDEN), (CMP_BLOCK * hd) ** -0.5),
        "cmp_w2_v": normal((L, CMP_HIDDEN, hd), CMP_HIDDEN ** -0.5),
        "g_gmlp_v": gain((L, N_GMLP_GROUPS, GMLP_GROUP_DIM)),
        "w_spatial": normal((L, N_GMLP_GROUPS, GMLP_CHUNK, GMLP_CHUNK), 0.5 * GMLP_CHUNK ** -0.5),
        "b_spatial": gain((L, N_GMLP_GROUPS, GMLP_CHUNK), 0.1),
        "g_out_nsa": gain((L, NSA_WIDTH)),
        "g_out_gmlp": gain((L, GMLP_WIDTH)),
        "w_out": normal((L, D_MODEL, D_MODEL), D_MODEL ** -0.5),
        "g_norm2": gain((L, D_MODEL)),
        "w_router": normal((L, D_MODEL, N_EXPERTS), D_MODEL ** -0.5),
        "router_bias": normal((L, N_EXPERTS), 0.01),
        "w_gate": normal((L, N_EXPERTS, D_MODEL, EXPERT_DIM), D_MODEL ** -0.5),
        "w_up": normal((L, N_EXPERTS, D_MODEL, EXPERT_DIM), D_MODEL ** -0.5),
        "w_down": normal((L, N_EXPERTS, EXPERT_DIM, D_MODEL), EXPERT_DIM ** -0.5),
        "ws_gate": normal((L, D_MODEL, SHARED_DIM), D_MODEL ** -0.5),
        "ws_up": normal((L, D_MODEL, SHARED_DIM), D_MODEL ** -0.5),
        "ws_down": normal((L, SHARED_DIM, D_MODEL), SHARED_DIM ** -0.5),
    }


def reference(x, c, w_ada, b_ada, g_norm1, w_in, g_q, g_k, cmp_pos_k, cmp_pos_v, cmp_w1_k, cmp_w2_k,
              cmp_w1_v, cmp_w2_v, g_gmlp_v, w_spatial, b_spatial, g_out_nsa, g_out_gmlp, w_out, g_norm2,
              w_router, router_bias, w_gate, w_up, w_down, ws_gate, ws_up, ws_down):
    for l in range(DEPTH):
        x = hybrid_layer(x, c, w_ada[l], b_ada[l], g_norm1[l], w_in[l], g_q[l], g_k[l], cmp_pos_k[l],
                         cmp_pos_v[l], cmp_w1_k[l], cmp_w2_k[l], cmp_w1_v[l], cmp_w2_v[l], g_gmlp_v[l],
                         w_spatial[l], b_spatial[l], g_out_nsa[l], g_out_gmlp[l], w_out[l], g_norm2[l],
                         w_router[l], router_bias[l], w_gate[l], w_up[l], w_down[l], ws_gate[l], ws_up[l],
                         ws_down[l])
    return x
```

```cpp
#include <hip/hip_runtime.h>
#include <hip/hip_cooperative_groups.h>
#include <cstdio>
#include <cstdint>
namespace cg = cooperative_groups;

#ifndef MK_N_LAUNCHES
#define MK_N_LAUNCHES 1
#endif

#ifndef PROBE_MASK
#define PROBE_MASK 0
#endif
#define DUP(k) ((((PROBE_MASK) >> (k)) & 1) != 0)
#define LAS __attribute__((address_space(3)))
#define GAS __attribute__((address_space(1)))
typedef unsigned short bf16_t;
typedef short bf16x8 __attribute__((ext_vector_type(8)));
typedef short s16x4 __attribute__((ext_vector_type(4)));
typedef float f32x4 __attribute__((ext_vector_type(4)));
typedef float f32x2 __attribute__((ext_vector_type(2)));
typedef float f32x16 __attribute__((ext_vector_type(16)));
typedef unsigned u32x4 __attribute__((ext_vector_type(4)));
typedef unsigned u32x2 __attribute__((ext_vector_type(2)));
typedef short v4i16_t __attribute__((ext_vector_type(4)));
typedef int v4i32 __attribute__((ext_vector_type(4)));
typedef int v8i32 __attribute__((ext_vector_type(8)));

constexpr int NB = 4, T = 2048, D = 2048, NTOK = NB * T;
constexpr int NH = 16, KVH = 4, HD = 64;
constexpr int NCMP = 127;
constexpr int NEXP = 64, TOPK = 8, EDIM = 512;
constexpr int IN_COLS = 4656, NIN_T = 19 * 256;
constexpr float EPS = 1e-6f;
constexpr float QSCALE = 0.125f * 1.4426950408889634f;
constexpr float NEGF = -1e30f;
constexpr float W8SCALE = 32.0f, H8SCALE = 4.0f, PO8SCALE = 16.0f;

constexpr size_t MiB = 1u << 20, KiB = 1024;
constexpr size_t WS_CTL = 0, CTL_BYTES = 1 * MiB;
constexpr size_t WS_MOD = 1 * MiB;
constexpr size_t WS_ROPE = 1 * MiB + 256 * KiB;
constexpr size_t WS_BIAS1 = 1 * MiB + 768 * KiB;
constexpr size_t WS_KCMP = 2 * MiB;
constexpr size_t WS_VCMP = 2 * MiB + 256 * KiB;
constexpr size_t WS_OSSN = 2 * MiB + 512 * KiB;
constexpr size_t WS_OSSG = 2 * MiB + 768 * KiB;
constexpr size_t WS_VSS = 3 * MiB + 512 * KiB;
constexpr size_t WS_EIDX = 5 * MiB;
constexpr size_t WS_POS = 5 * MiB + 256 * KiB;
constexpr size_t WS_WTS = 5 * MiB + 512 * KiB;
constexpr size_t WS_LIST = 6 * MiB;
constexpr size_t WS_GATE = 8 * MiB;
constexpr size_t WS_HIDC = 10 * MiB;
constexpr size_t WS_KV = 12 * MiB;
constexpr size_t KV_STRIDE = 4 * MiB;
constexpr size_t WS_Q = 36 * MiB;
constexpr size_t WS_U = 52 * MiB;
constexpr size_t WS_V = 68 * MiB;
constexpr size_t WS_H = 84 * MiB;
constexpr size_t WS_OCAT = 116 * MiB;
constexpr size_t WS_WIN_T = 148 * MiB;
constexpr size_t WS_WOUT_T = 168 * MiB;
constexpr size_t WS_WCMP_T = 176 * MiB;
constexpr size_t WS_WGU_T = 178 * MiB;
constexpr size_t WS_WD_T = 438 * MiB;
constexpr size_t WS_HID = 568 * MiB;
constexpr size_t WS_PO = 656 * MiB;
constexpr size_t WS_END = 1008 * MiB;
constexpr int CW_CNT = 256;
constexpr int CW_BAR = 4096;

constexpr int RING_BYTES = 131072;
constexpr int LDSX_OFF = RING_BYTES;
constexpr int MISC_OFF = RING_BYTES + 12288;
constexpr int LDS_BYTES = 147456;

__device__ __forceinline__ unsigned cvt_pk_bf16(float lo, float hi) { unsigned r; asm volatile("v_cvt_pk_bf16_f32 %0, %1, %2" : "=v"(r) : "v"(lo), "v"(hi)); return r; }
__device__ __forceinline__ unsigned pk4_fp8(float a, float b, float c, float d) { int w = 0; w = __builtin_amdgcn_cvt_pk_fp8_f32(a, b, w, false); w = __builtin_amdgcn_cvt_pk_fp8_f32(c, d, w, true); return (unsigned)w; }
__device__ __forceinline__ float bf2f(unsigned short h) { return __uint_as_float(((unsigned)h) << 16); }
__device__ __forceinline__ float bflo(unsigned w) { return __uint_as_float(w << 16); }
__device__ __forceinline__ float bfhi(unsigned w) { return __uint_as_float(w & 0xffff0000u); }
__device__ __forceinline__ float fexp2(float x) { return __builtin_amdgcn_exp2f(x); }
__device__ __forceinline__ float frcp(float x) { return __builtin_amdgcn_rcpf(x); }
__device__ __forceinline__ float sigmoidf_(float x) { return frcp(1.0f + fexp2(-1.4426950408889634f * x)); }
__device__ __forceinline__ float siluf_(float x) { return x * sigmoidf_(x); }
__device__ __forceinline__ float gelu_tanh(float x) {
    const float u = x * (1.0f + 0.044715f * x * x);
    return x * frcp(1.0f + fexp2(u * (-2.0f * 0.7978845608028654f * 1.4426950408889634f)));
}
__device__ __forceinline__ float wave_sum(float v) {
#pragma unroll
    for (int o = 1; o < 64; o <<= 1) v += __shfl_xor(v, o);
    return v;
}
__device__ __forceinline__ void rope_cs(float pos, int i, float& c, float& s) {
    const float fr = exp2f(-(float)i * (13.287712379549449f / 32.0f));
    const float ang = pos * fr;
    const double rev = (double)ang * 0.15915494309189535;
    const double fr_ = rev - rint(rev);
    const float r = (float)(fr_ * 6.283185307179586);
    c = cosf(r); s = sinf(r);
}

#define XB_TMO      128
#define XB_XCNT(j)  (256  + 64 * (j))
#define XB_XSUB(j)  (1280 + 64 * (j))
#define XB_XGEN(j)  (2304 + 64 * (j))
#define XB_TOP      3328
#define XB_TOPGEN   3392
#define XCD_BAR_WORDS 3456
#define XB_SPIN_CAP (1u << 22)
__device__ __forceinline__ unsigned xb_ld(unsigned* p)              { return __hip_atomic_load(p, __ATOMIC_RELAXED, __HIP_MEMORY_SCOPE_AGENT); }
__device__ __forceinline__ unsigned xb_add(unsigned* p, unsigned v) { return __hip_atomic_fetch_add(p, v, __ATOMIC_RELAXED, __HIP_MEMORY_SCOPE_AGENT); }
__device__ __forceinline__ unsigned xb_xcc_id() { return (unsigned)__builtin_amdgcn_s_getreg((3 << 11) | 20) & 0xFu; }
#define XB_SPIN(cond, bar) do { unsigned _sp = 0; while (cond) { __builtin_amdgcn_s_sleep(1); \
    if ((++_sp & 255u) == 0u) { if (xb_ld(&(bar)[XB_TMO])) break; if (_sp > XB_SPIN_CAP) { atomicAdd(&(bar)[XB_TMO], 1u); break; } } } } while (0)
struct XcdBarrier { unsigned* bar; unsigned x; volatile LAS unsigned* st; };
__device__ __forceinline__ XcdBarrier xcd_barrier_post(unsigned* bar, volatile LAS unsigned* st) {
    XcdBarrier b; b.bar = bar; b.x = xb_xcc_id(); b.st = st;
    if (threadIdx.x == 0) (void)xb_add(&bar[XB_XCNT(b.x)], 1u);
    return b;
}
__device__ __forceinline__ void xcd_barrier_complete(unsigned* bar, unsigned x, unsigned& nloc, unsigned& nx) {
    const unsigned G = gridDim.x * gridDim.y * gridDim.z;
    unsigned sum, cnt, mine, sp = 0u;
    for (;;) {
        sum = 0u; cnt = 0u; mine = 0u;
#pragma unroll
        for (unsigned j = 0; j < 16; ++j) { const unsigned c = xb_ld(&bar[XB_XCNT(j)]); sum += c; cnt += (c > 0u) ? 1u : 0u; mine = (j == x) ? c : mine; }
        if (sum == G) break;
        __builtin_amdgcn_s_sleep(1);
        if ((++sp & 255u) == 0u) { if (xb_ld(&bar[XB_TMO])) break; if (sp > XB_SPIN_CAP) { atomicAdd(&bar[XB_TMO], 1u); break; } }
    }
    nloc = mine > 0u ? mine : 1u; nx = cnt > 0u ? cnt : 1u;
}
__device__ __forceinline__ void xcd_barrier(const XcdBarrier& b) {
    asm volatile("s_waitcnt vmcnt(0)" ::: "memory");
    __syncthreads();
    if (threadIdx.x == 0) {
        unsigned* bar = b.bar;
        __builtin_amdgcn_s_waitcnt(0);
        unsigned nloc = b.st[0], nx = b.st[1];
        if (nloc == 0u) { xcd_barrier_complete(bar, b.x, nloc, nx); b.st[0] = nloc; b.st[1] = nx; }
        const unsigned old = xb_add(&bar[XB_XSUB(b.x)], 1u);
        const unsigned gen = old / nloc;
        if (old + 1u == (gen + 1u) * nloc) {
            __builtin_amdgcn_fence(__ATOMIC_RELEASE, "agent");
            asm volatile("s_waitcnt vmcnt(0)" ::: "memory");
            const unsigned og = xb_add(&bar[XB_TOP], 1u);
            const unsigned tg = og / nx;
            if (og + 1u == (tg + 1u) * nx) xb_add(&bar[XB_TOPGEN], 1u);
            else XB_SPIN(xb_ld(&bar[XB_TOPGEN]) == tg, bar);
            __builtin_amdgcn_fence(__ATOMIC_ACQUIRE, "agent");
            xb_add(&bar[XB_XGEN(b.x)], 1u);
            asm volatile("s_waitcnt vmcnt(0)" ::: "memory");
        } else {
            XB_SPIN(xb_ld(&bar[XB_XGEN(b.x)]) == gen, bar);
            __builtin_amdgcn_fence(__ATOMIC_ACQUIRE, "agent");
            asm volatile("s_waitcnt vmcnt(0)" ::: "memory");
        }
    }
    __syncthreads();
}

struct Params { const float* in[29]; float* out; unsigned char* ws; int ph_lo, ph_hi; };
enum { I_X = 0, I_C, I_WADA, I_BADA, I_GN1, I_WIN, I_GQ, I_GK, I_CPK, I_CPV, I_CW1K, I_CW2K, I_CW1V, I_CW2V, I_GGV, I_WSP, I_BSP, I_GON, I_GOG, I_WOUT, I_GN2,
       I_WR, I_RB, I_WG, I_WU, I_WD, I_SG, I_SU, I_SD };

namespace pg8 {
constexpr int BM = 256, BK = 64, HALF = 128, HTB = HALF * BK * 2, NXCD = 8, WGM = 8;
__device__ __forceinline__ int lds_byte(int r, int c) { const int st = (r >> 4) * 2 + (c >> 5), rr = r & 15, cc = c & 31, ob = rr * 64 + cc * 2; return st * 1024 + (ob ^ (((ob >> 9) & 1) << 5)); }
__device__ __forceinline__ void stage_rc(int b, int& R, int& C) { const int st = b / 1024, sb = b % 1024, swz = sb ^ (((sb >> 9) & 1) << 5); R = (st >> 1) * 16 + swz / 64; C = (st & 1) * 32 + (swz % 64) / 2; }
__device__ __forceinline__ int perm32(int rho) { const int n = rho >> 4, i = rho & 15; return 8 * (i >> 2) + 4 * n + (i & 3); }
struct Unit { int pm, pn, e, aux; };

__device__ __forceinline__ bool dense_next(int i, int G, int c, int nM, int nN, Unit& u) {
    const int nwg = nM * nN; const long L = (long)i * G + c; if (L >= nwg) return false;
    int wgid = (int)L; { const int q = nwg / NXCD, r = nwg % NXCD, xcd = wgid % NXCD, off = wgid / NXCD; wgid = (xcd < r ? xcd * (q + 1) : r * (q + 1) + (xcd - r) * q) + off; }
    const int nig = WGM * nN, gid = wgid / nig, fm = gid * WGM, gsz = (nM - fm) < WGM ? (nM - fm) : WGM;
    u.pm = fm + ((wgid % nig) % gsz); u.pn = (wgid % nig) / gsz; u.e = 0; u.aux = 0; return true;
}

template <class P>
__device__ __forceinline__ void gemm_phase(LAS unsigned char* lds, const P& prm) {
    const int tid = threadIdx.x, wid = __builtin_amdgcn_readfirstlane(tid >> 6), lane = tid & 63, wr = wid >> 2, wc = wid & 3, fr = lane & 15, fq = lane >> 4;
    constexpr int K = P::K, ESZ = P::ESZ, nt = (K * ESZ) / 128;
    const unsigned lda2 = (unsigned)prm.lda * (unsigned)ESZ;
    int Rl[2], Cl[2]; unsigned voffB[2];
#pragma unroll
    for (int i = 0; i < 2; ++i) { int R, C; stage_rc(tid * 16 + i * 8192, R, C); Rl[i] = R; Cl[i] = C; const int Rb = (R & ~31) + perm32(R & 31); voffB[i] = (unsigned)(Rb * P::LDB * ESZ + C * 2); }
    const size_t kstep = (size_t)(BK * 2);
    const size_t hstepB = (size_t)HALF * P::LDB * ESZ;
    const unsigned ldsw = (unsigned)wid * 1024u;
    const int fcol = fq * 8;
    const int aoff = lds_byte(wr * 64 + fr, fcol), boff = lds_byte(wc * 32 + fr, fcol);
    constexpr int fkst = 1024;
#define PG8_SA(b, h) (((b) * 2 + (h)) * HTB)
#define PG8_SB(b, h) ((4 + (b) * 2 + (h)) * HTB)
#define PG8_STAGE(bufoff, gbase, voff) do { _Pragma("unroll") for (int _i = 0; _i < 2; ++_i) \
        __builtin_amdgcn_global_load_lds((const unsigned*)((const char*)(gbase) + (voff)[_i]), (LAS unsigned*)(lds + (bufoff) + ldsw + _i * 8192), 16, 0, 0); } while (0)
#define PG8_LDA(dst, b, h) do { _Pragma("unroll") for (int m = 0; m < 4; ++m) _Pragma("unroll") for (int k = 0; k < 2; ++k) dst[m][k] = *(const LAS bf16x8*)(lds + PG8_SA(b, h) + aoff + m * 2048 + k * fkst); } while (0)
#define PG8_LDB(dst, b, h) do { _Pragma("unroll") for (int n = 0; n < 2; ++n) _Pragma("unroll") for (int k = 0; k < 2; ++k) dst[n][k] = *(const LAS bf16x8*)(lds + PG8_SB(b, h) + boff + n * 2048 + k * fkst); } while (0)
#define PG8_MMA(ai, bj, At, Bt) do { __builtin_amdgcn_s_setprio(1); \
        if constexpr (ESZ == 2) { _Pragma("unroll") for (int m = 0; m < 4; ++m) _Pragma("unroll") for (int n = 0; n < 2; ++n) _Pragma("unroll") for (int k = 0; k < 2; ++k) \
            acc[ai][bj][m][n] = __builtin_amdgcn_mfma_f32_16x16x32_bf16(Bt[n][k], At[m][k], acc[ai][bj][m][n], 0, 0, 0); } \
        else { _Pragma("unroll") for (int m = 0; m < 4; ++m) _Pragma("unroll") for (int n = 0; n < 2; ++n) { \
            const v8i32 a8_ = __builtin_shufflevector(__builtin_bit_cast(v4i32, At[m][0]), __builtin_bit_cast(v4i32, At[m][1]), 0, 1, 2, 3, 4, 5, 6, 7); \
            const v8i32 b8_ = __builtin_shufflevector(__builtin_bit_cast(v4i32, Bt[n][0]), __builtin_bit_cast(v4i32, Bt[n][1]), 0, 1, 2, 3, 4, 5, 6, 7); \
            acc[ai][bj][m][n] = __builtin_amdgcn_mfma_scale_f32_16x16x128_f8f6f4(b8_, a8_, acc[ai][bj][m][n], 0, 0, 0, 0x7f7f7f7f, 0, 0x7f7f7f7f); } } \
        __builtin_amdgcn_s_setprio(0); } while (0)
#define PG8_WAIT_V(n) asm volatile("s_waitcnt vmcnt(" #n ")" ::: "memory")
#define PG8_WAIT_L(n) asm volatile("s_waitcnt lgkmcnt(" #n ")" ::: "memory")
#define PG8_WAIT_VK() do { if constexpr (P::HALFONLY) asm volatile("s_waitcnt vmcnt(6)" ::: "memory"); else asm volatile("s_waitcnt vmcnt(8)" ::: "memory"); } while (0)
#define PG8_BAR __builtin_amdgcn_s_barrier()
#define PG8_SCHED __builtin_amdgcn_sched_barrier(0)
    Unit cur, nxt; int ui = 0;
    if (!prm.next(0, cur)) return;
    f32x4 acc[2][2][4][2];
#pragma unroll
    for (int a = 0; a < 2; ++a)
#pragma unroll
        for (int b = 0; b < 2; ++b)
#pragma unroll
            for (int m = 0; m < 4; ++m)
#pragma unroll
                for (int n = 0; n < 2; ++n) acc[a][b][m][n] = (f32x4){0.f, 0.f, 0.f, 0.f};
    bf16x8 At[4][2], B0[2][2], B1[2][2];
    const char* Ab = (const char*)prm.A;
    unsigned offA0[2], offA1[2];
#pragma unroll
    for (int i = 0; i < 2; ++i) { offA0[i] = prm.row_id(cur, Rl[i]) * lda2 + (unsigned)Cl[i] * 2u + prm.a_koff(cur); offA1[i] = prm.row_id(cur, Rl[i] + HALF) * lda2 + (unsigned)Cl[i] * 2u + prm.a_koff(cur); }
    const char* cB = prm.b_base(cur);
    PG8_STAGE(PG8_SB(0, 0), cB, voffB); PG8_STAGE(PG8_SB(0, 1), cB + hstepB, voffB); PG8_STAGE(PG8_SA(0, 0), Ab, offA0); if constexpr (!P::HALFONLY) PG8_STAGE(PG8_SA(0, 1), Ab, offA1);
    if (wr == 1) PG8_BAR;
    if constexpr (P::HALFONLY) PG8_WAIT_V(0); else PG8_WAIT_V(2);
    PG8_BAR;
    PG8_STAGE(PG8_SB(1, 0), cB + kstep, voffB); PG8_STAGE(PG8_SA(1, 0), Ab + kstep, offA0); PG8_STAGE(PG8_SB(1, 1), cB + hstepB + kstep, voffB);
    PG8_WAIT_V(6); PG8_BAR;
    for (;;) {
        const bool has_next = prm.next(ui + 1, nxt);
        const char* nB = has_next ? prm.b_base(nxt) : cB;
        prm.unit_begin(cur, ui);
        unsigned idn[4] = {0u, 0u, 0u, 0u};
#pragma unroll 1
        for (int t = 0; t < nt; t += 2) {
            const bool last = (t == nt - 2);
            if (t == nt - 4 && has_next) {
                if constexpr (P::IDLDS) prm.ids_prefetch(nxt, wid, lane);
                else {
#pragma unroll
                    for (int i = 0; i < 2; ++i) { idn[i] = prm.row_id(nxt, Rl[i]); idn[2 + i] = prm.row_id(nxt, Rl[i] + HALF); }
                }
            }
            const char* a1 = Ab + (size_t)(t + 1) * kstep;
            const char* a2 = last ? Ab : Ab + (size_t)(t + 2) * kstep; const char* b2 = last ? nB : cB + (size_t)(t + 2) * kstep;
            const char* a3 = a2 + kstep; const char* b3 = b2 + kstep;
            if constexpr (P::MIDK) { if (t == nt / 2) prm.midk(acc, cur, ui, wr, fr); }
            PG8_LDB(B0, 0, 0); PG8_LDB(B1, 0, 1); PG8_SCHED; PG8_LDA(At, 0, 0); if constexpr (!P::HALFONLY) PG8_STAGE(PG8_SA(1, 1), a1, offA1);
            if (last && has_next) {
                if constexpr (P::IDLDS) {
#pragma unroll
                    for (int i = 0; i < 2; ++i) { idn[i] = prm.ids_read(nxt, Rl[i]); idn[2 + i] = prm.ids_read(nxt, Rl[i] + HALF); }
                }
#pragma unroll
                for (int i = 0; i < 2; ++i) { offA0[i] = idn[i] * lda2 + (unsigned)Cl[i] * 2u + prm.a_koff(nxt); offA1[i] = idn[2 + i] * lda2 + (unsigned)Cl[i] * 2u + prm.a_koff(nxt); }
            }
            PG8_WAIT_VK(); PG8_WAIT_L(0); PG8_BAR; PG8_MMA(0, 0, At, B0); PG8_MMA(0, 1, At, B1); PG8_BAR; PG8_SCHED;
            if constexpr (!P::HALFONLY) PG8_LDA(At, 0, 1); PG8_STAGE(PG8_SB(0, 0), b2, voffB); PG8_STAGE(PG8_SB(0, 1), b2 + hstepB, voffB); PG8_STAGE(PG8_SA(0, 0), a2, offA0);
            PG8_WAIT_VK(); PG8_WAIT_L(0); PG8_BAR; if constexpr (!P::HALFONLY) { PG8_MMA(1, 0, At, B0); PG8_MMA(1, 1, At, B1); } PG8_BAR; PG8_SCHED;
            PG8_LDB(B0, 1, 0); PG8_LDB(B1, 1, 1); PG8_SCHED; PG8_LDA(At, 1, 0); if constexpr (!P::HALFONLY) PG8_STAGE(PG8_SA(0, 1), a2, offA1);
            PG8_WAIT_VK(); PG8_WAIT_L(0); PG8_BAR; PG8_MMA(0, 0, At, B0); PG8_MMA(0, 1, At, B1); PG8_BAR; PG8_SCHED;
            if constexpr (!P::HALFONLY) PG8_LDA(At, 1, 1); PG8_STAGE(PG8_SB(1, 0), b3, voffB); PG8_STAGE(PG8_SB(1, 1), b3 + hstepB, voffB); PG8_STAGE(PG8_SA(1, 0), a3, offA0);
            PG8_WAIT_VK(); PG8_WAIT_L(0); PG8_BAR; if constexpr (!P::HALFONLY) { PG8_MMA(1, 0, At, B0); PG8_MMA(1, 1, At, B1); } PG8_BAR; PG8_SCHED;
        }
        if (wr == 0) PG8_BAR;
        prm.epi(acc, cur, ui, wr, wc, fr, fq);
        if (DUP(16)) { asm volatile("" ::: "memory"); prm.epi(acc, cur, ui, wr, wc, fr, fq); }
        if (!has_next) break;
#pragma unroll
        for (int a = 0; a < 2; ++a)
#pragma unroll
            for (int b = 0; b < 2; ++b)
#pragma unroll
                for (int m = 0; m < 4; ++m)
#pragma unroll
                    for (int n = 0; n < 2; ++n) acc[a][b][m][n] = (f32x4){0.f, 0.f, 0.f, 0.f};
        cur = nxt; cB = nB; ++ui;
        if (wr == 1) PG8_BAR;
    }
    PG8_WAIT_V(0);
    PG8_BAR;
#undef PG8_SA
#undef PG8_SB
#undef PG8_STAGE
#undef PG8_LDA
#undef PG8_LDB
#undef PG8_MMA
#undef PG8_WAIT_V
#undef PG8_WAIT_L
#undef PG8_WAIT_VK
#undef PG8_BAR
#undef PG8_SCHED
}
}
using pg8::Unit;
typedef f32x4 Acc[2][2][4][2];

struct Frame {
    LAS unsigned char* lds;
    unsigned char* ws;
    const float* const* in;
    float* out;
    int tid, lane, wave, G, vcu;
};
#define WSP(T_, off) ((T_*)(F.ws + (off)))

struct ConvItem { const float* src; int ldn; int k0; int n0; bf16_t* dst; int Kd; int drow0; int mode; int nvalid; int fp8; const float* rs0; const float* rs1; };
constexpr int CV_WIN = 16 * 38, CV_WOUT = 256, CV_CMP = 64, CV_GU = 65 * 128, CV_DN = 65 * 64;
constexpr int CV_TOTAL = CV_WIN + CV_WOUT + CV_CMP + CV_GU + CV_DN;
__device__ __forceinline__ void conv_decode(const Frame& F, int it, ConvItem& c) {
    c.mode = 0; c.nvalid = 128; c.fp8 = 0; c.rs0 = nullptr; c.rs1 = nullptr;
    if (it < CV_WIN) {
        const int kb = it / 38, nb = it % 38; c.src = F.in[I_WIN]; c.ldn = IN_COLS; c.k0 = kb * 128; c.dst = WSP(bf16_t, WS_WIN_T); c.Kd = 2048;
        if (nb < 20) { c.n0 = nb * 128; c.drow0 = (nb >> 1) * 256; c.mode = 1 + (nb & 1); }
        else if (nb < 28) { c.n0 = 2608 + (nb - 20) * 128; c.drow0 = 2560 + (nb - 20) * 128; }
        else if (nb < 36) { c.n0 = 3632 + (nb - 28) * 128; c.drow0 = 3584 + (nb - 28) * 128; }
        else if (nb == 36) { c.n0 = 2560; c.drow0 = 4608; c.nvalid = 48; }
        else { c.n0 = 2560; c.drow0 = 4736; c.nvalid = 0; }
        return;
    }
    it -= CV_WIN;
    if (it < CV_WOUT) { const int kb = it / 16, nb = it % 16; c.src = F.in[I_WOUT]; c.ldn = 2048; c.k0 = kb * 128; c.n0 = nb * 128; c.dst = WSP(bf16_t, WS_WOUT_T); c.Kd = 2048; c.drow0 = nb * 128;
        c.rs0 = F.in[I_GON]; c.rs1 = F.in[I_GOG]; return; }
    it -= CV_WOUT;
    if (it < CV_CMP) { const int kv = it / 32, r = it % 32, kb = r / 2, nb = r % 2; c.src = F.in[kv ? I_CW1V : I_CW1K]; c.ldn = 256; c.k0 = kb * 128; c.n0 = nb * 128;
        c.dst = WSP(bf16_t, WS_WCMP_T) + (size_t)kv * 256 * 2048; c.Kd = 2048; c.drow0 = nb * 128; return; }
    it -= CV_CMP;
    if (it < CV_GU) { const int e = it / 128, r = it % 128, up = r / 64, kb = (r % 64) / 4, nb = r % 4;
        c.src = (e < 64) ? F.in[up ? I_WU : I_WG] + (size_t)e * 2048 * 512 : F.in[up ? I_SU : I_SG];
        c.ldn = 512; c.k0 = kb * 128; c.n0 = nb * 128; c.dst = (bf16_t*)(WSP(unsigned char, WS_WGU_T) + (size_t)e * 1024 * 2048); c.Kd = 2048; c.drow0 = nb * 256 + up * 128; c.fp8 = 1; return; }
    it -= CV_GU;
    { const int e = it / 64, r = it % 64, kb = r / 16, nb = r % 16;
      c.src = (e < 64) ? F.in[I_WD] + (size_t)e * 512 * 2048 : F.in[I_SD];
      c.ldn = 2048; c.k0 = kb * 128; c.n0 = nb * 128; c.dst = (bf16_t*)(WSP(unsigned char, WS_WD_T) + (size_t)e * 2048 * 512); c.Kd = 512; c.drow0 = nb * 128; c.fp8 = 1; c.mode = 3; }
}
__device__ __forceinline__ void conv_load(const ConvItem& c, int sub, int lane, f32x4 (&v)[16]) {
    const int n4 = lane & 15, kq = lane >> 4, nl = 64 * (sub & 1) + 4 * n4;
    const bool ok = nl < c.nvalid;
    if (c.fp8) {
        const float* s = c.src + (size_t)(c.k0 + 64 * (sub >> 1) + 4 * kq) * c.ldn + c.n0 + nl;
#pragma unroll
        for (int i = 0; i < 4; ++i)
#pragma unroll
            for (int j = 0; j < 4; ++j) v[4 * i + j] = __builtin_nontemporal_load((const f32x4*)(s + (size_t)(16 * i + j) * c.ldn));
        return;
    }
    const float* s = c.src + (size_t)(c.k0 + 64 * (sub >> 1) + 2 * kq) * c.ldn + c.n0 + nl;
#pragma unroll
    for (int i = 0; i < 8; ++i) {
        v[2 * i] = ok ? __builtin_nontemporal_load((const f32x4*)(s + (size_t)(8 * i) * c.ldn)) : (f32x4){0.f, 0.f, 0.f, 0.f};
        v[2 * i + 1] = ok ? __builtin_nontemporal_load((const f32x4*)(s + (size_t)(8 * i + 1) * c.ldn)) : (f32x4){0.f, 0.f, 0.f, 0.f};
    }
}
__device__ __forceinline__ void conv_process(const ConvItem& c, int sub, int lane, const f32x4 (&v)[16], LAS unsigned* tile) {
    const int n4 = lane & 15, kq = lane >> 4, kb = c.k0 + 64 * (sub >> 1);
    if (c.fp8) {
#pragma unroll
        for (int i = 0; i < 4; ++i)
#pragma unroll
            for (int cc = 0; cc < 4; ++cc) tile[(4 * n4 + cc) * 129 + 4 * i + kq] = pk4_fp8(v[4 * i][cc] * W8SCALE, v[4 * i + 1][cc] * W8SCALE, v[4 * i + 2][cc] * W8SCALE, v[4 * i + 3][cc] * W8SCALE);
        return;
    }
#pragma unroll
    for (int i = 0; i < 8; ++i) {
        float s0 = 1.f, s1 = 1.f;
        if (c.rs0) { const int k = kb + 8 * i + 2 * kq; s0 = (k < 1024) ? c.rs0[k] : c.rs1[k - 1024]; s1 = (k + 1 < 1024) ? c.rs0[k + 1] : c.rs1[k + 1 - 1024]; }
#pragma unroll
        for (int cc = 0; cc < 4; ++cc) tile[(4 * n4 + cc) * 33 + 4 * i + kq] = cvt_pk_bf16(v[2 * i][cc] * s0, v[2 * i + 1][cc] * s1);
    }
#pragma unroll
    for (int j = 0; j < 8; ++j) {
        const int row = (lane >> 3) + 8 * j, c8 = lane & 7;
        const LAS unsigned* sp = tile + row * 33 + 4 * c8;
        u32x4 o; o.x = sp[0]; o.y = sp[1]; o.z = sp[2]; o.w = sp[3];
        const int n = 64 * (sub & 1) + row;
        int drow = c.drow0 + n;
        if (c.mode) { const int l = (c.mode - 1) * 128 + n, wc = l >> 6, bj = (l >> 5) & 1, jj = l & 31; drow = c.drow0 + 128 * bj + 32 * wc + jj; }
        __builtin_nontemporal_store(o, (u32x4*)(c.dst + (size_t)drow * c.Kd + kb + 8 * c8));
    }
}
template <int R>
__device__ __forceinline__ void gemv_item(const Frame& F, const LAS float* a_lds, LAS float* red, const float* W, int ldn, int n0, const float* bias, float* out, int ldo) {
    const int ks = F.tid >> 4, c4 = F.tid & 15;
    float acc[R][4];
#pragma unroll
    for (int r = 0; r < R; ++r) { acc[r][0] = 0.f; acc[r][1] = 0.f; acc[r][2] = 0.f; acc[r][3] = 0.f; }
    const float* wp = W + (size_t)(ks * 64) * ldn + n0 + 4 * c4;
#pragma unroll 16
    for (int kk = 0; kk < 64; ++kk) {
        const f32x4 w = *(const f32x4*)(wp + (size_t)kk * ldn);
#pragma unroll
        for (int r = 0; r < R; ++r) { const float a = a_lds[r * 2048 + ks * 64 + kk]; acc[r][0] += a * w.x; acc[r][1] += a * w.y; acc[r][2] += a * w.z; acc[r][3] += a * w.w; }
    }
#pragma unroll
    for (int r = 0; r < R; ++r) *(LAS f32x4*)(red + (ks * R + r) * 64 + 4 * c4) = (f32x4){acc[r][0], acc[r][1], acc[r][2], acc[r][3]};
    __syncthreads();
    if (F.tid < R * 64) {
        const int r = F.tid >> 6, n = F.tid & 63; float s = bias ? bias[n0 + n] : 0.f;
        for (int k = 0; k < 32; ++k) s += red[(k * R + r) * 64 + n];
        out[(size_t)r * ldo + n0 + n] = s;
    }
    __syncthreads();
}
constexpr int CV_NT4 = CV_TOTAL * 4;
constexpr int CV_DEFER = 0;
constexpr int CV_EARLY = 76 * 32;
constexpr int CV_EARLY_ALL = 76 * 32 + 32 * 32 + 2 * 4 * 32;
constexpr int NG_INPROJ = 132;
constexpr int CV_DEFER2 = 0;
__device__ __forceinline__ void tile_decode(int T, int& item, int& sub) {
    constexpr int T_WIN = 76 * 32, T_WOUT = 32 * 32, T_CMP = 2 * 4 * 32, T_GU = 65 * 2 * 8 * 32;
    int kb, nb;
    if (T < T_WIN) { kb = T & 31; nb = T >> 5; item = (kb >> 1) * 38 + (nb >> 1); }
    else if ((T -= T_WIN) < T_WOUT) { kb = T & 31; nb = T >> 5; item = CV_WIN + (kb >> 1) * 16 + (nb >> 1); }
    else if ((T -= T_WOUT) < T_CMP) { kb = T & 31; nb = (T >> 5) & 3; const int kv = T >> 7; item = CV_WIN + CV_WOUT + kv * 32 + (kb >> 1) * 2 + (nb >> 1); }
    else if ((T -= T_CMP) < T_GU) { kb = T & 31; nb = (T >> 5) & 7; const int eu = T >> 8; item = CV_WIN + CV_WOUT + CV_CMP + eu * 64 + (kb >> 1) * 4 + (nb >> 1); }
    else { T -= T_GU; kb = T & 7; nb = (T >> 3) & 31; const int e = T >> 8; item = CV_WIN + CV_WOUT + CV_CMP + CV_GU + e * 64 + (kb >> 1) * 16 + (nb >> 1); }
    sub = ((kb & 1) << 1) | (nb & 1);
}
__device__ __forceinline__ void conv_coop_store(const ConvItem& c0, int s0, int tid, const LAS unsigned* img) {
    unsigned char* d8 = (unsigned char*)c0.dst; const int kbase = c0.k0 + 64 * (s0 >> 1);
#pragma unroll
    for (int q = 0; q < 4; ++q) {
        const int ch = tid + 512 * q, row = ch >> 5, c16 = ch & 31;
        const LAS unsigned* sp = img + row * 129 + 4 * c16;
        u32x4 o; o.x = sp[0]; o.y = sp[1]; o.z = sp[2]; o.w = sp[3];
        int drow = c0.drow0 + 64 * (s0 & 1) + row;
        if (c0.mode == 3) { const int L = drow & 255; drow = (drow & ~255) + 128 * ((L >> 3) & 1) + 32 * (L >> 6) + 8 * ((L >> 4) & 3) + (L & 7); }
        __builtin_nontemporal_store(o, (u32x4*)(d8 + (size_t)drow * c0.Kd + kbase + 16 * c16));
    }
}
__device__ __forceinline__ void conv_range(const Frame& F, int t0, int t1, int wid, int nw) {
    LAS unsigned* tile = (LAS unsigned*)F.lds + F.wave * (64 * 33);
    LAS unsigned* img0 = (LAS unsigned*)(F.lds + 67584);
    int ta = t0 + wid; const int te = t1; int par = 0;
    ConvItem ca, cb, c0; f32x4 va[16], vb[16]; int ia, sa, ib, sb, i0, s0;
    if (ta < te) { tile_decode(ta, ia, sa); conv_decode(F, ia, ca); conv_load(ca, sa, F.lane, va); }
    while (ta < te) {
        const int tb = ta + nw;
        if (tb < te) { tile_decode(tb, ib, sb); conv_decode(F, ib, cb); conv_load(cb, sb, F.lane, vb); }
        if (ca.fp8) {
            LAS unsigned* img = img0 + par * (64 * 129);
            conv_process(ca, sa, F.lane, va, img + 16 * F.wave);
            __syncthreads();
            tile_decode(ta - F.wave, i0, s0); conv_decode(F, i0, c0); conv_coop_store(c0, s0, F.tid, img); par ^= 1;
        } else conv_process(ca, sa, F.lane, va, tile);
        if (tb >= te) break;
        ta = tb + nw;
        if (ta < te) { tile_decode(ta, ia, sa); conv_decode(F, ia, ca); conv_load(ca, sa, F.lane, va); }
        if (cb.fp8) {
            LAS unsigned* img = img0 + par * (64 * 129);
            conv_process(cb, sb, F.lane, vb, img + 16 * F.wave);
            __syncthreads();
            tile_decode(tb - F.wave, i0, s0); conv_decode(F, i0, c0); conv_coop_store(c0, s0, F.tid, img); par ^= 1;
        } else conv_process(cb, sb, F.lane, vb, tile);
    }
}
__device__ __forceinline__ void conv_process8_wave(const ConvItem& c, int sub, int lane, const f32x4 (&v)[16], LAS unsigned* tile) {
    const int n4 = lane & 15, kq = lane >> 4, kb = c.k0 + 64 * (sub >> 1);
#pragma unroll
    for (int i = 0; i < 4; ++i)
#pragma unroll
        for (int cc = 0; cc < 4; ++cc) tile[(4 * n4 + cc) * 17 + 4 * i + kq] = pk4_fp8(v[4 * i][cc] * W8SCALE, v[4 * i + 1][cc] * W8SCALE, v[4 * i + 2][cc] * W8SCALE, v[4 * i + 3][cc] * W8SCALE);
    unsigned char* d8 = (unsigned char*)c.dst;
#pragma unroll
    for (int j = 0; j < 4; ++j) {
        const int row = (lane >> 2) + 16 * j, c4 = lane & 3;
        const LAS unsigned* sp = tile + row * 17 + 4 * c4;
        u32x4 o; o.x = sp[0]; o.y = sp[1]; o.z = sp[2]; o.w = sp[3];
        int drow = c.drow0 + 64 * (sub & 1) + row;
        if (c.mode == 3) { const int L = drow & 255; drow = (drow & ~255) + 128 * ((L >> 3) & 1) + 32 * (L >> 6) + 8 * ((L >> 4) & 3) + (L & 7); }
        __builtin_nontemporal_store(o, (u32x4*)(d8 + (size_t)drow * c.Kd + kb + 16 * c4));
    }
}
__device__ __forceinline__ void conv_step(const Frame& F, const ConvItem& c, int sid, const f32x4 (&v)[16], int tcur, LAS unsigned* tile, LAS unsigned* img0, int& par) {
    if (c.fp8) { conv_process8_wave(c, sid, F.lane, v, tile);
    } else conv_process(c, sid, F.lane, v, tile);
}
__device__ __forceinline__ void conv_range3(const Frame& F, int t0, int t1, int wid, int nw) {
    LAS unsigned* tile = (LAS unsigned*)F.lds + F.wave * (64 * 33);
    LAS unsigned* img0 = (LAS unsigned*)(F.lds + 67584);
    int par = 0; const int te = t1;
    ConvItem ca, cb, cc; f32x4 va[16], vb[16], vc[16]; int ia, sa, ib, sb, ic, sc;
    int ta = t0 + wid, tb = ta + nw, tc = tb + nw;
    if (ta < te) { tile_decode(ta, ia, sa); conv_decode(F, ia, ca); conv_load(ca, sa, F.lane, va); }
    if (tb < te) { tile_decode(tb, ib, sb); conv_decode(F, ib, cb); conv_load(cb, sb, F.lane, vb); }
    while (ta < te) {
        if (tc < te) { tile_decode(tc, ic, sc); conv_decode(F, ic, cc); conv_load(cc, sc, F.lane, vc); }
        conv_step(F, ca, sa, va, ta, tile, img0, par);
        ta = tc + nw;
        if (tb >= te) break;
        if (ta < te) { tile_decode(ta, ia, sa); conv_decode(F, ia, ca); conv_load(ca, sa, F.lane, va); }
        conv_step(F, cb, sb, vb, tb, tile, img0, par);
        tb = ta + nw;
        if (tc >= te) break;
        if (tb < te) { tile_decode(tb, ib, sb); conv_decode(F, ib, cb); conv_load(cb, sb, F.lane, vb); }
        conv_step(F, cc, sc, vc, tc, tile, img0, par);
        tc = tb + nw;
    }
}
__device__ __forceinline__ void phase0a(const Frame& F) {
    LAS float* a_lds = (LAS float*)F.lds;
    LAS float* red = (LAS float*)(F.lds + 32768);
    for (int it = F.vcu; it < 200; it += F.G) {
        if (it < 192) {
            for (int i = F.tid; i < 4 * 2048; i += 512) a_lds[i] = siluf_(F.in[I_C][i]);
            __syncthreads();
            gemv_item<4>(F, a_lds, red, F.in[I_WADA], 6 * D, it * 64, F.in[I_BADA], WSP(float, WS_MOD), 6 * D);
        } else {
            const int kv = (it - 192) >> 2, nb = (it - 192) & 3;
            for (int i = F.tid; i < 2048; i += 512) a_lds[i] = F.in[kv ? I_CPV : I_CPK][i];
            __syncthreads();
            gemv_item<1>(F, a_lds, red, F.in[kv ? I_CW1V : I_CW1K], 256, nb * 64, nullptr, WSP(float, WS_BIAS1) + kv * 256, 256);
        }
    }
    for (int it = F.vcu; it < 128; it += F.G) {
        const int idx = it * 512 + F.tid, pos = idx >> 5, i = idx & 31; float c, s; rope_cs((float)pos, i, c, s);
        WSP(float, WS_ROPE)[idx] = c; WSP(float, WS_ROPE)[65536 + idx] = s;
    }
    __syncthreads();
    if (F.G == 256) {
        constexpr int HEAD = 56 * 8 * 3;
        if (F.vcu >= 200) conv_range(F, 0, HEAD, (F.vcu - 200) * 8 + F.wave, 56 * 8);
        conv_range(F, HEAD, CV_EARLY, F.vcu * 8 + F.wave, F.G * 8);
    }
    else conv_range(F, 0, CV_NT4 - CV_DEFER2, F.vcu * 8 + F.wave, F.G * 8);
}

__device__ __forceinline__ void phase0b(const Frame& F) {
    const int gw = F.vcu * 8 + F.wave, NGW = F.G * 8;
    const float* mod = WSP(float, WS_MOD);
    for (int r0 = gw * 4; r0 < NTOK; r0 += NGW * 4) {
        const int b = r0 >> 11;
        f32x4 ga[8], sh[8];
#pragma unroll
        for (int j = 0; j < 8; ++j) { const int k = 4 * F.lane + 256 * j;
            ga[j] = *(const f32x4*)(F.in[I_GN1] + k) * (*(const f32x4*)(mod + b * 6 * D + D + k) + 1.0f); sh[j] = *(const f32x4*)(mod + b * 6 * D + k); }
#pragma unroll 1
        for (int hf = 0; hf < 2; ++hf) {
            f32x4 v[2][8];
#pragma unroll
            for (int q = 0; q < 2; ++q) { const f32x4* xr = (const f32x4*)(F.in[I_X] + (size_t)(r0 + 2 * hf + q) * D) + F.lane;
#pragma unroll
                for (int j = 0; j < 8; ++j) v[q][j] = xr[64 * j]; }
#pragma unroll
            for (int q = 0; q < 2; ++q) {
                float s = 0.f;
#pragma unroll
                for (int j = 0; j < 8; ++j) s += (v[q][j].x * v[q][j].x + v[q][j].y * v[q][j].y) + (v[q][j].z * v[q][j].z + v[q][j].w * v[q][j].w);
                const float rstd = rsqrtf(wave_sum(s) * (1.f / D) + EPS);
                u32x2* o = (u32x2*)(WSP(bf16_t, WS_H) + (size_t)(r0 + 2 * hf + q) * D) + F.lane;
#pragma unroll
                for (int j = 0; j < 8; ++j) { const f32x4 h = v[q][j] * rstd * ga[j] + sh[j]; u32x2 w; w.x = cvt_pk_bf16(h.x, h.y); w.y = cvt_pk_bf16(h.z, h.w); o[64 * j] = w; }
            }
        }
    }
}

struct InProjP {
    static constexpr int K = 2048, ESZ = 2, LDB = 2048; static constexpr bool IDLDS = false; static constexpr bool HALFONLY = false; static constexpr bool MIDK = false;
    const bf16_t* A; const bf16_t* Bt; int lda; int G, c;
    unsigned char* ws; const float* gq; const float* gk;
    __device__ __forceinline__ bool next(int i, Unit& u) const { return pg8::dense_next(i, G, c, 32, 19, u); }
    __device__ __forceinline__ unsigned row_id(const Unit& u, int r) const { return (unsigned)(u.pm * 256 + r); }
    __device__ __forceinline__ const char* b_base(const Unit& u) const { return (const char*)(Bt + (size_t)u.pn * 256 * K); }
    __device__ __forceinline__ void unit_begin(const Unit&, int) const {}
    __device__ __forceinline__ unsigned a_koff(const Unit&) const { return 0u; }
    __device__ __forceinline__ void midk(Acc&, const Unit&, int, int, int) const {}
    __device__ __forceinline__ void epi(const Acc& acc, const Unit& u, int ui, int wr, int wc, int fr, int fq) const {
        const int pn = u.pn;
        if (pn < 10) {
            const bool donorm = (pn < 4) || pn == 6 || pn == 8;
            const float* g = (pn < 4) ? gq : gk;
            float glo[8], ghi[8];
#pragma unroll
            for (int j = 0; j < 8; ++j) { glo[j] = g[8 * fq + j]; ghi[j] = g[32 + 8 * fq + j]; }
            const float qs = (pn < 4) ? QSCALE : 1.0f;
            const float* cosT = (const float*)(ws + WS_ROPE); const float* sinT = cosT + 65536;
#pragma unroll
            for (int ai = 0; ai < 2; ++ai)
#pragma unroll
                for (int m = 0; m < 4; ++m) {
                    const int row = u.pm * 256 + ai * 128 + wr * 64 + m * 16 + fr, b = row >> 11, t = row & 2047;
                    float lo[8], hi[8];
#pragma unroll
                    for (int n = 0; n < 2; ++n)
#pragma unroll
                        for (int v = 0; v < 4; ++v) { lo[4 * n + v] = acc[ai][0][m][n][v]; hi[4 * n + v] = acc[ai][1][m][n][v]; }
                    if (donorm) {
                        float ss = 0.f;
#pragma unroll
                        for (int j = 0; j < 8; ++j) ss += lo[j] * lo[j] + hi[j] * hi[j];
                        ss += __shfl_xor(ss, 16); ss += __shfl_xor(ss, 32);
                        const float rstd = rsqrtf(ss * (1.f / 64.f) + EPS) * qs;
                        const f32x4 c0 = *(const f32x4*)(cosT + t * 32 + 8 * fq), c1 = *(const f32x4*)(cosT + t * 32 + 8 * fq + 4);
                        const f32x4 s0 = *(const f32x4*)(sinT + t * 32 + 8 * fq), s1 = *(const f32x4*)(sinT + t * 32 + 8 * fq + 4);
#pragma unroll
                        for (int j = 0; j < 8; ++j) {
                            const float cc = j < 4 ? c0[j & 3] : c1[j & 3], sn = j < 4 ? s0[j & 3] : s1[j & 3];
                            const float yl = lo[j] * rstd * glo[j], yh = hi[j] * rstd * ghi[j];
                            lo[j] = yl * cc - yh * sn; hi[j] = yh * cc + yl * sn;
                        }
                    }
                    bf16_t* dst = (pn < 4) ? (bf16_t*)(ws + WS_Q) + ((size_t)((b * 16 + 4 * pn + wc) * 2048 + t)) * 64
                                           : (bf16_t*)(ws + WS_KV + (size_t)(pn - 4) * KV_STRIDE) + ((size_t)((b * 4 + wc) * 2048 + t)) * 64;
                    u32x4 w0, w1;
                    w0.x = cvt_pk_bf16(lo[0], lo[1]); w0.y = cvt_pk_bf16(lo[2], lo[3]); w0.z = cvt_pk_bf16(lo[4], lo[5]); w0.w = cvt_pk_bf16(lo[6], lo[7]);
                    w1.x = cvt_pk_bf16(hi[0], hi[1]); w1.y = cvt_pk_bf16(hi[2], hi[3]); w1.z = cvt_pk_bf16(hi[4], hi[5]); w1.w = cvt_pk_bf16(hi[6], hi[7]);
                    *(u32x4*)(dst + 8 * fq) = w0; *(u32x4*)(dst + 32 + 8 * fq) = w1;
                }
        } else if (pn < 18) {
            const bool isv = pn >= 14; const int tb = isv ? pn - 14 : pn - 10;
            bf16_t* O = (bf16_t*)(ws + (isv ? WS_V : WS_U)); float* vss = (float*)(ws + WS_VSS);
#pragma unroll
            for (int ai = 0; ai < 2; ++ai)
#pragma unroll
                for (int m = 0; m < 4; ++m) {
                    const int row = u.pm * 256 + ai * 128 + wr * 64 + m * 16 + fr;
#pragma unroll
                    for (int bj = 0; bj < 2; ++bj) {
                        float y[8]; float ss = 0.f;
#pragma unroll
                        for (int n = 0; n < 2; ++n)
#pragma unroll
                            for (int v = 0; v < 4; ++v) { const float gl = gelu_tanh(acc[ai][bj][m][n][v]); y[4 * n + v] = gl; ss += gl * gl; }
                        u32x4 w; w.x = cvt_pk_bf16(y[0], y[1]); w.y = cvt_pk_bf16(y[2], y[3]); w.z = cvt_pk_bf16(y[4], y[5]); w.w = cvt_pk_bf16(y[6], y[7]);
                        *(u32x4*)(O + (size_t)row * 1024 + tb * 256 + bj * 128 + wc * 32 + 8 * fq) = w;
                        if (isv) { ss += __shfl_xor(ss, 16); ss += __shfl_xor(ss, 32); if (fq == 0) vss[(size_t)row * 32 + (2 * tb + bj) * 4 + wc] = ss; }
                    }
                }
        } else {
            float* gate = (float*)(ws + WS_GATE);
            const int col = wc * 32 + 8 * fq;
            if (col < 48) {
#pragma unroll
                for (int ai = 0; ai < 2; ++ai)
#pragma unroll
                    for (int m = 0; m < 4; ++m) {
                        const int row = u.pm * 256 + ai * 128 + wr * 64 + m * 16 + fr;
#pragma unroll
                        for (int n = 0; n < 2; ++n) { f32x4 a = acc[ai][0][m][n]; f32x4 o; o.x = sigmoidf_(a.x); o.y = sigmoidf_(a.y); o.z = sigmoidf_(a.z); o.w = sigmoidf_(a.w);
                            *(f32x4*)(gate + (size_t)row * 48 + col + 4 * n) = o; }
                    }
            }
        }
    }
};

struct CmpP {
    static constexpr int K = 512, ESZ = 2, LDB = 2048; static constexpr bool IDLDS = false; static constexpr bool HALFONLY = false; static constexpr bool MIDK = false;
    const bf16_t* A; const bf16_t* Bt; int lda; int G, c;
    unsigned char* ws;
    __device__ __forceinline__ bool next(int i, Unit& u) const { const int L = i * G + c; if (L >= 64) return false; u.e = L >> 5; u.pm = (L >> 2) & 7; u.aux = L & 3; u.pn = 0; return true; }
    __device__ __forceinline__ unsigned row_id(const Unit& u, int r) const { return (unsigned)(u.e * 2048 + u.pm * 256 + r); }
    __device__ __forceinline__ unsigned a_koff(const Unit& u) const { return (unsigned)u.aux * 1024u; }
    __device__ __forceinline__ const char* b_base(const Unit& u) const { return (const char*)(Bt + (size_t)u.e * 256 * 2048 + u.aux * 512); }
    __device__ __forceinline__ void unit_begin(const Unit&, int) const {}
    __device__ __forceinline__ void midk(Acc&, const Unit&, int, int, int) const {}
    __device__ __forceinline__ void epi(const Acc& acc, const Unit& u, int ui, int wr, int wc, int fr, int fq) const {
        float* O = (float*)(ws + WS_PO) + ((size_t)(u.aux * 2 + u.e) * 2048) * 256;
#pragma unroll
        for (int bj = 0; bj < 2; ++bj) {
            const int col = bj * 128 + wc * 32 + 8 * fq;
#pragma unroll
            for (int ai = 0; ai < 2; ++ai)
#pragma unroll
                for (int m = 0; m < 4; ++m) {
                    const int row = u.pm * 256 + ai * 128 + wr * 64 + m * 16 + fr;
                    *(f32x4*)(O + (size_t)row * 256 + col) = acc[ai][bj][m][0]; *(f32x4*)(O + (size_t)row * 256 + col + 4) = acc[ai][bj][m][1];
                }
        }
    }
};

struct OutProjP {
    static constexpr int K = 2048, ESZ = 2, LDB = 2048; static constexpr bool IDLDS = false; static constexpr bool HALFONLY = false; static constexpr bool MIDK = true;
    const bf16_t* A; const bf16_t* Bt; int lda; int G, c;
    unsigned char* ws; const float* x; float* out; LAS f32x2* tab;
    __device__ __forceinline__ bool next(int i, Unit& u) const { return pg8::dense_next(i, G, c, 32, 8, u); }
    __device__ __forceinline__ unsigned row_id(const Unit& u, int r) const { return (unsigned)(u.pm * 256 + r); }
    __device__ __forceinline__ const char* b_base(const Unit& u) const { return (const char*)(Bt + (size_t)u.pn * 256 * K); }
    __device__ __forceinline__ unsigned a_koff(const Unit&) const { return 0u; }
    __device__ __forceinline__ void unit_begin(const Unit& u, int ui) const {
        if (threadIdx.x < 256) {
            const int row = u.pm * 256 + threadIdx.x;
            const f32x4 a = *(const f32x4*)((const float*)(ws + WS_OSSN) + (size_t)row * 4);
            const f32x4* gp = (const f32x4*)((const float*)(ws + WS_OSSG) + (size_t)row * 16);
            const f32x4 g0 = gp[0], g1 = gp[1], g2 = gp[2], g3 = gp[3];
            const float sn = (a.x + a.y) + (a.z + a.w);
            const float sg = ((g0.x + g0.y) + (g0.z + g0.w)) + ((g1.x + g1.y) + (g1.z + g1.w)) + ((g2.x + g2.y) + (g2.z + g2.w)) + ((g3.x + g3.y) + (g3.z + g3.w));
            const float rn = rsqrtf(sn * (1.f / 1024.f) + EPS), rg = rsqrtf(sg * (1.f / 1024.f) + EPS);
            tab[(ui & 1) * 256 + threadIdx.x] = (f32x2){rn / rg, rg};
        }
    }
    __device__ __forceinline__ void midk(Acc& acc, const Unit& u, int ui, int wr, int fr) const {
#pragma unroll
        for (int ai = 0; ai < 2; ++ai)
#pragma unroll
            for (int m = 0; m < 4; ++m) { const float s = tab[(ui & 1) * 256 + ai * 128 + wr * 64 + m * 16 + fr].x;
#pragma unroll
                for (int bj = 0; bj < 2; ++bj)
#pragma unroll
                    for (int n = 0; n < 2; ++n) acc[ai][bj][m][n] *= s; }
    }
    __device__ __forceinline__ void epi(const Acc& acc, const Unit& u, int ui, int wr, int wc, int fr, int fq) const {
        const float* mod = (const float*)(ws + WS_MOD);
#pragma unroll
        for (int ai = 0; ai < 2; ++ai)
#pragma unroll
            for (int m = 0; m < 4; ++m) {
                const int r = ai * 128 + wr * 64 + m * 16 + fr, row = u.pm * 256 + r, b = row >> 11; const float s = tab[(ui & 1) * 256 + r].y;
#pragma unroll
                for (int bj = 0; bj < 2; ++bj) {
                    const int col = u.pn * 256 + bj * 128 + wc * 32 + 8 * fq;
#pragma unroll
                    for (int n = 0; n < 2; ++n) {
                        const f32x4 gt = *(const f32x4*)(mod + b * 6 * D + 2 * D + col + 4 * n), xv = *(const f32x4*)(x + (size_t)row * D + col + 4 * n);
                        *(f32x4*)(out + (size_t)row * D + col + 4 * n) = xv + gt * (acc[ai][bj][m][n] * s);
                    }
                }
            }
    }
};

__device__ __forceinline__ void moe_table(const Frame& F, LAS int* tb) {
    if (F.tid < 64) {
        const unsigned* cnt = (const unsigned*)(F.ws + WS_CTL) + CW_CNT;
        const int c = (int)__hip_atomic_load(cnt + F.tid, __ATOMIC_RELAXED, __HIP_MEMORY_SCOPE_AGENT);
        const int tl = (c + 255) >> 8; int inc = tl;
#pragma unroll
        for (int o = 1; o < 64; o <<= 1) { const int v = __shfl_up(inc, o); if (F.lane >= o) inc += v; }
        tb[F.tid] = inc - tl; tb[128 + F.tid] = c;
        if (F.tid == 63) { tb[64] = inc; tb[65] = inc + (NTOK >> 8); tb[128 + 64] = NTOK; }
    }
    __syncthreads();
    if (F.tid < 384) {
        int lo = 0, hi = 64; while (lo < hi) { const int mid = (lo + hi + 1) >> 1; if (tb[mid] <= F.tid) lo = mid; else hi = mid - 1; }
        tb[256 + F.tid] = lo;
        const int nv = tb[128 + lo] - (F.tid - tb[lo]) * 256;
        tb[640 + F.tid] = (F.tid < tb[65] && lo < 64 && nv <= 128) ? 1 : 0;
    }
    __syncthreads();
    if (F.tid < 384) {
        const int TT = tb[65]; int nfb = 0, nhb = 0, nf = 0;
        for (int m = 0; m < TT; ++m) { const int h = tb[640 + m]; nf += 1 - h; if (m < F.tid) { nhb += h; nfb += 1 - h; } }
        if (F.tid < TT) tb[1024 + (tb[640 + F.tid] ? nf + nhb : nfb)] = F.tid;
        if (F.tid == 0) tb[66] = nf;
    }
    __syncthreads();
}
__device__ __forceinline__ int moe_find(const LAS int* tb, int mt) { int lo = 0, hi = 64;
    while (lo < hi) { const int mid = (lo + hi + 1) >> 1; if (tb[mid] <= mt) lo = mid; else hi = mid - 1; } return lo; }

template <bool HALF> struct MoeUpP {
    LAS unsigned* idtab;
    static constexpr int K = 2048, ESZ = 1, LDB = 2048; static constexpr bool IDLDS = true; static constexpr bool HALFONLY = HALF; static constexpr bool MIDK = false;
    const unsigned char* A; const unsigned char* Bt; int lda; int G, c;
    unsigned char* ws; const LAS int* tb; int c0;
    __device__ __forceinline__ bool next(int i, Unit& u) const {
        const int nf = tb[66]; int k;
        if (!HALF) { const int L = i * G + c; if (L >= nf * 4) return false; k = L >> 2; u.pn = L & 3; }
        else { if (c < c0) return false; const int L = i * (G - c0) + (c - c0); if (L >= (tb[65] - nf) * 4) return false; k = nf + (L >> 2); u.pn = L & 3; }
        const int mt = tb[1024 + k]; u.e = tb[256 + mt]; u.pm = mt; u.aux = mt - tb[u.e]; return true; }
    __device__ __forceinline__ unsigned row_id(const Unit& u, int r) const {
        const int base = u.aux * 256; const int nv = tb[128 + u.e] - base; const int rr = r < nv ? r : 0;
        if (u.e == 64) return (unsigned)(base + rr);
        return (unsigned)((const int*)(ws + WS_LIST))[u.e * 8192 + base + rr];
    }
    __device__ __forceinline__ const char* b_base(const Unit& u) const { return (const char*)(Bt + ((size_t)u.e * 1024 + u.pn * 256) * K); }
    __device__ __forceinline__ void ids_prefetch(const Unit& u, int wid, int lane) const {
        if (u.e == 64) return;
        const int r = 64 * (wid & 3) + lane, base = u.aux * 256, nv = tb[128 + u.e] - base, rr = r < nv ? r : 0;
        __builtin_amdgcn_global_load_lds((const unsigned*)((const int*)(ws + WS_LIST) + u.e * 8192 + base + rr), (LAS unsigned*)(idtab + (wid >> 2) * 256 + 64 * (wid & 3)), 4, 0, 0);
    }
    __device__ __forceinline__ unsigned ids_read(const Unit& u, int r) const {
        if (u.e == 64) { const int base = u.aux * 256, nv = tb[128 + u.e] - base; return (unsigned)(base + (r < nv ? r : 0)); }
        return idtab[r];
    }
    __device__ __forceinline__ void unit_begin(const Unit&, int) const {}
    __device__ __forceinline__ unsigned a_koff(const Unit&) const { return 0u; }
    __device__ __forceinline__ void midk(Acc&, const Unit&, int, int, int) const {}
    __device__ __forceinline__ void epi(const Acc& acc, const Unit& u, int ui, int wr, int wc, int fr, int fq) const {
        unsigned char* O = ws + WS_HID; const float ws_ = 1.0f / W8SCALE;
#pragma unroll
        for (int ai = 0; ai < (HALF ? 1 : 2); ++ai)
#pragma unroll
            for (int m = 0; m < 4; ++m) {
                const size_t row = (size_t)u.pm * 256 + ai * 128 + wr * 64 + m * 16 + fr; float y[8];
#pragma unroll
                for (int n = 0; n < 2; ++n)
#pragma unroll
                    for (int v = 0; v < 4; ++v) y[4 * n + v] = siluf_(acc[ai][0][m][n][v] * ws_) * (acc[ai][1][m][n][v] * (ws_ * H8SCALE));
                u32x2 w; w.x = pk4_fp8(y[0], y[1], y[2], y[3]); w.y = pk4_fp8(y[4], y[5], y[6], y[7]);
                *(u32x2*)(O + row * 512 + u.pn * 128 + wc * 32 + 8 * fq) = w;
            }
    }
};
template <bool HALF> struct MoeDownP {
    static constexpr int K = 512, ESZ = 1, LDB = 512; static constexpr bool IDLDS = false; static constexpr bool HALFONLY = HALF; static constexpr bool MIDK = false;
    const unsigned char* A; const unsigned char* Bt; int lda; int G, c;
    unsigned char* ws; const LAS int* tb; int c0;
    __device__ __forceinline__ bool next(int i, Unit& u) const {
        const int nf = tb[66]; int k;
        if (!HALF) { const int L = i * G + c; if (L >= nf * 8) return false; k = L >> 3; u.pn = L & 7; }
        else { if (c < c0) return false; const int L = i * (G - c0) + (c - c0); if (L >= (tb[65] - nf) * 8) return false; k = nf + (L >> 3); u.pn = L & 7; }
        const int mt = tb[1024 + k]; u.e = tb[256 + mt]; u.pm = mt; u.aux = 0; return true; }
    __device__ __forceinline__ unsigned row_id(const Unit& u, int r) const { return (unsigned)(u.pm * 256 + r); }
    __device__ __forceinline__ const char* b_base(const Unit& u) const { return (const char*)(Bt + ((size_t)u.e * 2048 + u.pn * 256) * K); }
    __device__ __forceinline__ void unit_begin(const Unit&, int) const {}
    __device__ __forceinline__ unsigned a_koff(const Unit&) const { return 0u; }
    __device__ __forceinline__ void midk(Acc&, const Unit&, int, int, int) const {}
    __device__ __forceinline__ void epi(const Acc& acc, const Unit& u, int ui, int wr, int wc, int fr, int fq) const {
        unsigned char* O = ws + WS_PO; const float sc_ = PO8SCALE / (W8SCALE * H8SCALE);
#pragma unroll
        for (int ai = 0; ai < (HALF ? 1 : 2); ++ai)
#pragma unroll
            for (int m = 0; m < 4; ++m) {
                const size_t row = (size_t)u.pm * 256 + ai * 128 + wr * 64 + m * 16 + fr;
                const f32x4 a0 = acc[ai][0][m][0] * sc_, a1 = acc[ai][0][m][1] * sc_, b0 = acc[ai][1][m][0] * sc_, b1 = acc[ai][1][m][1] * sc_;
                u32x4 w; w.x = pk4_fp8(a0.x, a0.y, a0.z, a0.w); w.y = pk4_fp8(a1.x, a1.y, a1.z, a1.w); w.z = pk4_fp8(b0.x, b0.y, b0.z, b0.w); w.w = pk4_fp8(b1.x, b1.y, b1.z, b1.w);
                *(u32x4*)(O + row * 2048 + u.pn * 256 + wc * 64 + 16 * fq) = w;
            }
    }
};

__device__ __forceinline__ void gmlp_unit(const Frame& F, int n) {
    const int b = n >> 7, c = (n >> 3) & 15, g = n & 7;
    constexpr int WP = 136, VP = 160;
    LAS bf16_t* Ws = (LAS bf16_t*)F.lds;
    LAS bf16_t* Vs = (LAS bf16_t*)(F.lds + 34816);
    LAS float* rs = (LAS float*)(F.lds + 75776);
    LAS float* stg = (LAS float*)F.lds + F.wave * 2048;
    const int row0 = b * T + c * 128;
    const int tb = F.wave & 3, dh = F.wave >> 2, r32 = F.lane & 31, hi = F.lane >> 5;
    f32x4 vssv = (f32x4){0.f, 0.f, 0.f, 0.f};
    if (F.tid < 128) vssv = *(const f32x4*)(WSP(float, WS_VSS) + (size_t)(row0 + F.tid) * 32 + g * 4);
    const float* wsp = F.in[I_WSP] + (size_t)g * 128 * 128;
    f32x4 wv[8];
#pragma unroll
    for (int q = 0; q < 8; ++q) { const int idx = F.tid + 512 * q; wv[q] = *(const f32x4*)(wsp + (idx >> 5) * 128 + (idx & 31) * 4); }
    const bf16_t* Vg = WSP(bf16_t, WS_V);
    u32x4 vv[4];
#pragma unroll
    for (int q = 0; q < 4; ++q) { const int ch = F.tid + 512 * q; vv[q] = *(const u32x4*)(Vg + (size_t)(row0 + (ch >> 4)) * 1024 + g * 128 + (ch & 15) * 8); }
    const bf16_t* U = WSP(bf16_t, WS_U);
    u32x4 uv[4];
#pragma unroll
    for (int q = 0; q < 4; ++q) uv[q] = *(const u32x4*)(U + (size_t)(row0 + 32 * tb + q * 8 + (F.lane >> 3)) * 1024 + g * 128 + 64 * dh + (F.lane & 7) * 8);
    f32x4 gv0, gv1; { const float* gvp = F.in[I_GGV] + g * 128 + (F.tid & 15) * 8; gv0 = *(const f32x4*)gvp; gv1 = *(const f32x4*)(gvp + 4); }
    __syncthreads();
    if (F.tid < 128) rs[F.tid] = rsqrtf(((vssv.x + vssv.y) + (vssv.z + vssv.w)) * (1.f / 128.f) + EPS);
#pragma unroll
    for (int q = 0; q < 8; ++q) {
        const int idx = F.tid + 512 * q, t = idx >> 5, s4 = (idx & 31) * 4;
        f32x4 w = wv[q];
        if (s4 + 0 > t) w.x = 0.f; if (s4 + 1 > t) w.y = 0.f; if (s4 + 2 > t) w.z = 0.f; if (s4 + 3 > t) w.w = 0.f;
        u32x2 o; o.x = cvt_pk_bf16(w.x, w.y); o.y = cvt_pk_bf16(w.z, w.w);
        *(LAS u32x2*)(Ws + t * WP + s4) = o;
    }
    __syncthreads();
#pragma unroll
    for (int q = 0; q < 4; ++q) {
        const int ch = F.tid + 512 * q, sidx = ch >> 4, dc = ch & 15;
        const float r = rs[sidx];
        u32x4 o;
        o.x = cvt_pk_bf16(bflo(vv[q].x) * r * gv0.x, bfhi(vv[q].x) * r * gv0.y); o.y = cvt_pk_bf16(bflo(vv[q].y) * r * gv0.z, bfhi(vv[q].y) * r * gv0.w);
        o.z = cvt_pk_bf16(bflo(vv[q].z) * r * gv1.x, bfhi(vv[q].z) * r * gv1.y); o.w = cvt_pk_bf16(bflo(vv[q].w) * r * gv1.z, bfhi(vv[q].w) * r * gv1.w);
        *(LAS u32x4*)(Vs + sidx * VP + dc * 8) = o;
    }
    __syncthreads();
    f32x16 acc[2]; acc[0] = (f32x16)(0.f); acc[1] = (f32x16)(0.f);
    {
        const LAS unsigned char* vbase = (const LAS unsigned char*)Vs + (8 * hi + ((F.lane & 15) >> 2)) * (VP * 2) + (64 * dh + 16 * ((F.lane >> 4) & 1) + 4 * (F.lane & 3)) * 2;
        for (int kc = 0; kc < 2 * tb + 2; ++kc) {
            const bf16x8 a = *(const LAS bf16x8*)(Ws + (32 * tb + r32) * WP + 16 * kc + 8 * hi);
#pragma unroll
            for (int db = 0; db < 2; ++db) {
                const v4i16_t lo4 = __builtin_amdgcn_ds_read_tr16_b64_v4i16((LAS v4i16_t*)(vbase + (16 * kc) * (VP * 2) + 64 * db));
                const v4i16_t hi4 = __builtin_amdgcn_ds_read_tr16_b64_v4i16((LAS v4i16_t*)(vbase + (16 * kc + 4) * (VP * 2) + 64 * db));
                const bf16x8 bq = (bf16x8){lo4[0], lo4[1], lo4[2], lo4[3], hi4[0], hi4[1], hi4[2], hi4[3]};
                acc[db] = __builtin_amdgcn_mfma_f32_32x32x16_bf16(a, bq, acc[db], 0, 0, 0);
            }
        }
    }
    __syncthreads();
    {
        const float* bsp = F.in[I_BSP] + g * 128 + 32 * tb + 4 * hi;
        LAS float* sl = stg + (4 * hi) * 64 + r32;
#pragma unroll
        for (int r = 0; r < 16; ++r) { const int rc = (r & 3) + 8 * (r >> 2); const float bias = bsp[rc]; sl[rc * 64] = acc[0][r] + bias; sl[rc * 64 + 32] = acc[1][r] + bias; }
    }
    bf16_t* O = WSP(bf16_t, WS_OCAT); float* ossg = WSP(float, WS_OSSG);
#pragma unroll
    for (int q = 0; q < 4; ++q) {
        const int rl = q * 8 + (F.lane >> 3), ch = F.lane & 7, row = row0 + 32 * tb + rl;
        const f32x4 m0 = *(const LAS f32x4*)(stg + rl * 64 + ch * 8), m1 = *(const LAS f32x4*)(stg + rl * 64 + ch * 8 + 4);
        const float o0 = bflo(uv[q].x) * m0.x, o1 = bfhi(uv[q].x) * m0.y, o2 = bflo(uv[q].y) * m0.z, o3 = bfhi(uv[q].y) * m0.w;
        const float o4 = bflo(uv[q].z) * m1.x, o5 = bfhi(uv[q].z) * m1.y, o6 = bflo(uv[q].w) * m1.z, o7 = bfhi(uv[q].w) * m1.w;
        u32x4 w; w.x = cvt_pk_bf16(o0, o1); w.y = cvt_pk_bf16(o2, o3); w.z = cvt_pk_bf16(o4, o5); w.w = cvt_pk_bf16(o6, o7);
        *(u32x4*)(O + (size_t)row * 2048 + 1024 + g * 128 + 64 * dh + ch * 8) = w;
        float ss = ((o0 * o0 + o1 * o1) + (o2 * o2 + o3 * o3)) + ((o4 * o4 + o5 * o5) + (o6 * o6 + o7 * o7));
        ss += __shfl_xor(ss, 1); ss += __shfl_xor(ss, 2); ss += __shfl_xor(ss, 4);
        if (ch == 0) ossg[(size_t)row * 16 + 2 * g + dh] = ss;
    }
}

__device__ __forceinline__ void phase2b(const Frame& F) {
    const int gw = F.vcu * 8 + F.wave, NGW = F.G * 8;
    LAS float* hs = (LAS float*)F.lds + F.wave * 256;
    for (int it = gw; it < 4096; it += NGW) {
        const int kv = it >> 11, m = it & 2047, n = m & 127;
        bf16_t* dst = WSP(bf16_t, kv ? WS_VCMP : WS_KCMP) + (size_t)m * 64;
        if (n == 127) { dst[F.lane] = 0; continue; }
        {
            f32x4 a = *(const f32x4*)(WSP(float, WS_BIAS1) + kv * 256 + 4 * F.lane);
#pragma unroll
            for (int ks = 0; ks < 4; ++ks) a += *(const f32x4*)(WSP(float, WS_PO) + ((size_t)(ks * 2 + kv) * 2048 + m) * 256 + 4 * F.lane);
            hs[4 * F.lane + 0] = gelu_tanh(a.x); hs[4 * F.lane + 1] = gelu_tanh(a.y); hs[4 * F.lane + 2] = gelu_tanh(a.z); hs[4 * F.lane + 3] = gelu_tanh(a.w);
        }
        const float* w2 = F.in[kv ? I_CW2V : I_CW2K];
        float y = 0.f;
#pragma unroll 8
        for (int k = 0; k < 256; ++k) y += hs[k] * w2[k * 64 + F.lane];
        if (kv == 0) {
            const float rstd = rsqrtf(wave_sum(y * y) * (1.f / 64.f) + EPS);
            const float yn = y * rstd * F.in[I_GK][F.lane];
            const float pr = __shfl_xor(yn, 32);
            float c, s; rope_cs(16.0f * (float)n + 15.5f, F.lane & 31, c, s);
            y = (F.lane < 32) ? yn * c - pr * s : yn * c + pr * s;
        }
        dst[F.lane] = (bf16_t)(cvt_pk_bf16(y, 0.f) & 0xffffu);
    }
}

constexpr int AT_KS = 0, AT_VT = 18432, AT_WSF = 43008, AT_MSK = 45056, AT_FS = 45312, AT_SSQ = 47360, AT_IMP = 48384, AT_G = 56832, AT_L = 90624;
constexpr int KSP = 72, VTP = 96, VTB = 64 * VTP * 2;
constexpr float AT_THR = 20.0f;
struct AttnCtx {
    LAS unsigned char* lds; int tid, lane, wave, r32, hi, g, th, tokl;
    bf16x8 qf[4];
};
__device__ __forceinline__ void at_load(const bf16_t* Kb, const bf16_t* Vb, int tile, int tid, u32x4& kr, u32x4& vr) {
    const size_t off = (size_t)(tile * 64 + (tid >> 3)) * 64 + (tid & 7) * 8;
    kr = *(const u32x4*)(Kb + off); vr = *(const u32x4*)(Vb + off);
}
__device__ __forceinline__ void at_store(LAS unsigned char* lds, int buf, int tid, const u32x4& kr, const u32x4& vr) {
    const int key = tid >> 3, ch = tid & 7;
    *(LAS u32x4*)(lds + AT_KS + buf * 9216 + (key * KSP + ch * 8) * 2) = kr;
    *(LAS u32x4*)(lds + AT_VT + buf * VTB + (key * VTP + ch * 8) * 2) = vr;
}
__device__ __forceinline__ void attn_pass(const int MODE, AttnCtx& C, const bf16_t* Kb, const bf16_t* Vb, int i, int j0, int ntiles, unsigned rowmask, bool want_imp, float gatev, f32x16 (&of)[2],
                                          u32x4& kr, u32x4& vr, const bf16_t* Kn, const bf16_t* Vn, int jn) {
    LAS unsigned char* lds = C.lds;
    LAS float* wsf = (LAS float*)(lds + AT_WSF) + C.wave * 64;
    float mref = 0.f, l = 0.f, m0 = 0.f;
    f32x16 o[2]; o[0] = (f32x16)(0.f); o[1] = (f32x16)(0.f);
    const int vlane = (4 * C.hi + ((C.lane & 15) >> 2)) * (VTP * 2) + (16 * ((C.lane >> 4) & 1) + 4 * (C.lane & 3)) * 2;
    at_store(lds, 0, C.tid, kr, vr);
    __syncthreads();
    for (int tt = 0; tt < ntiles; ++tt) {
        const int buf = tt & 1, j = j0 + tt;
        if (tt + 1 < ntiles) at_load(Kb, Vb, j + 1, C.tid, kr, vr); else if (Kn) at_load(Kn, Vn, jn, C.tid, kr, vr);
        bool active = true;
        if (MODE == 1) active = __any((rowmask >> j) & 1u);
        if (active) {
            f32x16 p0, p1;
            const LAS unsigned char* ks = lds + AT_KS + buf * 9216;
            int wlo = 0, whi = 63;
            if (MODE == 0) { const int t = 64 * i + C.tokl; whi = ((t >= 31) ? ((t - 31) >> 4) : -1) - 64 * tt; }
            else {
                if (MODE == 1 && !((rowmask >> j) & 1u)) wlo = 64;
                if (j == i) whi = C.tokl;
                if (MODE == 2 && j == i - 8) wlo = C.tokl + 1;
            }
            const bf16x8 ka0 = *(const LAS bf16x8*)(ks + (C.r32 * KSP + 8 * C.hi) * 2);
            const bf16x8 ka1 = *(const LAS bf16x8*)(ks + ((32 + C.r32) * KSP + 8 * C.hi) * 2);
            if (__any(wlo > 0 || whi < 63)) {
                f32x16 c0, c1;
#pragma unroll
                for (int r = 0; r < 16; ++r) { const int kl = (r & 3) + 8 * (r >> 2) + 4 * C.hi; c0[r] = (kl < wlo || kl > whi) ? NEGF : 0.f; c1[r] = (kl + 32 < wlo || kl + 32 > whi) ? NEGF : 0.f; }
                p0 = __builtin_amdgcn_mfma_f32_32x32x16_bf16(ka0, C.qf[0], c0, 0, 0, 0); p1 = __builtin_amdgcn_mfma_f32_32x32x16_bf16(ka1, C.qf[0], c1, 0, 0, 0);
            } else {
                const f32x16 z16 = (f32x16)(0.f);
                p0 = __builtin_amdgcn_mfma_f32_32x32x16_bf16(ka0, C.qf[0], z16, 0, 0, 0); p1 = __builtin_amdgcn_mfma_f32_32x32x16_bf16(ka1, C.qf[0], z16, 0, 0, 0);
            }
#pragma unroll
            for (int d0 = 1; d0 < 4; ++d0) {
                const bf16x8 k0 = *(const LAS bf16x8*)(ks + (C.r32 * KSP + 16 * d0 + 8 * C.hi) * 2);
                const bf16x8 k1 = *(const LAS bf16x8*)(ks + ((32 + C.r32) * KSP + 16 * d0 + 8 * C.hi) * 2);
                p0 = __builtin_amdgcn_mfma_f32_32x32x16_bf16(k0, C.qf[d0], p0, 0, 0, 0); p1 = __builtin_amdgcn_mfma_f32_32x32x16_bf16(k1, C.qf[d0], p1, 0, 0, 0);
            }
            if (__any(mref != 0.f)) {
#pragma unroll
                for (int r = 0; r < 16; ++r) { p0[r] -= mref; p1[r] -= mref; }
            }
            float mx = fmaxf(p0[0], p1[0]);
#pragma unroll
            for (int r = 1; r < 16; ++r) mx = fmaxf(fmaxf(mx, p0[r]), p1[r]);
            if (__any(mx > AT_THR)) {
                mx = fmaxf(mx, __shfl_xor(mx, 32));
                const float dl = fmaxf(mx, 0.f); mref += dl;
#pragma unroll
                for (int r = 0; r < 16; ++r) { p0[r] -= dl; p1[r] -= dl; }
                const float f = fexp2(-dl); l *= f;
                if (C.hi == 0) wsf[C.r32] = f;
#pragma unroll
                for (int r = 0; r < 16; ++r) { const float ff = wsf[(r & 3) + 8 * (r >> 2) + 4 * C.hi]; o[0][r] *= ff; o[1][r] *= ff; }
            }
            float rsum = 0.f;
#pragma unroll
            for (int r = 0; r < 16; ++r) { p0[r] = fexp2(p0[r]); p1[r] = fexp2(p1[r]); rsum += p0[r] + p1[r]; }
            l += rsum;
            if (MODE == 0) {
                if (tt == 0) m0 = mref;
                if (want_imp) {
                    LAS float* Gs = (LAS float*)(lds + AT_G) + (C.g * 64 + C.tokl) * 33; LAS float* Ls = (LAS float*)(lds + AT_L) + (C.g * 64 + C.tokl) * 33;
#pragma unroll
                    for (int rg = 0; rg < 4; ++rg) {
                        const int ml = 16 * tt + 2 * rg + C.hi;
                        Gs[ml] = (p0[4 * rg] + p0[4 * rg + 1]) + (p0[4 * rg + 2] + p0[4 * rg + 3]); Ls[ml] = p0[4 * rg + 3];
                        Gs[ml + 8] = (p1[4 * rg] + p1[4 * rg + 1]) + (p1[4 * rg + 2] + p1[4 * rg + 3]); Ls[ml + 8] = p1[4 * rg + 3];
                    }
                }
            }
            bf16x8 pa[4];
#pragma unroll
            for (int c = 0; c < 4; ++c) {
                u32x4 w;
                if (c < 2) { w.x = cvt_pk_bf16(p0[8 * c], p0[8 * c + 1]); w.y = cvt_pk_bf16(p0[8 * c + 2], p0[8 * c + 3]); w.z = cvt_pk_bf16(p0[8 * c + 4], p0[8 * c + 5]); w.w = cvt_pk_bf16(p0[8 * c + 6], p0[8 * c + 7]); }
                else { const int cc = c - 2; w.x = cvt_pk_bf16(p1[8 * cc], p1[8 * cc + 1]); w.y = cvt_pk_bf16(p1[8 * cc + 2], p1[8 * cc + 3]); w.z = cvt_pk_bf16(p1[8 * cc + 4], p1[8 * cc + 5]); w.w = cvt_pk_bf16(p1[8 * cc + 6], p1[8 * cc + 7]); }
                pa[c] = __builtin_bit_cast(bf16x8, w);
            }
            const LAS unsigned char* vb = lds + AT_VT + buf * VTB + vlane;
#pragma unroll
            for (int c = 0; c < 4; ++c) {
                const int koff = (32 * (c >> 1) + 16 * (c & 1)) * (VTP * 2);
#pragma unroll
                for (int db = 0; db < 2; ++db) {
                    const v4i16_t lo = __builtin_amdgcn_ds_read_tr16_b64_v4i16((LAS v4i16_t*)(vb + koff + 64 * db));
                    const v4i16_t hi4 = __builtin_amdgcn_ds_read_tr16_b64_v4i16((LAS v4i16_t*)(vb + koff + 8 * (VTP * 2) + 64 * db));
                    const bf16x8 bv = (bf16x8){lo[0], lo[1], lo[2], lo[3], hi4[0], hi4[1], hi4[2], hi4[3]};
                    o[db] = __builtin_amdgcn_mfma_f32_32x32x16_bf16(pa[c], bv, o[db], 0, 0, 0);
                }
            }
        }
        if (tt + 1 < ntiles) at_store(lds, buf ^ 1, C.tid, kr, vr);
        __syncthreads();
    }
    const float lt = l + __shfl_xor(l, 32);
    const float inv = lt > 0.f ? frcp(lt) : 0.f;
    if (MODE == 0 && want_imp && C.hi == 0) {
        LAS float* fs = (LAS float*)(lds + AT_FS) + (C.g * 64 + C.tokl) * 2;
        fs[0] = (ntiles > 1) ? fexp2(m0 - mref) * inv : inv; fs[1] = inv;
    }
    if (C.hi == 0) wsf[C.r32] = inv * gatev;
#pragma unroll
    for (int r = 0; r < 16; ++r) { const float f = wsf[(r & 3) + 8 * (r >> 2) + 4 * C.hi]; of[0][r] += o[0][r] * f; of[1][r] += o[1][r] * f; }
}
__device__ __forceinline__ void attn_unit(const Frame& F, int b, int kvh, int i) {
    AttnCtx C; C.lds = F.lds; C.tid = F.tid; C.lane = F.lane; C.wave = F.wave; C.r32 = F.lane & 31; C.hi = F.lane >> 5; C.g = F.wave >> 1; C.th = F.wave & 1; C.tokl = 32 * C.th + C.r32;
    const int h = 4 * kvh + C.g, t = 64 * i + C.tokl, row = b * T + t;
    const bf16_t* Qp = WSP(bf16_t, WS_Q) + ((size_t)(b * 16 + h) * 2048 + t) * 64;
#pragma unroll
    for (int d0 = 0; d0 < 4; ++d0) C.qf[d0] = *(const bf16x8*)(Qp + 16 * d0 + 8 * C.hi);
    const float* gp = WSP(float, WS_GATE) + (size_t)row * 48 + h * 3;
    const float g0 = gp[0], g1 = gp[1], g2 = gp[2];
    const size_t kvoff = (size_t)(b * 4 + kvh) * 2048 * 64;
    f32x16 of[2]; of[0] = (f32x16)(0.f); of[1] = (f32x16)(0.f);
    const bool want_imp = i >= 16;
    u32x4 kr, vr;
    at_load(WSP(bf16_t, WS_KCMP) + (size_t)(b * 4 + kvh) * 128 * 64, WSP(bf16_t, WS_VCMP) + (size_t)(b * 4 + kvh) * 128 * 64, 0, C.tid, kr, vr);
    __syncthreads();
    LAS unsigned* msk = (LAS unsigned*)(F.lds + AT_MSK);
    unsigned rowmask = 0u;
#pragma unroll 1
    for (int ps = 0; ps < 3; ++ps) {
        const bf16_t* Kb; const bf16_t* Vb; int j0, ntl; float gv;
        if (ps == 0) { Kb = WSP(bf16_t, WS_KCMP) + (size_t)(b * 4 + kvh) * 128 * 64; Vb = WSP(bf16_t, WS_VCMP) + (size_t)(b * 4 + kvh) * 128 * 64; j0 = 0; ntl = want_imp ? 2 : 1; gv = g0; }
        else if (ps == 1) { Kb = WSP(bf16_t, WS_KV + 2 * KV_STRIDE) + kvoff; Vb = WSP(bf16_t, WS_KV + 3 * KV_STRIDE) + kvoff; j0 = 0; ntl = i + 1; gv = g1; }
        else { Kb = WSP(bf16_t, WS_KV + 4 * KV_STRIDE) + kvoff; Vb = WSP(bf16_t, WS_KV + 5 * KV_STRIDE) + kvoff; j0 = i >= 8 ? i - 8 : 0; ntl = i - j0 + 1; gv = g2; }
        const bf16_t* Kn = nullptr; const bf16_t* Vn = nullptr; int jn = 0;
        if (ps == 0) { Kn = WSP(bf16_t, WS_KV + 2 * KV_STRIDE) + kvoff; Vn = WSP(bf16_t, WS_KV + 3 * KV_STRIDE) + kvoff; jn = 0; }
        else if (ps == 1) { Kn = WSP(bf16_t, WS_KV + 4 * KV_STRIDE) + kvoff; Vn = WSP(bf16_t, WS_KV + 5 * KV_STRIDE) + kvoff; jn = i >= 8 ? i - 8 : 0; }
        attn_pass(ps, C, Kb, Vb, i, j0, ntl, rowmask, want_imp, gv, of, kr, vr, Kn, Vn, jn);
        if (ps == 0) {
            if (want_imp) {
                __syncthreads();
                LAS float* Gs = (LAS float*)(F.lds + AT_G); LAS float* Ls = (LAS float*)(F.lds + AT_L); LAS float* fs = (LAS float*)(F.lds + AT_FS); LAS float* imp = (LAS float*)(F.lds + AT_IMP);
#pragma unroll 1
                for (int q = 0; q < 4; ++q) {
                    const int idx = F.tid + 512 * q, tok = idx >> 5, j = idx & 31; float v = 0.f;
#pragma unroll
                    for (int g = 0; g < 4; ++g) {
                        const int base = (g * 64 + tok);
                        v += fs[base * 2 + (j >> 4)] * Gs[base * 33 + j];
                        if (j > 0) v += fs[base * 2 + ((j - 1) >> 4)] * Ls[base * 33 + j - 1];
                    }
                    imp[tok * 33 + j] = v;
                }
                __syncthreads();
                {
                    const int tok = F.tid >> 3, sub = F.tid & 7;
                    const LAS float* im = imp + tok * 33;
                    float cv[4]; int cj[4];
#pragma unroll
                    for (int q = 0; q < 4; ++q) { cj[q] = 1 + sub + 8 * q; cv[q] = (cj[q] <= i - 2) ? im[cj[q]] : -2.f; }
                    unsigned mk = 1u | (1u << i) | (1u << (i - 1));
                    for (int rnd = 0; rnd < 13; ++rnd) {
                        float best = -1.f; int bj = 99;
#pragma unroll
                        for (int q = 0; q < 4; ++q) if (cv[q] > best) { best = cv[q]; bj = cj[q]; }
#pragma unroll
                        for (int o = 1; o < 8; o <<= 1) { const float ov = __shfl_xor(best, o); const int oj = __shfl_xor(bj, o); if (ov > best || (ov == best && oj < bj)) { best = ov; bj = oj; } }
                        mk |= 1u << bj;
#pragma unroll
                        for (int q = 0; q < 4; ++q) if (cj[q] == bj) cv[q] = -2.f;
                    }
                    if (sub == 0) msk[tok] = mk;
                }
            } else {
                if (F.tid < 64) msk[F.tid] = (2u << i) - 1u;
            }
            __syncthreads();
            rowmask = msk[C.tokl];
        }
    }
    bf16_t* O = WSP(bf16_t, WS_OCAT); LAS float* ssq = (LAS float*)(F.lds + AT_SSQ);
    LAS bf16_t* stg = (LAS bf16_t*)(F.lds + AT_G) + C.wave * 2048;
#pragma unroll
    for (int r = 0; r < 16; ++r) {
        const int rl = (r & 3) + 8 * (r >> 2) + 4 * C.hi;
        stg[rl * 64 + C.r32] = (bf16_t)(cvt_pk_bf16(of[0][r], 0.f) & 0xffffu); stg[rl * 64 + 32 + C.r32] = (bf16_t)(cvt_pk_bf16(of[1][r], 0.f) & 0xffffu);
        float ss = of[0][r] * of[0][r] + of[1][r] * of[1][r];
        ss += __shfl_xor(ss, 1); ss += __shfl_xor(ss, 2); ss += __shfl_xor(ss, 4); ss += __shfl_xor(ss, 8); ss += __shfl_xor(ss, 16);
        if (C.r32 == 0) ssq[C.g * 64 + 32 * C.th + rl] = ss;
    }
    {
        bf16_t* ob = O + (size_t)(b * T + 64 * i + 32 * C.th + (C.lane >> 3)) * 2048 + h * 64 + (C.lane & 7) * 8;
#pragma unroll
        for (int q = 0; q < 4; ++q) { const u32x4 v = *(const LAS u32x4*)(stg + (q * 8 + (C.lane >> 3)) * 64 + (C.lane & 7) * 8); *(u32x4*)(ob + (size_t)q * 8 * 2048) = v; }
    }
    __syncthreads();
    if (F.tid < 64) WSP(float, WS_OSSN)[(size_t)(b * T + 64 * i + F.tid) * 4 + kvh] = (ssq[F.tid] + ssq[64 + F.tid]) + (ssq[128 + F.tid] + ssq[192 + F.tid]);
}

__device__ __forceinline__ void split_bf16(const float (&v)[8], bf16x8& hi, bf16x8& lo) {
    u32x4 h, l;
    unsigned* hp = (unsigned*)&h; unsigned* lp = (unsigned*)&l;
#pragma unroll
    for (int e = 0; e < 4; ++e) {
        const unsigned pk = cvt_pk_bf16(v[2 * e], v[2 * e + 1]); hp[e] = pk;
        lp[e] = cvt_pk_bf16(v[2 * e] - bflo(pk), v[2 * e + 1] - bfhi(pk));
    }
    hi = __builtin_bit_cast(bf16x8, h); lo = __builtin_bit_cast(bf16x8, l);
}
__device__ __forceinline__ void router_unit(const Frame& F, int un) {
    LAS float* rstd_s = (LAS float*)F.lds;
    LAS float* part = (LAS float*)(F.lds + 1024);
    LAS float* sc_s = (LAS float*)(F.lds + 1024 + 65536);
    LAS float* sb_s = sc_s + 32 * 65;
    LAS int* lcnt = (LAS int*)(sb_s + 32 * 65);
    LAS int* lbase = lcnt + 64;
    const int row0 = un * 32, b = row0 >> 11;
    const float* x1 = F.out; const float* mod = WSP(float, WS_MOD) + b * 6 * D;
    __syncthreads();
    if (F.tid < 64) lcnt[F.tid] = 0;
    {
        f32x4 xv[4][8];
#pragma unroll
        for (int q = 0; q < 4; ++q) { const f32x4* xr = (const f32x4*)(x1 + (size_t)(row0 + F.wave * 4 + q) * D) + F.lane;
#pragma unroll
            for (int j = 0; j < 8; ++j) xv[q][j] = xr[64 * j]; }
#pragma unroll
        for (int q = 0; q < 4; ++q) { float s = 0.f;
#pragma unroll
            for (int j = 0; j < 8; ++j) { const f32x4 v = xv[q][j]; s += (v.x * v.x + v.y * v.y) + (v.z * v.z + v.w * v.w); }
            s = wave_sum(s); if (F.lane == 0) rstd_s[F.wave * 4 + q] = rsqrtf(s * (1.f / D) + EPS); }
    }
    __syncthreads();
    const int r32 = F.lane & 31, hi = F.lane >> 5;
    const float rs = rstd_s[r32];
    f32x16 acc[2]; acc[0] = (f32x16)(0.f); acc[1] = (f32x16)(0.f);
    const float* wr_ = F.in[I_WR];
#pragma unroll 4
    for (int kc = 0; kc < 16; ++kc) {
        const int kk = F.wave * 256 + kc * 16 + 8 * hi;
        float hv[8];
        {
            const f32x4 xa = *(const f32x4*)(x1 + (size_t)(row0 + r32) * D + kk), xb = *(const f32x4*)(x1 + (size_t)(row0 + r32) * D + kk + 4);
            const f32x4 ga = *(const f32x4*)(F.in[I_GN2] + kk), gb = *(const f32x4*)(F.in[I_GN2] + kk + 4);
            const f32x4 sa = *(const f32x4*)(mod + 4 * D + kk), sb2 = *(const f32x4*)(mod + 4 * D + kk + 4);
            const f32x4 ha = *(const f32x4*)(mod + 3 * D + kk), hb = *(const f32x4*)(mod + 3 * D + kk + 4);
            const f32x4 ra = xa * rs * ga * (sa + 1.0f) + ha, rb = xb * rs * gb * (sb2 + 1.0f) + hb;
            hv[0] = ra.x; hv[1] = ra.y; hv[2] = ra.z; hv[3] = ra.w; hv[4] = rb.x; hv[5] = rb.y; hv[6] = rb.z; hv[7] = rb.w;
        }
        bf16x8 ah, al; split_bf16(hv, ah, al);
        { u32x2 h8; h8.x = pk4_fp8(hv[0], hv[1], hv[2], hv[3]); h8.y = pk4_fp8(hv[4], hv[5], hv[6], hv[7]); *(u32x2*)(WSP(unsigned char, WS_H) + (size_t)(row0 + r32) * D + kk) = h8; }
#pragma unroll
        for (int nb = 0; nb < 2; ++nb) {
            float wv[8];
#pragma unroll
            for (int j = 0; j < 8; ++j) wv[j] = wr_[(size_t)(kk + j) * 64 + 32 * nb + r32];
            bf16x8 bh, bl; split_bf16(wv, bh, bl);
            acc[nb] = __builtin_amdgcn_mfma_f32_32x32x16_bf16(ah, bh, acc[nb], 0, 0, 0);
            acc[nb] = __builtin_amdgcn_mfma_f32_32x32x16_bf16(ah, bl, acc[nb], 0, 0, 0);
            acc[nb] = __builtin_amdgcn_mfma_f32_32x32x16_bf16(al, bh, acc[nb], 0, 0, 0);
        }
    }
#pragma unroll
    for (int nb = 0; nb < 2; ++nb)
#pragma unroll
        for (int r = 0; r < 16; ++r) part[(F.wave * 32 + (r & 3) + 8 * (r >> 2) + 4 * hi) * 64 + 32 * nb + r32] = acc[nb][r];
    __syncthreads();
    int eid[8]; int lp[8]; float wk[8];
    const int tok = F.tid >> 4, sub = F.tid & 15;
    {
        const int e4 = sub * 4; f32x4 sacc = (f32x4){0.f, 0.f, 0.f, 0.f};
#pragma unroll
        for (int w = 0; w < 8; ++w) sacc += *(const LAS f32x4*)(part + (w * 32 + tok) * 64 + e4);
        const f32x4 rb = *(const f32x4*)(F.in[I_RB] + e4);
        float s4[4], sb4[4];
#pragma unroll
        for (int v = 0; v < 4; ++v) { s4[v] = 1.0f / (1.0f + expf(-sacc[v])); sb4[v] = s4[v] + rb[v]; }
        float a1 = -3.0e38f, a2 = -3.0e38f;
#pragma unroll
        for (int v = 0; v < 4; ++v) { if (sb4[v] > a1) { a2 = a1; a1 = sb4[v]; } else if (sb4[v] > a2) a2 = sb4[v]; }
        const float b1 = __shfl_xor(a1, 1), b2 = __shfl_xor(a2, 1);
        const float gs = fmaxf(a1, b1) + fmaxf(fminf(a1, b1), fmaxf(a2, b2));
        int rank = 0; const int g = sub >> 1;
#pragma unroll
        for (int gg = 0; gg < 8; ++gg) { const float v = __shfl(gs, (F.lane & ~15) | (2 * gg)); rank += (v > gs || (v == gs && gg < g)) ? 1 : 0; }
        const bool gsel = rank < 4;
        float cv[4];
#pragma unroll
        for (int v = 0; v < 4; ++v) cv[v] = gsel ? sb4[v] : -3.0e38f;
        float wsum = 0.f;
#pragma unroll 1
        for (int k = 0; k < 8; ++k) {
            float best = -3.9e38f; int be = 99; float bs = 0.f;
#pragma unroll
            for (int v = 0; v < 4; ++v) if (cv[v] > best) { best = cv[v]; be = e4 + v; bs = s4[v]; }
#pragma unroll
            for (int o = 1; o < 16; o <<= 1) { const float ov = __shfl_xor(best, o); const int oe = __shfl_xor(be, o); const float os = __shfl_xor(bs, o);
                if (ov > best || (ov == best && oe < be)) { best = ov; be = oe; bs = os; } }
#pragma unroll
            for (int v = 0; v < 4; ++v) if (e4 + v == be) cv[v] = -3.9e38f;
#pragma unroll
            for (int kk = 0; kk < 8; ++kk) if (kk == k) { eid[kk] = be; wk[kk] = bs; }
            wsum += bs;
        }
        const float sc = 2.5f / wsum;
        if (sub == 0) {
#pragma unroll
            for (int k = 0; k < 8; ++k) { wk[k] *= sc; lp[k] = atomicAdd((int*)(lcnt + eid[k]), 1); }
        }
    }
    __syncthreads();
    if (F.tid < 64) { const int c = lcnt[F.tid]; lbase[F.tid] = c ? (int)atomicAdd((unsigned*)(F.ws + WS_CTL) + CW_CNT + F.tid, (unsigned)c) : 0; }
    __syncthreads();
    if (sub == 0) {
        const int row = row0 + tok;
#pragma unroll
        for (int k = 0; k < 8; ++k) { const int pos = lbase[eid[k]] + lp[k];
            WSP(int, WS_EIDX)[row * 8 + k] = eid[k]; WSP(int, WS_POS)[row * 8 + k] = pos; WSP(float, WS_WTS)[row * 8 + k] = wk[k];
            WSP(int, WS_LIST)[eid[k] * 8192 + pos] = row; }
    }
}

__device__ __forceinline__ void phase8(const Frame& F, const LAS int* tb) {
    const int gw = F.vcu * 8 + F.wave, NGW = F.G * 8;
    const unsigned char* PO = WSP(unsigned char, WS_PO);
    for (int row = gw; row < NTOK; row += NGW) {
        const int b = row >> 11;
        size_t pr[9]; float w[9];
#pragma unroll
        for (int k = 0; k < 8; ++k) { const int e = WSP(int, WS_EIDX)[row * 8 + k], pos = WSP(int, WS_POS)[row * 8 + k]; w[k] = WSP(float, WS_WTS)[row * 8 + k] * (1.0f / PO8SCALE); pr[k] = ((size_t)tb[e] * 256 + pos) * 2048; }
        pr[8] = ((size_t)tb[64] * 256 + row) * 2048; w[8] = 1.0f / PO8SCALE;
        const float* gt2 = WSP(float, WS_MOD) + b * 6 * D + 5 * D;
#pragma unroll
        for (int j = 0; j < 2; ++j) {
            const int col = 16 * F.lane + 1024 * j; float a[16];
#pragma unroll
            for (int e = 0; e < 16; ++e) a[e] = 0.f;
#pragma unroll
            for (int k = 0; k < 9; ++k) {
                const u32x4 v = *(const u32x4*)(PO + pr[k] + col);
                const unsigned vv[4] = {v.x, v.y, v.z, v.w};
#pragma unroll
                for (int q = 0; q < 4; ++q) {
                    const f32x2 lo = __builtin_amdgcn_cvt_pk_f32_fp8((int)vv[q], false), hi = __builtin_amdgcn_cvt_pk_f32_fp8((int)vv[q], true);
                    a[4 * q] += w[k] * lo.x; a[4 * q + 1] += w[k] * lo.y; a[4 * q + 2] += w[k] * hi.x; a[4 * q + 3] += w[k] * hi.y;
                }
            }
            float* op = F.out + (size_t)row * D + col;
#pragma unroll
            for (int q = 0; q < 4; ++q) {
                const f32x4 x0 = *(const f32x4*)(op + 4 * q), g0 = *(const f32x4*)(gt2 + col + 4 * q);
                *(f32x4*)(op + 4 * q) = x0 + g0 * (f32x4){a[4 * q], a[4 * q + 1], a[4 * q + 2], a[4 * q + 3]};
            }
        }
    }
}

constexpr int N_PHASES = 11;
__global__ void __launch_bounds__(512, 2) mk_fwd(Params p) {
    extern __shared__ __attribute__((aligned(16))) unsigned char lds_raw[];
    Frame F;
    F.lds = (LAS unsigned char*)lds_raw; F.ws = p.ws; F.in = p.in; F.out = p.out;
    F.tid = threadIdx.x; F.lane = F.tid & 63; F.wave = __builtin_amdgcn_readfirstlane(F.tid >> 6);
    F.G = gridDim.x; { const int bx = blockIdx.x; F.vcu = (F.G % 8 == 0) ? (bx % 8) * (F.G / 8) + bx / 8 : bx; }
    volatile LAS unsigned* MISC = (volatile LAS unsigned*)(F.lds + MISC_OFF);
    if (F.tid < 64) MISC[F.tid] = 0u;
    __syncthreads();
    const int lo = p.ph_lo, hi = p.ph_hi;
    const bool multi = (hi - lo) > 1;
    XcdBarrier bar; bar.bar = (unsigned*)(p.ws + WS_CTL) + CW_BAR; bar.x = 0; bar.st = nullptr;
    if (multi) bar = xcd_barrier_post((unsigned*)(p.ws + WS_CTL) + CW_BAR, MISC + 8);
#ifndef PH_MASK
#define PH_MASK 0xffff
#endif
#define IN(k) (((PH_MASK >> (k)) & 1) && lo <= (k) && (k) < hi)
#define SEAM(k) do { if (IN(k) && IN((k) + 1)) xcd_barrier(bar); } while (0)
#define REP(k) for (int rep_ = 0; rep_ < ((((PROBE_MASK) >> (k)) & 1) ? 2 : 1); ++rep_)
    LAS int* mtab = (LAS int*)(F.lds + LDSX_OFF + 4096);

    if (IN(0)) REP(0) { phase0a(F); SEAM(0); }
    if (IN(1)) REP(1) { phase0b(F); SEAM(1); }
    if (IN(2)) REP(2) {
        const bool split = (F.G == 256);
        if (!split || (int)blockIdx.x < NG_INPROJ) {
            InProjP P; P.A = WSP(bf16_t, WS_H); P.Bt = WSP(bf16_t, WS_WIN_T); P.lda = D; P.G = split ? NG_INPROJ : F.G; P.c = blockIdx.x; P.ws = p.ws; P.gq = p.in[I_GQ]; P.gk = p.in[I_GK];
            pg8::gemm_phase(F.lds, P);
        } else conv_range3(F, CV_EARLY, CV_NT4 - CV_DEFER2, ((int)blockIdx.x - NG_INPROJ) * 8 + F.wave, (256 - NG_INPROJ) * 8);
        SEAM(2);
    }
    if (IN(3) && DUP(3)) {
        {
            CmpP P; P.A = WSP(bf16_t, WS_KV); P.Bt = WSP(bf16_t, WS_WCMP_T); P.lda = 1024; P.G = F.G; P.c = F.vcu; P.ws = p.ws;
            pg8::gemm_phase(F.lds, P);
        }
        if (F.G >= 128) {
            if (F.vcu < 64) gmlp_unit(F, F.vcu);
            else { for (int n = 64 + (F.vcu - 64); n < 512; n += F.G - 64) gmlp_unit(F, n);
                   __syncthreads(); conv_range(F, CV_NT4 - CV_DEFER - CV_DEFER2, CV_NT4 - CV_DEFER, (F.vcu - 64) * 8 + F.wave, (F.G - 64) * 8); }
        } else { for (int n = F.vcu; n < 512; n += F.G) gmlp_unit(F, n); __syncthreads(); conv_range(F, CV_NT4 - CV_DEFER - CV_DEFER2, CV_NT4 - CV_DEFER, F.vcu * 8 + F.wave, F.G * 8); }
        SEAM(3);
    }
    if (IN(3)) {
        {
            CmpP P; P.A = WSP(bf16_t, WS_KV); P.Bt = WSP(bf16_t, WS_WCMP_T); P.lda = 1024; P.G = F.G; P.c = F.vcu; P.ws = p.ws;
            pg8::gemm_phase(F.lds, P);
        }
        if (F.G >= 128) {
            if (F.vcu < 64) gmlp_unit(F, F.vcu);
            else { for (int n = 64 + (F.vcu - 64); n < 512; n += F.G - 64) gmlp_unit(F, n);
                   __syncthreads(); conv_range(F, CV_NT4 - CV_DEFER - CV_DEFER2, CV_NT4 - CV_DEFER, (F.vcu - 64) * 8 + F.wave, (F.G - 64) * 8); }
        } else { for (int n = F.vcu; n < 512; n += F.G) gmlp_unit(F, n); __syncthreads(); conv_range(F, CV_NT4 - CV_DEFER - CV_DEFER2, CV_NT4 - CV_DEFER, F.vcu * 8 + F.wave, F.G * 8); }
        SEAM(3);
    }
    if (IN(4)) REP(4) { phase2b(F); SEAM(4); }
    if (IN(5)) REP(5) {
        for (int n = F.vcu; n < 512; n += F.G) {
            int combo, i; if (n < 256) { combo = n >> 4; i = 31 - (n & 15); } else { combo = (n - 256) >> 4; i = n & 15; }
            attn_unit(F, combo >> 2, combo & 3, i);
        }
        SEAM(5);
    }
    if (IN(6) && DUP(6)) {
        OutProjP P; P.A = WSP(bf16_t, WS_OCAT); P.Bt = WSP(bf16_t, WS_WOUT_T); P.lda = D; P.G = F.G; P.c = blockIdx.x; P.ws = p.ws; P.x = p.in[I_X]; P.out = p.out; P.tab = (LAS f32x2*)(F.lds + LDSX_OFF);
        pg8::gemm_phase(F.lds, P); SEAM(6);
    }
    if (IN(6)) {
        OutProjP P; P.A = WSP(bf16_t, WS_OCAT); P.Bt = WSP(bf16_t, WS_WOUT_T); P.lda = D; P.G = F.G; P.c = blockIdx.x; P.ws = p.ws; P.x = p.in[I_X]; P.out = p.out; P.tab = (LAS f32x2*)(F.lds + LDSX_OFF);
        pg8::gemm_phase(F.lds, P); SEAM(6);
    }
    if (IN(7)) { for (int un = F.vcu; un < 256; un += F.G) router_unit(F, un); SEAM(7); }
    if (IN(8)) REP(8) {
        moe_table(F, mtab);
        { MoeUpP<false> P; P.A = WSP(unsigned char, WS_H); P.Bt = WSP(unsigned char, WS_WGU_T); P.lda = D; P.G = F.G; P.c = F.vcu; P.ws = p.ws; P.tb = mtab; P.c0 = 0; P.idtab = (LAS unsigned*)(F.lds + LDSX_OFF + 10240);
          pg8::gemm_phase(F.lds, P); }
        { MoeUpP<true> P; P.A = WSP(unsigned char, WS_H); P.Bt = WSP(unsigned char, WS_WGU_T); P.lda = D; P.G = F.G; P.c = F.vcu; P.ws = p.ws; P.tb = mtab; P.c0 = (mtab[66] * 4) % F.G; P.idtab = (LAS unsigned*)(F.lds + LDSX_OFF + 10240);
          pg8::gemm_phase(F.lds, P); }
        SEAM(8);
    }
    if (IN(9) && DUP(9)) {
        moe_table(F, mtab);
        { MoeDownP<false> P; P.A = WSP(unsigned char, WS_HID); P.Bt = WSP(unsigned char, WS_WD_T); P.lda = EDIM; P.G = F.G; P.c = F.vcu; P.ws = p.ws; P.tb = mtab; P.c0 = 0;
          pg8::gemm_phase(F.lds, P); }
        { MoeDownP<true> P; P.A = WSP(unsigned char, WS_HID); P.Bt = WSP(unsigned char, WS_WD_T); P.lda = EDIM; P.G = F.G; P.c = F.vcu; P.ws = p.ws; P.tb = mtab; P.c0 = (mtab[66] * 8) % F.G;
          pg8::gemm_phase(F.lds, P); } SEAM(9);
    }
    if (IN(9)) {
        moe_table(F, mtab);
        { MoeDownP<false> P; P.A = WSP(unsigned char, WS_HID); P.Bt = WSP(unsigned char, WS_WD_T); P.lda = EDIM; P.G = F.G; P.c = F.vcu; P.ws = p.ws; P.tb = mtab; P.c0 = 0;
          pg8::gemm_phase(F.lds, P); }
        { MoeDownP<true> P; P.A = WSP(unsigned char, WS_HID); P.Bt = WSP(unsigned char, WS_WD_T); P.lda = EDIM; P.G = F.G; P.c = F.vcu; P.ws = p.ws; P.tb = mtab; P.c0 = (mtab[66] * 8) % F.G;
          pg8::gemm_phase(F.lds, P); } SEAM(9);
    }
    if (IN(10)) { moe_table(F, mtab); phase8(F, mtab); }
#undef IN
#undef SEAM
}

extern "C" void kernel_launch(void* const* d_in, const int* in_sizes, int n_in, void* d_out, int out_size, void* d_ws, size_t ws_size, hipStream_t stream) {
    static int grid = 0;
    if (grid == 0) {
        if (n_in != 29 || out_size != NTOK * D || ws_size < WS_END) { fprintf(stderr, "kernel_launch: unexpected shapes (n_in %d out %d ws %zu)\n", n_in, out_size, ws_size); grid = -1; return; }
        int dev = 0, cus = 0, per_cu = 0;
        hipGetDevice(&dev); hipDeviceGetAttribute(&cus, hipDeviceAttributeMultiprocessorCount, dev);
        if (hipFuncSetAttribute((const void*)mk_fwd, hipFuncAttributeMaxDynamicSharedMemorySize, LDS_BYTES) != hipSuccess) { fprintf(stderr, "kernel_launch: hipFuncSetAttribute failed\n"); grid = -1; return; }
        if (hipOccupancyMaxActiveBlocksPerMultiprocessor(&per_cu, (const void*)mk_fwd, 512, LDS_BYTES) != hipSuccess || per_cu < 1) { fprintf(stderr, "kernel_launch: occupancy query says %d\n", per_cu); per_cu = 1; }
        (void)hipGetLastError();
        grid = cus;
    }
    if (grid < 0) return;
    hipMemsetAsync((char*)d_ws + WS_CTL, 0, CTL_BYTES, stream);
    Params p{};
    for (int i = 0; i < 29; ++i) p.in[i] = (const float*)d_in[i];
    p.out = (float*)d_out; p.ws = (unsigned char*)d_ws;
#if MK_N_LAUNCHES == 1
    p.ph_lo = 0; p.ph_hi = N_PHASES;
    void* args[] = {&p};
    hipError_t e = hipLaunchCooperativeKernel((const void*)mk_fwd, dim3(grid), dim3(512), args, LDS_BYTES, stream);
    if (e != hipSuccess) fprintf(stderr, "kernel_launch: cooperative launch failed: %s (grid %d)\n", hipGetErrorString(e), grid);
#else
    for (int ph = 0; ph < N_PHASES; ++ph) { p.ph_lo = ph; p.ph_hi = ph + 1; hipLaunchKernelGGL(mk_fwd, dim3(grid), dim3(512), LDS_BYTES, stream, p); }
#endif
}
```

```cpp
#include <hip/hip_runtime.h>
#include <hip/hip_cooperative_groups.h>
#include <cstdio>
#include <cstdint>
namespace cg = cooperative_groups;

#ifndef MK_N_LAUNCHES
#define MK_N_LAUNCHES 1
#endif

#ifndef PROBE_MASK
#define PROBE_MASK 0
#endif
#define DUP(k) ((((PROBE_MASK) >> (k)) & 1) != 0)
#define LAS __attribute__((address_space(3)))
#define GAS __attribute__((address_space(1)))
typedef unsigned short bf16_t;
typedef short bf16x8 __attribute__((ext_vector_type(8)));
typedef short s16x4 __attribute__((ext_vector_type(4)));
typedef float f32x4 __attribute__((ext_vector_type(4)));
typedef float f32x2 __attribute__((ext_vector_type(2)));
typedef float f32x16 __attribute__((ext_vector_type(16)));
typedef unsigned u32x4 __attribute__((ext_vector_type(4)));
typedef unsigned u32x2 __attribute__((ext_vector_type(2)));
typedef short v4i16_t __attribute__((ext_vector_type(4)));
typedef int v4i32 __attribute__((ext_vector_type(4)));
typedef int v8i32 __attribute__((ext_vector_type(8)));

constexpr int NB = 4, T = 2048, D = 2048, NTOK = NB * T;
constexpr int NH = 16, KVH = 4, HD = 64;
constexpr int NCMP = 127;
constexpr int NEXP = 64, TOPK = 8, EDIM = 512;
constexpr int IN_COLS = 4656, NIN_T = 19 * 256;
constexpr float EPS = 1e-6f;
constexpr float QSCALE = 0.125f * 1.4426950408889634f;
constexpr float NEGF = -1e30f;
constexpr float W8SCALE = 32.0f, H8SCALE = 4.0f, PO8SCALE = 16.0f;

constexpr size_t MiB = 1u << 20, KiB = 1024;
constexpr size_t WS_CTL = 0, CTL_BYTES = 1 * MiB;
constexpr size_t WS_MOD = 1 * MiB;
constexpr size_t WS_ROPE = 1 * MiB + 256 * KiB;
constexpr size_t WS_BIAS1 = 1 * MiB + 768 * KiB;
constexpr size_t WS_KCMP = 2 * MiB;
constexpr size_t WS_VCMP = 2 * MiB + 256 * KiB;
constexpr size_t WS_OSSN = 2 * MiB + 512 * KiB;
constexpr size_t WS_OSSG = 2 * MiB + 768 * KiB;
constexpr size_t WS_VSS = 3 * MiB + 512 * KiB;
constexpr size_t WS_EIDX = 5 * MiB;
constexpr size_t WS_POS = 5 * MiB + 256 * KiB;
constexpr size_t WS_WTS = 5 * MiB + 512 * KiB;
constexpr size_t WS_LIST = 6 * MiB;
constexpr size_t WS_GATE = 8 * MiB;
constexpr size_t WS_HIDC = 10 * MiB;
constexpr size_t WS_KV = 12 * MiB;
constexpr size_t KV_STRIDE = 4 * MiB;
constexpr size_t WS_Q = 36 * MiB;
constexpr size_t WS_U = 52 * MiB;
constexpr size_t WS_V = 68 * MiB;
constexpr size_t WS_H = 84 * MiB;
constexpr size_t WS_OCAT = 116 * MiB;
constexpr size_t WS_WIN_T = 148 * MiB;
constexpr size_t WS_WOUT_T = 168 * MiB;
constexpr size_t WS_WCMP_T = 176 * MiB;
constexpr size_t WS_WGU_T = 178 * MiB;
constexpr size_t WS_WD_T = 438 * MiB;
constexpr size_t WS_HID = 568 * MiB;
constexpr size_t WS_PO = 656 * MiB;
constexpr size_t WS_END = 1008 * MiB;
constexpr int CW_CNT = 256;
constexpr int CW_BAR = 4096;

constexpr int RING_BYTES = 131072;
constexpr int LDSX_OFF = RING_BYTES;
constexpr int MISC_OFF = RING_BYTES + 12288;
constexpr int LDS_BYTES = 147456;

__device__ __forceinline__ unsigned cvt_pk_bf16(float lo, float hi) { unsigned r; asm volatile("v_cvt_pk_bf16_f32 %0, %1, %2" : "=v"(r) : "v"(lo), "v"(hi)); return r; }
__device__ __forceinline__ unsigned pk4_fp8(float a, float b, float c, float d) { int w = 0; w = __builtin_amdgcn_cvt_pk_fp8_f32(a, b, w, false); w = __builtin_amdgcn_cvt_pk_fp8_f32(c, d, w, true); return (unsigned)w; }
__device__ __forceinline__ float bf2f(unsigned short h) { return __uint_as_float(((unsigned)h) << 16); }
__device__ __forceinline__ float bflo(unsigned w) { return __uint_as_float(w << 16); }
__device__ __forceinline__ float bfhi(unsigned w) { return __uint_as_float(w & 0xffff0000u); }
__device__ __forceinline__ float fexp2(float x) { return __builtin_amdgcn_exp2f(x); }
__device__ __forceinline__ float frcp(float x) { return __builtin_amdgcn_rcpf(x); }
__device__ __forceinline__ float sigmoidf_(float x) { return frcp(1.0f + fexp2(-1.4426950408889634f * x)); }
__device__ __forceinline__ float siluf_(float x) { return x * sigmoidf_(x); }
__device__ __forceinline__ float gelu_tanh(float x) {
    const float u = x * (1.0f + 0.044715f * x * x);
    return x * frcp(1.0f + fexp2(u * (-2.0f * 0.7978845608028654f * 1.4426950408889634f)));
}
__device__ __forceinline__ float wave_sum(float v) {
#pragma unroll
    for (int o = 1; o < 64; o <<= 1) v += __shfl_xor(v, o);
    return v;
}
__device__ __forceinline__ void rope_cs(float pos, int i, float& c, float& s) {
    const float fr = exp2f(-(float)i * (13.287712379549449f / 32.0f));
    const float ang = pos * fr;
    const double rev = (double)ang * 0.15915494309189535;
    const double fr_ = rev - rint(rev);
    const float r = (float)(fr_ * 6.283185307179586);
    c = cosf(r); s = sinf(r);
}

#define XB_TMO      128
#define XB_XCNT(j)  (256  + 64 * (j))
#define XB_XSUB(j)  (1280 + 64 * (j))
#define XB_XGEN(j)  (2304 + 64 * (j))
#define XB_TOP      3328
#define XB_TOPGEN   3392
#define XCD_BAR_WORDS 3456
#define XB_SPIN_CAP (1u << 22)
__device__ __forceinline__ unsigned xb_ld(unsigned* p)              { return __hip_atomic_load(p, __ATOMIC_RELAXED, __HIP_MEMORY_SCOPE_AGENT); }
__device__ __forceinline__ unsigned xb_add(unsigned* p, unsigned v) { return __hip_atomic_fetch_add(p, v, __ATOMIC_RELAXED, __HIP_MEMORY_SCOPE_AGENT); }
__device__ __forceinline__ unsigned xb_xcc_id() { return (unsigned)__builtin_amdgcn_s_getreg((3 << 11) | 20) & 0xFu; }
#define XB_SPIN(cond, bar) do { unsigned _sp = 0; while (cond) { __builtin_amdgcn_s_sleep(1); \
    if ((++_sp & 255u) == 0u) { if (xb_ld(&(bar)[XB_TMO])) break; if (_sp > XB_SPIN_CAP) { atomicAdd(&(bar)[XB_TMO], 1u); break; } } } } while (0)
struct XcdBarrier { unsigned* bar; unsigned x; volatile LAS unsigned* st; };
__device__ __forceinline__ XcdBarrier xcd_barrier_post(unsigned* bar, volatile LAS unsigned* st) {
    XcdBarrier b; b.bar = bar; b.x = xb_xcc_id(); b.st = st;
    if (threadIdx.x == 0) (void)xb_add(&bar[XB_XCNT(b.x)], 1u);
    return b;
}
__device__ __forceinline__ void xcd_barrier_complete(unsigned* bar, unsigned x, unsigned& nloc, unsigned& nx) {
    const unsigned G = gridDim.x * gridDim.y * gridDim.z;
    unsigned sum, cnt, mine, sp = 0u;
    for (;;) {
        sum = 0u; cnt = 0u; mine = 0u;
#pragma unroll
        for (unsigned j = 0; j < 16; ++j) { const unsigned c = xb_ld(&bar[XB_XCNT(j)]); sum += c; cnt += (c > 0u) ? 1u : 0u; mine = (j == x) ? c : mine; }
        if (sum == G) break;
        __builtin_amdgcn_s_sleep(1);
        if ((++sp & 255u) == 0u) { if (xb_ld(&bar[XB_TMO])) break; if (sp > XB_SPIN_CAP) { atomicAdd(&bar[XB_TMO], 1u); break; } }
    }
    nloc = mine > 0u ? mine : 1u; nx = cnt > 0u ? cnt : 1u;
}
__device__ __forceinline__ void xcd_barrier(const XcdBarrier& b) {
    asm volatile("s_waitcnt vmcnt(0)" ::: "memory");
    __syncthreads();
    if (threadIdx.x == 0) {
        unsigned* bar = b.bar;
        __builtin_amdgcn_s_waitcnt(0);
        unsigned nloc = b.st[0], nx = b.st[1];
        if (nloc == 0u) { xcd_barrier_complete(bar, b.x, nloc, nx); b.st[0] = nloc; b.st[1] = nx; }
        const unsigned old = xb_add(&bar[XB_XSUB(b.x)], 1u);
        const unsigned gen = old / nloc;
        if (old + 1u == (gen + 1u) * nloc) {
            __builtin_amdgcn_fence(__ATOMIC_RELEASE, "agent");
            asm volatile("s_waitcnt vmcnt(0)" ::: "memory");
            const unsigned og = xb_add(&bar[XB_TOP], 1u);
            const unsigned tg = og / nx;
            if (og + 1u == (tg + 1u) * nx) xb_add(&bar[XB_TOPGEN], 1u);
            else XB_SPIN(xb_ld(&bar[XB_TOPGEN]) == tg, bar);
            __builtin_amdgcn_fence(__ATOMIC_ACQUIRE, "agent");
            xb_add(&bar[XB_XGEN(b.x)], 1u);
            asm volatile("s_waitcnt vmcnt(0)" ::: "memory");
        } else {
            XB_SPIN(xb_ld(&bar[XB_XGEN(b.x)]) == gen, bar);
            __builtin_amdgcn_fence(__ATOMIC_ACQUIRE, "agent");
            asm volatile("s_waitcnt vmcnt(0)" ::: "memory");
        }
    }
    __syncthreads();
}

struct Params { const float* in[29]; float* out; unsigned char* ws; int ph_lo, ph_hi; };
enum { I_X = 0, I_C, I_WADA, I_BADA, I_GN1, I_WIN, I_GQ, I_GK, I_CPK, I_CPV, I_CW1K, I_CW2K, I_CW1V, I_CW2V, I_GGV, I_WSP, I_BSP, I_GON, I_GOG, I_WOUT, I_GN2,
       I_WR, I_RB, I_WG, I_WU, I_WD, I_SG, I_SU, I_SD };

namespace pg8 {
constexpr int BM = 256, BK = 64, HALF = 128, HTB = HALF * BK * 2, NXCD = 8, WGM = 8;
__device__ __forceinline__ int lds_byte(int r, int c) { const int st = (r >> 4) * 2 + (c >> 5), rr = r & 15, cc = c & 31, ob = rr * 64 + cc * 2; return st * 1024 + (ob ^ (((ob >> 9) & 1) << 5)); }
__device__ __forceinline__ void stage_rc(int b, int& R, int& C) { const int st = b / 1024, sb = b % 1024, swz = sb ^ (((sb >> 9) & 1) << 5); R = (st >> 1) * 16 + swz / 64; C = (st & 1) * 32 + (swz % 64) / 2; }
__device__ __forceinline__ int perm32(int rho) { const int n = rho >> 4, i = rho & 15; return 8 * (i >> 2) + 4 * n + (i & 3); }
struct Unit { int pm, pn, e, aux; };

__device__ __forceinline__ bool dense_next(int i, int G, int c, int nM, int nN, Unit& u) {
    const int nwg = nM * nN; const long L = (long)i * G + c; if (L >= nwg) return false;
    int wgid = (int)L; { const int q = nwg / NXCD, r = nwg % NXCD, xcd = wgid % NXCD, off = wgid / NXCD; wgid = (xcd < r ? xcd * (q + 1) : r * (q + 1) + (xcd - r) * q) + off; }
    const int nig = WGM * nN, gid = wgid / nig, fm = gid * WGM, gsz = (nM - fm) < WGM ? (nM - fm) : WGM;
    u.pm = fm + ((wgid % nig) % gsz); u.pn = (wgid % nig) / gsz; u.e = 0; u.aux = 0; return true;
}

template <class P>
__device__ __forceinline__ void gemm_phase(LAS unsigned char* lds, const P& prm) {
    const int tid = threadIdx.x, wid = __builtin_amdgcn_readfirstlane(tid >> 6), lane = tid & 63, wr = wid >> 2, wc = wid & 3, fr = lane & 15, fq = lane >> 4;
    constexpr int K = P::K, ESZ = P::ESZ, nt = (K * ESZ) / 128;
    const unsigned lda2 = (unsigned)prm.lda * (unsigned)ESZ;
    int Rl[2], Cl[2]; unsigned voffB[2];
#pragma unroll
    for (int i = 0; i < 2; ++i) { int R, C; stage_rc(tid * 16 + i * 8192, R, C); Rl[i] = R; Cl[i] = C; const int Rb = (R & ~31) + perm32(R & 31); voffB[i] = (unsigned)(Rb * P::LDB * ESZ + C * 2); }
    const size_t kstep = (size_t)(BK * 2);
    const size_t hstepB = (size_t)HALF * P::LDB * ESZ;
    const unsigned ldsw = (unsigned)wid * 1024u;
    const int fcol = fq * 8;
    const int aoff = lds_byte(wr * 64 + fr, fcol), boff = lds_byte(wc * 32 + fr, fcol);
    constexpr int fkst = 1024;
#define PG8_SA(b, h) (((b) * 2 + (h)) * HTB)
#define PG8_SB(b, h) ((4 + (b) * 2 + (h)) * HTB)
#define PG8_STAGE(bufoff, gbase, voff) do { _Pragma("unroll") for (int _i = 0; _i < 2; ++_i) \
        __builtin_amdgcn_global_load_lds((const unsigned*)((const char*)(gbase) + (voff)[_i]), (LAS unsigned*)(lds + (bufoff) + ldsw + _i * 8192), 16, 0, 0); } while (0)
#define PG8_LDA(dst, b, h) do { _Pragma("unroll") for (int m = 0; m < 4; ++m) _Pragma("unroll") for (int k = 0; k < 2; ++k) dst[m][k] = *(const LAS bf16x8*)(lds + PG8_SA(b, h) + aoff + m * 2048 + k * fkst); } while (0)
#define PG8_LDB(dst, b, h) do { _Pragma("unroll") for (int n = 0; n < 2; ++n) _Pragma("unroll") for (int k = 0; k < 2; ++k) dst[n][k] = *(const LAS bf16x8*)(lds + PG8_SB(b, h) + boff + n * 2048 + k * fkst); } while (0)
#define PG8_MMA(ai, bj, At, Bt) do { __builtin_amdgcn_s_setprio(1); \
        if constexpr (ESZ == 2) { _Pragma("unroll") for (int m = 0; m < 4; ++m) _Pragma("unroll") for (int n = 0; n < 2; ++n) _Pragma("unroll") for (int k = 0; k < 2; ++k) \
            acc[ai][bj][m][n] = __builtin_amdgcn_mfma_f32_16x16x32_bf16(Bt[n][k], At[m][k], acc[ai][bj][m][n], 0, 0, 0); } \
        else { _Pragma("unroll") for (int m = 0; m < 4; ++m) _Pragma("unroll") for (int n = 0; n < 2; ++n) { \
            const v8i32 a8_ = __builtin_shufflevector(__builtin_bit_cast(v4i32, At[m][0]), __builtin_bit_cast(v4i32, At[m][1]), 0, 1, 2, 3, 4, 5, 6, 7); \
            const v8i32 b8_ = __builtin_shufflevector(__builtin_bit_cast(v4i32, Bt[n][0]), __builtin_bit_cast(v4i32, Bt[n][1]), 0, 1, 2, 3, 4, 5, 6, 7); \
            acc[ai][bj][m][n] = __builtin_amdgcn_mfma_scale_f32_16x16x128_f8f6f4(b8_, a8_, acc[ai][bj][m][n], 0, 0, 0, 0x7f7f7f7f, 0, 0x7f7f7f7f); } } \
        __builtin_amdgcn_s_setprio(0); } while (0)
#define PG8_WAIT_V(n) asm volatile("s_waitcnt vmcnt(" #n ")" ::: "memory")
#define PG8_WAIT_L(n) asm volatile("s_waitcnt lgkmcnt(" #n ")" ::: "memory")
#define PG8_WAIT_VK() do { if constexpr (P::HALFONLY) asm volatile("s_waitcnt vmcnt(6)" ::: "memory"); else asm volatile("s_waitcnt vmcnt(8)" ::: "memory"); } while (0)
#define PG8_BAR __builtin_amdgcn_s_barrier()
#define PG8_SCHED __builtin_amdgcn_sched_barrier(0)
    Unit cur, nxt; int ui = 0;
    if (!prm.next(0, cur)) return;
    f32x4 acc[2][2][4][2];
#pragma unroll
    for (int a = 0; a < 2; ++a)
#pragma unroll
        for (int b = 0; b < 2; ++b)
#pragma unroll
            for (int m = 0; m < 4; ++m)
#pragma unroll
                for (int n = 0; n < 2; ++n) acc[a][b][m][n] = (f32x4){0.f, 0.f, 0.f, 0.f};
    bf16x8 At[4][2], B0[2][2], B1[2][2];
    const char* Ab = (const char*)prm.A;
    unsigned offA0[2], offA1[2];
#pragma unroll
    for (int i = 0; i < 2; ++i) { offA0[i] = prm.row_id(cur, Rl[i]) * lda2 + (unsigned)Cl[i] * 2u + prm.a_koff(cur); offA1[i] = prm.row_id(cur, Rl[i] + HALF) * lda2 + (unsigned)Cl[i] * 2u + prm.a_koff(cur); }
    const char* cB = prm.b_base(cur);
    PG8_STAGE(PG8_SB(0, 0), cB, voffB); PG8_STAGE(PG8_SB(0, 1), cB + hstepB, voffB); PG8_STAGE(PG8_SA(0, 0), Ab, offA0); if constexpr (!P::HALFONLY) PG8_STAGE(PG8_SA(0, 1), Ab, offA1);
    if (wr == 1) PG8_BAR;
    if constexpr (P::HALFONLY) PG8_WAIT_V(0); else PG8_WAIT_V(2);
    PG8_BAR;
    PG8_STAGE(PG8_SB(1, 0), cB + kstep, voffB); PG8_STAGE(PG8_SA(1, 0), Ab + kstep, offA0); PG8_STAGE(PG8_SB(1, 1), cB + hstepB + kstep, voffB);
    PG8_WAIT_V(6); PG8_BAR;
    for (;;) {
        const bool has_next = prm.next(ui + 1, nxt);
        const char* nB = has_next ? prm.b_base(nxt) : cB;
        prm.unit_begin(cur, ui);
        unsigned idn[4] = {0u, 0u, 0u, 0u};
#pragma unroll 1
        for (int t = 0; t < nt; t += 2) {
            const bool last = (t == nt - 2);
            if (t == nt - 4 && has_next) {
                if constexpr (P::IDLDS) prm.ids_prefetch(nxt, wid, lane);
                else {
#pragma unroll
                    for (int i = 0; i < 2; ++i) { idn[i] = prm.row_id(nxt, Rl[i]); idn[2 + i] = prm.row_id(nxt, Rl[i] + HALF); }
                }
            }
            const char* a1 = Ab + (size_t)(t + 1) * kstep;
            const char* a2 = last ? Ab : Ab + (size_t)(t + 2) * kstep; const char* b2 = last ? nB : cB + (size_t)(t + 2) * kstep;
            const char* a3 = a2 + kstep; const char* b3 = b2 + kstep;
            if constexpr (P::MIDK) { if (t == nt / 2) prm.midk(acc, cur, ui, wr, fr); }
            PG8_LDB(B0, 0, 0); PG8_LDB(B1, 0, 1); PG8_SCHED; PG8_LDA(At, 0, 0); if constexpr (!P::HALFONLY) PG8_STAGE(PG8_SA(1, 1), a1, offA1);
            if (last && has_next) {
                if constexpr (P::IDLDS) {
#pragma unroll
                    for (int i = 0; i < 2; ++i) { idn[i] = prm.ids_read(nxt, Rl[i]); idn[2 + i] = prm.ids_read(nxt, Rl[i] + HALF); }
                }
#pragma unroll
                for (int i = 0; i < 2; ++i) { offA0[i] = idn[i] * lda2 + (unsigned)Cl[i] * 2u + prm.a_koff(nxt); offA1[i] = idn[2 + i] * lda2 + (unsigned)Cl[i] * 2u + prm.a_koff(nxt); }
            }
            PG8_WAIT_VK(); PG8_WAIT_L(0); PG8_BAR; PG8_MMA(0, 0, At, B0); PG8_MMA(0, 1, At, B1); PG8_BAR; PG8_SCHED;
            if constexpr (!P::HALFONLY) PG8_LDA(At, 0, 1); PG8_STAGE(PG8_SB(0, 0), b2, voffB); PG8_STAGE(PG8_SB(0, 1), b2 + hstepB, voffB); PG8_STAGE(PG8_SA(0, 0), a2, offA0);
            PG8_WAIT_VK(); PG8_WAIT_L(0); PG8_BAR; if constexpr (!P::HALFONLY) { PG8_MMA(1, 0, At, B0); PG8_MMA(1, 1, At, B1); } PG8_BAR; PG8_SCHED;
            PG8_LDB(B0, 1, 0); PG8_LDB(B1, 1, 1); PG8_SCHED; PG8_LDA(At, 1, 0); if constexpr (!P::HALFONLY) PG8_STAGE(PG8_SA(0, 1), a2, offA1);
            PG8_WAIT_VK(); PG8_WAIT_L(0); PG8_BAR; PG8_MMA(0, 0, At, B0); PG8_MMA(0, 1, At, B1); PG8_BAR; PG8_SCHED;
            if constexpr (!P::HALFONLY) PG8_LDA(At, 1, 1); PG8_STAGE(PG8_SB(1, 0), b3, voffB); PG8_STAGE(PG8_SB(1, 1), b3 + hstepB, voffB); PG8_STAGE(PG8_SA(1, 0), a3, offA0);
            PG8_WAIT_VK(); PG8_WAIT_L(0); PG8_BAR; if constexpr (!P::HALFONLY) { PG8_MMA(1, 0, At, B0); PG8_MMA(1, 1, At, B1); } PG8_BAR; PG8_SCHED;
        }
        if (wr == 0) PG8_BAR;
        prm.epi(acc, cur, ui, wr, wc, fr, fq);
        if (DUP(16)) { asm volatile("" ::: "memory"); prm.epi(acc, cur, ui, wr, wc, fr, fq); }
        if (!has_next) break;
#pragma unroll
        for (int a = 0; a < 2; ++a)
#pragma unroll
            for (int b = 0; b < 2; ++b)
#pragma unroll
                for (int m = 0; m < 4; ++m)
#pragma unroll
                    for (int n = 0; n < 2; ++n) acc[a][b][m][n] = (f32x4){0.f, 0.f, 0.f, 0.f};
        cur = nxt; cB = nB; ++ui;
        if (wr == 1) PG8_BAR;
    }
    PG8_WAIT_V(0);
    PG8_BAR;
#undef PG8_SA
#undef PG8_SB
#undef PG8_STAGE
#undef PG8_LDA
#undef PG8_LDB
#undef PG8_MMA
#undef PG8_WAIT_V
#undef PG8_WAIT_L
#undef PG8_WAIT_VK
#undef PG8_BAR
#undef PG8_SCHED
}
}
using pg8::Unit;
typedef f32x4 Acc[2][2][4][2];

struct Frame {
    LAS unsigned char* lds;
    unsigned char* ws;
    const float* const* in;
    float* out;
    int tid, lane, wave, G, vcu;
};
#define WSP(T_, off) ((T_*)(F.ws + (off)))

struct ConvItem { const float* src; int ldn; int k0; int n0; bf16_t* dst; int Kd; int drow0; int mode; int nvalid; int fp8; const float* rs0; const float* rs1; };
constexpr int CV_WIN = 16 * 38, CV_WOUT = 256, CV_CMP = 64, CV_GU = 65 * 128, CV_DN = 65 * 64;
constexpr int CV_TOTAL = CV_WIN + CV_WOUT + CV_CMP + CV_GU + CV_DN;
__device__ __forceinline__ void conv_decode(const Frame& F, int it, ConvItem& c) {
    c.mode = 0; c.nvalid = 128; c.fp8 = 0; c.rs0 = nullptr; c.rs1 = nullptr;
    if (it < CV_WIN) {
        const int kb = it / 38, nb = it % 38; c.src = F.in[I_WIN]; c.ldn = IN_COLS; c.k0 = kb * 128; c.dst = WSP(bf16_t, WS_WIN_T); c.Kd = 2048;
        if (nb < 20) { c.n0 = nb * 128; c.drow0 = (nb >> 1) * 256; c.mode = 1 + (nb & 1); }
        else if (nb < 28) { c.n0 = 2608 + (nb - 20) * 128; c.drow0 = 2560 + (nb - 20) * 128; }
        else if (nb < 36) { c.n0 = 3632 + (nb - 28) * 128; c.drow0 = 3584 + (nb - 28) * 128; }
        else if (nb == 36) { c.n0 = 2560; c.drow0 = 4608; c.nvalid = 48; }
        else { c.n0 = 2560; c.drow0 = 4736; c.nvalid = 0; }
        return;
    }
    it -= CV_WIN;
    if (it < CV_WOUT) { const int kb = it / 16, nb = it % 16; c.src = F.in[I_WOUT]; c.ldn = 2048; c.k0 = kb * 128; c.n0 = nb * 128; c.dst = WSP(bf16_t, WS_WOUT_T); c.Kd = 2048; c.drow0 = nb * 128;
        c.rs0 = F.in[I_GON]; c.rs1 = F.in[I_GOG]; return; }
    it -= CV_WOUT;
    if (it < CV_CMP) { const int kv = it / 32, r = it % 32, kb = r / 2, nb = r % 2; c.src = F.in[kv ? I_CW1V : I_CW1K]; c.ldn = 256; c.k0 = kb * 128; c.n0 = nb * 128;
        c.dst = WSP(bf16_t, WS_WCMP_T) + (size_t)kv * 256 * 2048; c.Kd = 2048; c.drow0 = nb * 128; return; }
    it -= CV_CMP;
    if (it < CV_GU) { const int e = it / 128, r = it % 128, up = r / 64, kb = (r % 64) / 4, nb = r % 4;
        c.src = (e < 64) ? F.in[up ? I_WU : I_WG] + (size_t)e * 2048 * 512 : F.in[up ? I_SU : I_SG];
        c.ldn = 512; c.k0 = kb * 128; c.n0 = nb * 128; c.dst = (bf16_t*)(WSP(unsigned char, WS_WGU_T) + (size_t)e * 1024 * 2048); c.Kd = 2048; c.drow0 = nb * 256 + up * 128; c.fp8 = 1; return; }
    it -= CV_GU;
    { const int e = it / 64, r = it % 64, kb = r / 16, nb = r % 16;
      c.src = (e < 64) ? F.in[I_WD] + (size_t)e * 512 * 2048 : F.in[I_SD];
      c.ldn = 2048; c.k0 = kb * 128; c.n0 = nb * 128; c.dst = (bf16_t*)(WSP(unsigned char, WS_WD_T) + (size_t)e * 2048 * 512); c.Kd = 512; c.drow0 = nb * 128; c.fp8 = 1; c.mode = 3; }
}
__device__ __forceinline__ void conv_load(const ConvItem& c, int sub, int lane, f32x4 (&v)[16]) {
    const int n4 = lane & 15, kq = lane >> 4, nl = 64 * (sub & 1) + 4 * n4;
    const bool ok = nl < c.nvalid;
    if (c.fp8) {
        const float* s = c.src + (size_t)(c.k0 + 64 * (sub >> 1) + 4 * kq) * c.ldn + c.n0 + nl;
#pragma unroll
        for (int i = 0; i < 4; ++i)
#pragma unroll
            for (int j = 0; j < 4; ++j) v[4 * i + j] = __builtin_nontemporal_load((const f32x4*)(s + (size_t)(16 * i + j) * c.ldn));
        return;
    }
    const float* s = c.src + (size_t)(c.k0 + 64 * (sub >> 1) + 2 * kq) * c.ldn + c.n0 + nl;
#pragma unroll
    for (int i = 0; i < 8; ++i) {
        v[2 * i] = ok ? __builtin_nontemporal_load((const f32x4*)(s + (size_t)(8 * i) * c.ldn)) : (f32x4){0.f, 0.f, 0.f, 0.f};
        v[2 * i + 1] = ok ? __builtin_nontemporal_load((const f32x4*)(s + (size_t)(8 * i + 1) * c.ldn)) : (f32x4){0.f, 0.f, 0.f, 0.f};
    }
}
__device__ __forceinline__ void conv_process(const ConvItem& c, int sub, int lane, const f32x4 (&v)[16], LAS unsigned* tile) {
    const int n4 = lane & 15, kq = lane >> 4, kb = c.k0 + 64 * (sub >> 1);
    if (c.fp8) {
#pragma unroll
        for (int i = 0; i < 4; ++i)
#pragma unroll
            for (int cc = 0; cc < 4; ++cc) tile[(4 * n4 + cc) * 129 + 4 * i + kq] = pk4_fp8(v[4 * i][cc] * W8SCALE, v[4 * i + 1][cc] * W8SCALE, v[4 * i + 2][cc] * W8SCALE, v[4 * i + 3][cc] * W8SCALE);
        return;
    }
#pragma unroll
    for (int i = 0; i < 8; ++i) {
        float s0 = 1.f, s1 = 1.f;
        if (c.rs0) { const int k = kb + 8 * i + 2 * kq; s0 = (k < 1024) ? c.rs0[k] : c.rs1[k - 1024]; s1 = (k + 1 < 1024) ? c.rs0[k + 1] : c.rs1[k + 1 - 1024]; }
#pragma unroll
        for (int cc = 0; cc < 4; ++cc) tile[(4 * n4 + cc) * 33 + 4 * i + kq] = cvt_pk_bf16(v[2 * i][cc] * s0, v[2 * i + 1][cc] * s1);
    }
#pragma unroll
    for (int j = 0; j < 8; ++j) {
        const int row = (lane >> 3) + 8 * j, c8 = lane & 7;
        const LAS unsigned* sp = tile + row * 33 + 4 * c8;
        u32x4 o; o.x = sp[0]; o.y = sp[1]; o.z = sp[2]; o.w = sp[3];
        const int n = 64 * (sub & 1) + row;
        int drow = c.drow0 + n;
        if (c.mode) { const int l = (c.mode - 1) * 128 + n, wc = l >> 6, bj = (l >> 5) & 1, jj = l & 31; drow = c.drow0 + 128 * bj + 32 * wc + jj; }
        __builtin_nontemporal_store(o, (u32x4*)(c.dst + (size_t)drow * c.Kd + kb + 8 * c8));
    }
}
template <int R>
__device__ __forceinline__ void gemv_item(const Frame& F, const LAS float* a_lds, LAS float* red, const float* W, int ldn, int n0, const float* bias, float* out, int ldo) {
    const int ks = F.tid >> 4, c4 = F.tid & 15;
    float acc[R][4];
#pragma unroll
    for (int r = 0; r < R; ++r) { acc[r][0] = 0.f; acc[r][1] = 0.f; acc[r][2] = 0.f; acc[r][3] = 0.f; }
    const float* wp = W + (size_t)(ks * 64) * ldn + n0 + 4 * c4;
#pragma unroll 16
    for (int kk = 0; kk < 64; ++kk) {
        const f32x4 w = *(const f32x4*)(wp + (size_t)kk * ldn);
#pragma unroll
        for (int r = 0; r < R; ++r) { const float a = a_lds[r * 2048 + ks * 64 + kk]; acc[r][0] += a * w.x; acc[r][1] += a * w.y; acc[r][2] += a * w.z; acc[r][3] += a * w.w; }
    }
#pragma unroll
    for (int r = 0; r < R; ++r) *(LAS f32x4*)(red + (ks * R + r) * 64 + 4 * c4) = (f32x4){acc[r][0], acc[r][1], acc[r][2], acc[r][3]};
    __syncthreads();
    if (F.tid < R * 64) {
        const int r = F.tid >> 6, n = F.tid & 63; float s = bias ? bias[n0 + n] : 0.f;
        for (int k = 0; k < 32; ++k) s += red[(k * R + r) * 64 + n];
        out[(size_t)r * ldo + n0 + n] = s;
    }
    __syncthreads();
}
constexpr int CV_NT4 = CV_TOTAL * 4;
constexpr int CV_DEFER = 0;
constexpr int CV_EARLY = 76 * 32;
constexpr int CV_EARLY_ALL = 76 * 32 + 32 * 32 + 2 * 4 * 32;
constexpr int NG_INPROJ = 132;
constexpr int CV_DEFER2 = 0;
__device__ __forceinline__ void tile_decode(int T, int& item, int& sub) {
    constexpr int T_WIN = 76 * 32, T_WOUT = 32 * 32, T_CMP = 2 * 4 * 32, T_GU = 65 * 2 * 8 * 32;
    int kb, nb;
    if (T < T_WIN) { kb = T & 31; nb = T >> 5; item = (kb >> 1) * 38 + (nb >> 1); }
    else if ((T -= T_WIN) < T_WOUT) { kb = T & 31; nb = T >> 5; item = CV_WIN + (kb >> 1) * 16 + (nb >> 1); }
    else if ((T -= T_WOUT) < T_CMP) { kb = T & 31; nb = (T >> 5) & 3; const int kv = T >> 7; item = CV_WIN + CV_WOUT + kv * 32 + (kb >> 1) * 2 + (nb >> 1); }
    else if ((T -= T_CMP) < T_GU) { kb = T & 31; nb = (T >> 5) & 7; const int eu = T >> 8; item = CV_WIN + CV_WOUT + CV_CMP + eu * 64 + (kb >> 1) * 4 + (nb >> 1); }
    else { T -= T_GU; kb = T & 7; nb = (T >> 3) & 31; const int e = T >> 8; item = CV_WIN + CV_WOUT + CV_CMP + CV_GU + e * 64 + (kb >> 1) * 16 + (nb >> 1); }
    sub = ((kb & 1) << 1) | (nb & 1);
}
__device__ __forceinline__ void conv_coop_store(const ConvItem& c0, int s0, int tid, const LAS unsigned* img) {
    unsigned char* d8 = (unsigned char*)c0.dst; const int kbase = c0.k0 + 64 * (s0 >> 1);
#pragma unroll
    for (int q = 0; q < 4; ++q) {
        const int ch = tid + 512 * q, row = ch >> 5, c16 = ch & 31;
        const LAS unsigned* sp = img + row * 129 + 4 * c16;
        u32x4 o; o.x = sp[0]; o.y = sp[1]; o.z = sp[2]; o.w = sp[3];
        int drow = c0.drow0 + 64 * (s0 & 1) + row;
        if (c0.mode == 3) { const int L = drow & 255; drow = (drow & ~255) + 128 * ((L >> 3) & 1) + 32 * (L >> 6) + 8 * ((L >> 4) & 3) + (L & 7); }
        __builtin_nontemporal_store(o, (u32x4*)(d8 + (size_t)drow * c0.Kd + kbase + 16 * c16));
    }
}
__device__ __forceinline__ void conv_range(const Frame& F, int t0, int t1, int wid, int nw) {
    LAS unsigned* tile = (LAS unsigned*)F.lds + F.wave * (64 * 33);
    LAS unsigned* img0 = (LAS unsigned*)(F.lds + 67584);
    int ta = t0 + wid; const int te = t1; int par = 0;
    ConvItem ca, cb, c0; f32x4 va[16], vb[16]; int ia, sa, ib, sb, i0, s0;
    if (ta < te) { tile_decode(ta, ia, sa); conv_decode(F, ia, ca); conv_load(ca, sa, F.lane, va); }
    while (ta < te) {
        const int tb = ta + nw;
        if (tb < te) { tile_decode(tb, ib, sb); conv_decode(F, ib, cb); conv_load(cb, sb, F.lane, vb); }
        if (ca.fp8) {
            LAS unsigned* img = img0 + par * (64 * 129);
            conv_process(ca, sa, F.lane, va, img + 16 * F.wave);
            __syncthreads();
            tile_decode(ta - F.wave, i0, s0); conv_decode(F, i0, c0); conv_coop_store(c0, s0, F.tid, img); par ^= 1;
        } else conv_process(ca, sa, F.lane, va, tile);
        if (tb >= te) break;
        ta = tb + nw;
        if (ta < te) { tile_decode(ta, ia, sa); conv_decode(F, ia, ca); conv_load(ca, sa, F.lane, va); }
        if (cb.fp8) {
            LAS unsigned* img = img0 + par * (64 * 129);
            conv_process(cb, sb, F.lane, vb, img + 16 * F.wave);
            __syncthreads();
            tile_decode(tb - F.wave, i0, s0); conv_decode(F, i0, c0); conv_coop_store(c0, s0, F.tid, img); par ^= 1;
        } else conv_process(cb, sb, F.lane, vb, tile);
    }
}
__device__ __forceinline__ void conv_process8_wave(const ConvItem& c, int sub, int lane, const f32x4 (&v)[16], LAS unsigned* tile) {
    const int n4 = lane & 15, kq = lane >> 4, kb = c.k0 + 64 * (sub >> 1);
#pragma unroll
    for (int i = 0; i < 4; ++i)
#pragma unroll
        for (int cc = 0; cc < 4; ++cc) tile[(4 * n4 + cc) * 17 + 4 * i + kq] = pk4_fp8(v[4 * i][cc] * W8SCALE, v[4 * i + 1][cc] * W8SCALE, v[4 * i + 2][cc] * W8SCALE, v[4 * i + 3][cc] * W8SCALE);
    unsigned char* d8 = (unsigned char*)c.dst;
#pragma unroll
    for (int j = 0; j < 4; ++j) {
        const int row = (lane >> 2) + 16 * j, c4 = lane & 3;
        const LAS unsigned* sp = tile + row * 17 + 4 * c4;
        u32x4 o; o.x = sp[0]; o.y = sp[1]; o.z = sp[2]; o.w = sp[3];
        int drow = c.drow0 + 64 * (sub & 1) + row;
        if (c.mode == 3) { const int L = drow & 255; drow = (drow & ~255) + 128 * ((L >> 3) & 1) + 32 * (L >> 6) + 8 * ((L >> 4) & 3) + (L & 7); }
        __builtin_nontemporal_store(o, (u32x4*)(d8 + (size_t)drow * c.Kd + kb + 16 * c4));
    }
}
__device__ __forceinline__ void conv_step(const Frame& F, const ConvItem& c, int sid, const f32x4 (&v)[16], int tcur, LAS unsigned* tile, LAS unsigned* img0, int& par) {
    if (c.fp8) { conv_process8_wave(c, sid, F.lane, v, tile);
    } else conv_process(c, sid, F.lane, v, tile);
}
__device__ __forceinline__ void conv_range3(const Frame& F, int t0, int t1, int wid, int nw) {
    LAS unsigned* tile = (LAS unsigned*)F.lds + F.wave * (64 * 33);
    LAS unsigned* img0 = (LAS unsigned*)(F.lds + 67584);
    int par = 0; const int te = t1;
    ConvItem ca, cb, cc; f32x4 va[16], vb[16], vc[16]; int ia, sa, ib, sb, ic, sc;
    int ta = t0 + wid, tb = ta + nw, tc = tb + nw;
    if (ta < te) { tile_decode(ta, ia, sa); conv_decode(F, ia, ca); conv_load(ca, sa, F.lane, va); }
    if (tb < te) { tile_decode(tb, ib, sb); conv_decode(F, ib, cb); conv_load(cb, sb, F.lane, vb); }
    while (ta < te) {
        if (tc < te) { tile_decode(tc, ic, sc); conv_decode(F, ic, cc); conv_load(cc, sc, F.lane, vc); }
        conv_step(F, ca, sa, va, ta, tile, img0, par);
        ta = tc + nw;
        if (tb >= te) break;
        if (ta < te) { tile_decode(ta, ia, sa); conv_decode(F, ia, ca); conv_load(ca, sa, F.lane, va); }
        conv_step(F, cb, sb, vb, tb, tile, img0, par);
        tb = ta + nw;
        if (tc >= te) break;
        if (tb < te) { tile_decode(tb, ib, sb); conv_decode(F, ib, cb); conv_load(cb, sb, F.lane, vb); }
        conv_step(F, cc, sc, vc, tc, tile, img0, par);
        tc = tb + nw;
    }
}
__device__ __forceinline__ void phase0a(const Frame& F) {
    LAS float* a_lds = (LAS float*)F.lds;
    LAS float* red = (LAS float*)(F.lds + 32768);
    for (int it = F.vcu; it < 200; it += F.G) {
        if (it < 192) {
            for (int i = F.tid; i < 4 * 2048; i += 512) a_lds[i] = siluf_(F.in[I_C][i]);
            __syncthreads();
            gemv_item<4>(F, a_lds, red, F.in[I_WADA], 6 * D, it * 64, F.in[I_BADA], WSP(float, WS_MOD), 6 * D);
        } else {
            const int kv = (it - 192) >> 2, nb = (it - 192) & 3;
            for (int i = F.tid; i < 2048; i += 512) a_lds[i] = F.in[kv ? I_CPV : I_CPK][i];
            __syncthreads();
            gemv_item<1>(F, a_lds, red, F.in[kv ? I_CW1V : I_CW1K], 256, nb * 64, nullptr, WSP(float, WS_BIAS1) + kv * 256, 256);
        }
    }
    for (int it = F.vcu; it < 128; it += F.G) {
        const int idx = it * 512 + F.tid, pos = idx >> 5, i = idx & 31; float c, s; rope_cs((float)pos, i, c, s);
        WSP(float, WS_ROPE)[idx] = c; WSP(float, WS_ROPE)[65536 + idx] = s;
    }
    __syncthreads();
    if (F.G == 256) {
        constexpr int HEAD = 56 * 8 * 3;
        if (F.vcu >= 200) conv_range(F, 0, HEAD, (F.vcu - 200) * 8 + F.wave, 56 * 8);
        conv_range(F, HEAD, CV_EARLY, F.vcu * 8 + F.wave, F.G * 8);
    }
    else conv_range(F, 0, CV_NT4 - CV_DEFER2, F.vcu * 8 + F.wave, F.G * 8);
}

__device__ __forceinline__ void phase0b(const Frame& F) {
    const int gw = F.vcu * 8 + F.wave, NGW = F.G * 8;
    const float* mod = WSP(float, WS_MOD);
    for (int r0 = gw * 4; r0 < NTOK; r0 += NGW * 4) {
        const int b = r0 >> 11;
        f32x4 ga[8], sh[8];
#pragma unroll
        for (int j = 0; j < 8; ++j) { const int k = 4 * F.lane + 256 * j;
            ga[j] = *(const f32x4*)(F.in[I_GN1] + k) * (*(const f32x4*)(mod + b * 6 * D + D + k) + 1.0f); sh[j] = *(const f32x4*)(mod + b * 6 * D + k); }
#pragma unroll 1
        for (int hf = 0; hf < 2; ++hf) {
            f32x4 v[2][8];
#pragma unroll
            for (int q = 0; q < 2; ++q) { const f32x4* xr = (const f32x4*)(F.in[I_X] + (size_t)(r0 + 2 * hf + q) * D) + F.lane;
#pragma unroll
                for (int j = 0; j < 8; ++j) v[q][j] = xr[64 * j]; }
#pragma unroll
            for (int q = 0; q < 2; ++q) {
                float s = 0.f;
#pragma unroll
                for (int j = 0; j < 8; ++j) s += (v[q][j].x * v[q][j].x + v[q][j].y * v[q][j].y) + (v[q][j].z * v[q][j].z + v[q][j].w * v[q][j].w);
                const float rstd = rsqrtf(wave_sum(s) * (1.f / D) + EPS);
                u32x2* o = (u32x2*)(WSP(bf16_t, WS_H) + (size_t)(r0 + 2 * hf + q) * D) + F.lane;
#pragma unroll
                for (int j = 0; j < 8; ++j) { const f32x4 h = v[q][j] * rstd * ga[j] + sh[j]; u32x2 w; w.x = cvt_pk_bf16(h.x, h.y); w.y = cvt_pk_bf16(h.z, h.w); o[64 * j] = w; }
            }
        }
    }
}

struct InProjP {
    static constexpr int K = 2048, ESZ = 2, LDB = 2048; static constexpr bool IDLDS = false; static constexpr bool HALFONLY = false; static constexpr bool MIDK = false;
    const bf16_t* A; const bf16_t* Bt; int lda; int G, c;
    unsigned char* ws; const float* gq; const float* gk;
    __device__ __forceinline__ bool next(int i, Unit& u) const { return pg8::dense_next(i, G, c, 32, 19, u); }
    __device__ __forceinline__ unsigned row_id(const Unit& u, int r) const { return (unsigned)(u.pm * 256 + r); }
    __device__ __forceinline__ const char* b_base(const Unit& u) const { return (const char*)(Bt + (size_t)u.pn * 256 * K); }
    __device__ __forceinline__ void unit_begin(const Unit&, int) const {}
    __device__ __forceinline__ unsigned a_koff(const Unit&) const { return 0u; }
    __device__ __forceinline__ void midk(Acc&, const Unit&, int, int, int) const {}
    __device__ __forceinline__ void epi(const Acc& acc, const Unit& u, int ui, int wr, int wc, int fr, int fq) const {
        const int pn = u.pn;
        if (pn < 10) {
            const bool donorm = (pn < 4) || pn == 6 || pn == 8;
            const float* g = (pn < 4) ? gq : gk;
            float glo[8], ghi[8];
#pragma unroll
            for (int j = 0; j < 8; ++j) { glo[j] = g[8 * fq + j]; ghi[j] = g[32 + 8 * fq + j]; }
            const float qs = (pn < 4) ? QSCALE : 1.0f;
            const float* cosT = (const float*)(ws + WS_ROPE); const float* sinT = cosT + 65536;
#pragma unroll
            for (int ai = 0; ai < 2; ++ai)
#pragma unroll
                for (int m = 0; m < 4; ++m) {
                    const int row = u.pm * 256 + ai * 128 + wr * 64 + m * 16 + fr, b = row >> 11, t = row & 2047;
                    float lo[8], hi[8];
#pragma unroll
                    for (int n = 0; n < 2; ++n)
#pragma unroll
                        for (int v = 0; v < 4; ++v) { lo[4 * n + v] = acc[ai][0][m][n][v]; hi[4 * n + v] = acc[ai][1][m][n][v]; }
                    if (donorm) {
                        float ss = 0.f;
#pragma unroll
                        for (int j = 0; j < 8; ++j) ss += lo[j] * lo[j] + hi[j] * hi[j];
                        ss += __shfl_xor(ss, 16); ss += __shfl_xor(ss, 32);
                        const float rstd = rsqrtf(ss * (1.f / 64.f) + EPS) * qs;
                        const f32x4 c0 = *(const f32x4*)(cosT + t * 32 + 8 * fq), c1 = *(const f32x4*)(cosT + t * 32 + 8 * fq + 4);
                        const f32x4 s0 = *(const f32x4*)(sinT + t * 32 + 8 * fq), s1 = *(const f32x4*)(sinT + t * 32 + 8 * fq + 4);
#pragma unroll
                        for (int j = 0; j < 8; ++j) {
                            const float cc = j < 4 ? c0[j & 3] : c1[j & 3], sn = j < 4 ? s0[j & 3] : s1[j & 3];
                            const float yl = lo[j] * rstd * glo[j], yh = hi[j] * rstd * ghi[j];
                            lo[j] = yl * cc - yh * sn; hi[j] = yh * cc + yl * sn;
                        }
                    }
                    bf16_t* dst = (pn < 4) ? (bf16_t*)(ws + WS_Q) + ((size_t)((b * 16 + 4 * pn + wc) * 2048 + t)) * 64
                                           : (bf16_t*)(ws + WS_KV + (size_t)(pn - 4) * KV_STRIDE) + ((size_t)((b * 4 + wc) * 2048 + t)) * 64;
                    u32x4 w0, w1;
                    w0.x = cvt_pk_bf16(lo[0], lo[1]); w0.y = cvt_pk_bf16(lo[2], lo[3]); w0.z = cvt_pk_bf16(lo[4], lo[5]); w0.w = cvt_pk_bf16(lo[6], lo[7]);
                    w1.x = cvt_pk_bf16(hi[0], hi[1]); w1.y = cvt_pk_bf16(hi[2], hi[3]); w1.z = cvt_pk_bf16(hi[4], hi[5]); w1.w = cvt_pk_bf16(hi[6], hi[7]);
                    *(u32x4*)(dst + 8 * fq) = w0; *(u32x4*)(dst + 32 + 8 * fq) = w1;
                }
        } else if (pn < 18) {
            const bool isv = pn >= 14; const int tb = isv ? pn - 14 : pn - 10;
            bf16_t* O = (bf16_t*)(ws + (isv ? WS_V : WS_U)); float* vss = (float*)(ws + WS_VSS);
#pragma unroll
            for (int ai = 0; ai < 2; ++ai)
#pragma unroll
                for (int m = 0; m < 4; ++m) {
                    const int row = u.pm * 256 + ai * 128 + wr * 64 + m * 16 + fr;
#pragma unroll
                    for (int bj = 0; bj < 2; ++bj) {
                        float y[8]; float ss = 0.f;
#pragma unroll
                        for (int n = 0; n < 2; ++n)
#pragma unroll
                            for (int v = 0; v < 4; ++v) { const float gl = gelu_tanh(acc[ai][bj][m][n][v]); y[4 * n + v] = gl; ss += gl * gl; }
                        u32x4 w; w.x = cvt_pk_bf16(y[0], y[1]); w.y = cvt_pk_bf16(y[2], y[3]); w.z = cvt_pk_bf16(y[4], y[5]); w.w = cvt_pk_bf16(y[6], y[7]);
                        *(u32x4*)(O + (size_t)row * 1024 + tb * 256 + bj * 128 + wc * 32 + 8 * fq) = w;
                        if (isv) { ss += __shfl_xor(ss, 16); ss += __shfl_xor(ss, 32); if (fq == 0) vss[(size_t)row * 32 + (2 * tb + bj) * 4 + wc] = ss; }
                    }
                }
        } else {
            float* gate = (float*)(ws + WS_GATE);
            const int col = wc * 32 + 8 * fq;
            if (col < 48) {
#pragma unroll
                for (int ai = 0; ai < 2; ++ai)
#pragma unroll
                    for (int m = 0; m < 4; ++m) {
                        const int row = u.pm * 256 + ai * 128 + wr * 64 + m * 16 + fr;
#pragma unroll
                        for (int n = 0; n < 2; ++n) { f32x4 a = acc[ai][0][m][n]; f32x4 o; o.x = sigmoidf_(a.x); o.y = sigmoidf_(a.y); o.z = sigmoidf_(a.z); o.w = sigmoidf_(a.w);
                            *(f32x4*)(gate + (size_t)row * 48 + col + 4 * n) = o; }
                    }
            }
        }
    }
};

struct CmpP {
    static constexpr int K = 512, ESZ = 2, LDB = 2048; static constexpr bool IDLDS = false; static constexpr bool HALFONLY = false; static constexpr bool MIDK = false;
    const bf16_t* A; const bf16_t* Bt; int lda; int G, c;
    unsigned char* ws;
    __device__ __forceinline__ bool next(int i, Unit& u) const { const int L = i * G + c; if (L >= 64) return false; u.e = L >> 5; u.pm = (L >> 2) & 7; u.aux = L & 3; u.pn = 0; return true; }
    __device__ __forceinline__ unsigned row_id(const Unit& u, int r) const { return (unsigned)(u.e * 2048 + u.pm * 256 + r); }
    __device__ __forceinline__ unsigned a_koff(const Unit& u) const { return (unsigned)u.aux * 1024u; }
    __device__ __forceinline__ const char* b_base(const Unit& u) const { return (const char*)(Bt + (size_t)u.e * 256 * 2048 + u.aux * 512); }
    __device__ __forceinline__ void unit_begin(const Unit&, int) const {}
    __device__ __forceinline__ void midk(Acc&, const Unit&, int, int, int) const {}
    __device__ __forceinline__ void epi(const Acc& acc, const Unit& u, int ui, int wr, int wc, int fr, int fq) const {
        float* O = (float*)(ws + WS_PO) + ((size_t)(u.aux * 2 + u.e) * 2048) * 256;
#pragma unroll
        for (int bj = 0; bj < 2; ++bj) {
            const int col = bj * 128 + wc * 32 + 8 * fq;
#pragma unroll
            for (int ai = 0; ai < 2; ++ai)
#pragma unroll
                for (int m = 0; m < 4; ++m) {
                    const int row = u.pm * 256 + ai * 128 + wr * 64 + m * 16 + fr;
                    *(f32x4*)(O + (size_t)row * 256 + col) = acc[ai][bj][m][0]; *(f32x4*)(O + (size_t)row * 256 + col + 4) = acc[ai][bj][m][1];
                }
        }
    }
};

struct OutProjP {
    static constexpr int K = 2048, ESZ = 2, LDB = 2048; static constexpr bool IDLDS = false; static constexpr bool HALFONLY = false; static constexpr bool MIDK = true;
    const bf16_t* A; const bf16_t* Bt; int lda; int G, c;
    unsigned char* ws; const float* x; float* out; LAS f32x2* tab;
    __device__ __forceinline__ bool next(int i, Unit& u) const { return pg8::dense_next(i, G, c, 32, 8, u); }
    __device__ __forceinline__ unsigned row_id(const Unit& u, int r) const { return (unsigned)(u.pm * 256 + r); }
    __device__ __forceinline__ const char* b_base(const Unit& u) const { return (const char*)(Bt + (size_t)u.pn * 256 * K); }
    __device__ __forceinline__ unsigned a_koff(const Unit&) const { return 0u; }
    __device__ __forceinline__ void unit_begin(const Unit& u, int ui) const {
        if (threadIdx.x < 256) {
            const int row = u.pm * 256 + threadIdx.x;
            const f32x4 a = *(const f32x4*)((const float*)(ws + WS_OSSN) + (size_t)row * 4);
            const f32x4* gp = (const f32x4*)((const float*)(ws + WS_OSSG) + (size_t)row * 16);
            const f32x4 g0 = gp[0], g1 = gp[1], g2 = gp[2], g3 = gp[3];
            const float sn = (a.x + a.y) + (a.z + a.w);
            const float sg = ((g0.x + g0.y) + (g0.z + g0.w)) + ((g1.x + g1.y) + (g1.z + g1.w)) + ((g2.x + g2.y) + (g2.z + g2.w)) + ((g3.x + g3.y) + (g3.z + g3.w));
            const float rn = rsqrtf(sn * (1.f / 1024.f) + EPS), rg = rsqrtf(sg * (1.f / 1024.f) + EPS);
            tab[(ui & 1) * 256 + threadIdx.x] = (f32x2){rn / rg, rg};
        }
    }
    __device__ __forceinline__ void midk(Acc& acc, const Unit& u, int ui, int wr, int fr) const {
#pragma unroll
        for (int ai = 0; ai < 2; ++ai)
#pragma unroll
            for (int m = 0; m < 4; ++m) { const float s = tab[(ui & 1) * 256 + ai * 128 + wr * 64 + m * 16 + fr].x;
#pragma unroll
                for (int bj = 0; bj < 2; ++bj)
#pragma unroll
                    for (int n = 0; n < 2; ++n) acc[ai][bj][m][n] *= s; }
    }
    __device__ __forceinline__ void epi(const Acc& acc, const Unit& u, int ui, int wr, int wc, int fr, int fq) const {
        const float* mod = (const float*)(ws + WS_MOD);
#pragma unroll
        for (int ai = 0; ai < 2; ++ai)
#pragma unroll
            for (int m = 0; m < 4; ++m) {
                const int r = ai * 128 + wr * 64 + m * 16 + fr, row = u.pm * 256 + r, b = row >> 11; const float s = tab[(ui & 1) * 256 + r].y;
#pragma unroll
                for (int bj = 0; bj < 2; ++bj) {
                    const int col = u.pn * 256 + bj * 128 + wc * 32 + 8 * fq;
#pragma unroll
                    for (int n = 0; n < 2; ++n) {
                        const f32x4 gt = *(const f32x4*)(mod + b * 6 * D + 2 * D + col + 4 * n), xv = *(const f32x4*)(x + (size_t)row * D + col + 4 * n);
                        *(f32x4*)(out + (size_t)row * D + col + 4 * n) = xv + gt * (acc[ai][bj][m][n] * s);
                    }
                }
            }
    }
};

__device__ __forceinline__ void moe_table(const Frame& F, LAS int* tb) {
    if (F.tid < 64) {
        const unsigned* cnt = (const unsigned*)(F.ws + WS_CTL) + CW_CNT;
        const int c = (int)__hip_atomic_load(cnt + F.tid, __ATOMIC_RELAXED, __HIP_MEMORY_SCOPE_AGENT);
        const int tl = (c + 255) >> 8; int inc = tl;
#pragma unroll
        for (int o = 1; o < 64; o <<= 1) { const int v = __shfl_up(inc, o); if (F.lane >= o) inc += v; }
        tb[F.tid] = inc - tl; tb[128 + F.tid] = c;
        if (F.tid == 63) { tb[64] = inc; tb[65] = inc + (NTOK >> 8); tb[128 + 64] = NTOK; }
    }
    __syncthreads();
    if (F.tid < 384) {
        int lo = 0, hi = 64; while (lo < hi) { const int mid = (lo + hi + 1) >> 1; if (tb[mid] <= F.tid) lo = mid; else hi = mid - 1; }
        tb[256 + F.tid] = lo;
        const int nv = tb[128 + lo] - (F.tid - tb[lo]) * 256;
        tb[640 + F.tid] = (F.tid < tb[65] && lo < 64 && nv <= 128) ? 1 : 0;
    }
    __syncthreads();
    {
        const int TT = tb[65];
        const unsigned long long bm = __ballot(F.tid < 384 && tb[640 + (F.tid < 384 ? F.tid : 0)] != 0);
        if (F.tid < 384 && F.lane == 0) { tb[1500 + 2 * F.wave] = (int)(unsigned)bm; tb[1501 + 2 * F.wave] = (int)(unsigned)(bm >> 32); }
        __syncthreads();
        if (F.tid < 384) {
            int nhb = 0, nh = 0;
#pragma unroll
            for (int w = 0; w < 6; ++w) { const int c = __popc((unsigned)tb[1500 + 2 * w]) + __popc((unsigned)tb[1501 + 2 * w]); nh += c; if (w < F.wave) nhb += c; }
            nhb += __popcll(bm & ((1ull << F.lane) - 1ull));
            const int nf = TT - nh;
            if (F.tid < TT) tb[1024 + (tb[640 + F.tid] ? nf + nhb : F.tid - nhb)] = F.tid;
            if (F.tid == 0) tb[66] = nf;
        }
    }
    __syncthreads();
}

template <bool HALF> struct MoeUpP {
    LAS unsigned* idtab;
    static constexpr int K = 2048, ESZ = 1, LDB = 2048; static constexpr bool IDLDS = true; static constexpr bool HALFONLY = HALF; static constexpr bool MIDK = false;
    const unsigned char* A; const unsigned char* Bt; int lda; int G, c;
    unsigned char* ws; const LAS int* tb; int c0;
    __device__ __forceinline__ bool next(int i, Unit& u) const {
        const int nf = tb[66]; int k;
        if (!HALF) { const int L = i * G + c; if (L >= nf * 4) return false; k = L >> 2; u.pn = L & 3; }
        else { if (c < c0) return false; const int L = i * (G - c0) + (c - c0); if (L >= (tb[65] - nf) * 4) return false; k = nf + (L >> 2); u.pn = L & 3; }
        const int mt = tb[1024 + k]; u.e = tb[256 + mt]; u.pm = mt; u.aux = mt - tb[u.e]; return true; }
    __device__ __forceinline__ unsigned row_id(const Unit& u, int r) const {
        const int base = u.aux * 256; const int nv = tb[128 + u.e] - base; const int rr = r < nv ? r : 0;
        if (u.e == 64) return (unsigned)(base + rr);
        return (unsigned)((const int*)(ws + WS_LIST))[u.e * 8192 + base + rr];
    }
    __device__ __forceinline__ const char* b_base(const Unit& u) const { return (const char*)(Bt + ((size_t)u.e * 1024 + u.pn * 256) * K); }
    __device__ __forceinline__ void ids_prefetch(const Unit& u, int wid, int lane) const {
        if (u.e == 64) return;
        const int r = 64 * (wid & 3) + lane, base = u.aux * 256, nv = tb[128 + u.e] - base, rr = r < nv ? r : 0;
        __builtin_amdgcn_global_load_lds((const unsigned*)((const int*)(ws + WS_LIST) + u.e * 8192 + base + rr), (LAS unsigned*)(idtab + (wid >> 2) * 256 + 64 * (wid & 3)), 4, 0, 0);
    }
    __device__ __forceinline__ unsigned ids_read(const Unit& u, int r) const {
        if (u.e == 64) { const int base = u.aux * 256, nv = tb[128 + u.e] - base; return (unsigned)(base + (r < nv ? r : 0)); }
        return idtab[r];
    }
    __device__ __forceinline__ void unit_begin(const Unit&, int) const {}
    __device__ __forceinline__ unsigned a_koff(const Unit&) const { return 0u; }
    __device__ __forceinline__ void midk(Acc&, const Unit&, int, int, int) const {}
    __device__ __forceinline__ void epi(const Acc& acc, const Unit& u, int ui, int wr, int wc, int fr, int fq) const {
        unsigned char* O = ws + WS_HID; const float ws_ = 1.0f / W8SCALE;
#pragma unroll
        for (int ai = 0; ai < (HALF ? 1 : 2); ++ai)
#pragma unroll
            for (int m = 0; m < 4; ++m) {
                const size_t row = (size_t)u.pm * 256 + ai * 128 + wr * 64 + m * 16 + fr; float y[8];
#pragma unroll
                for (int n = 0; n < 2; ++n)
#pragma unroll
                    for (int v = 0; v < 4; ++v) y[4 * n + v] = siluf_(acc[ai][0][m][n][v] * ws_) * (acc[ai][1][m][n][v] * (ws_ * H8SCALE));
                u32x2 w; w.x = pk4_fp8(y[0], y[1], y[2], y[3]); w.y = pk4_fp8(y[4], y[5], y[6], y[7]);
                *(u32x2*)(O + row * 512 + u.pn * 128 + wc * 32 + 8 * fq) = w;
            }
    }
};
template <bool HALF> struct MoeDownP {
    static constexpr int K = 512, ESZ = 1, LDB = 512; static constexpr bool IDLDS = false; static constexpr bool HALFONLY = HALF; static constexpr bool MIDK = false;
    const unsigned char* A; const unsigned char* Bt; int lda; int G, c;
    unsigned char* ws; const LAS int* tb; int c0;
    __device__ __forceinline__ bool next(int i, Unit& u) const {
        const int nf = tb[66]; int k;
        if (!HALF) { const int L = i * G + c; if (L >= nf * 8) return false; k = L >> 3; u.pn = L & 7; }
        else { if (c < c0) return false; const int L = i * (G - c0) + (c - c0); if (L >= (tb[65] - nf) * 8) return false; k = nf + (L >> 3); u.pn = L & 7; }
        const int mt = tb[1024 + k]; u.e = tb[256 + mt]; u.pm = mt; u.aux = 0; return true; }
    __device__ __forceinline__ unsigned row_id(const Unit& u, int r) const { return (unsigned)(u.pm * 256 + r); }
    __device__ __forceinline__ const char* b_base(const Unit& u) const { return (const char*)(Bt + ((size_t)u.e * 2048 + u.pn * 256) * K); }
    __device__ __forceinline__ void unit_begin(const Unit&, int) const {}
    __device__ __forceinline__ unsigned a_koff(const Unit&) const { return 0u; }
    __device__ __forceinline__ void midk(Acc&, const Unit&, int, int, int) const {}
    __device__ __forceinline__ void epi(const Acc& acc, const Unit& u, int ui, int wr, int wc, int fr, int fq) const {
        unsigned char* O = ws + WS_PO; const float sc_ = PO8SCALE / (W8SCALE * H8SCALE);
#pragma unroll
        for (int ai = 0; ai < (HALF ? 1 : 2); ++ai)
#pragma unroll
            for (int m = 0; m < 4; ++m) {
                const size_t row = (size_t)u.pm * 256 + ai * 128 + wr * 64 + m * 16 + fr;
                const f32x4 a0 = acc[ai][0][m][0] * sc_, a1 = acc[ai][0][m][1] * sc_, b0 = acc[ai][1][m][0] * sc_, b1 = acc[ai][1][m][1] * sc_;
                u32x4 w; w.x = pk4_fp8(a0.x, a0.y, a0.z, a0.w); w.y = pk4_fp8(a1.x, a1.y, a1.z, a1.w); w.z = pk4_fp8(b0.x, b0.y, b0.z, b0.w); w.w = pk4_fp8(b1.x, b1.y, b1.z, b1.w);
                *(u32x4*)(O + row * 2048 + u.pn * 256 + wc * 64 + 16 * fq) = w;
            }
    }
};

__device__ __forceinline__ void gmlp_unit(const Frame& F, int n) {
    const int b = n >> 7, c = (n >> 3) & 15, g = n & 7;
    constexpr int WP = 136, VP = 160;
    LAS bf16_t* Ws = (LAS bf16_t*)F.lds;
    LAS bf16_t* Vs = (LAS bf16_t*)(F.lds + 34816);
    LAS float* rs = (LAS float*)(F.lds + 75776);
    LAS float* stg = (LAS float*)F.lds + F.wave * 2048;
    const int row0 = b * T + c * 128;
    const int tb = F.wave & 3, dh = F.wave >> 2, r32 = F.lane & 31, hi = F.lane >> 5;
    f32x4 vssv = (f32x4){0.f, 0.f, 0.f, 0.f};
    if (F.tid < 128) vssv = *(const f32x4*)(WSP(float, WS_VSS) + (size_t)(row0 + F.tid) * 32 + g * 4);
    const float* wsp = F.in[I_WSP] + (size_t)g * 128 * 128;
    f32x4 wv[8];
#pragma unroll
    for (int q = 0; q < 8; ++q) { const int idx = F.tid + 512 * q; wv[q] = *(const f32x4*)(wsp + (idx >> 5) * 128 + (idx & 31) * 4); }
    const bf16_t* Vg = WSP(bf16_t, WS_V);
    u32x4 vv[4];
#pragma unroll
    for (int q = 0; q < 4; ++q) { const int ch = F.tid + 512 * q; vv[q] = *(const u32x4*)(Vg + (size_t)(row0 + (ch >> 4)) * 1024 + g * 128 + (ch & 15) * 8); }
    const bf16_t* U = WSP(bf16_t, WS_U);
    u32x4 uv[4];
#pragma unroll
    for (int q = 0; q < 4; ++q) uv[q] = *(const u32x4*)(U + (size_t)(row0 + 32 * tb + q * 8 + (F.lane >> 3)) * 1024 + g * 128 + 64 * dh + (F.lane & 7) * 8);
    f32x4 gv0, gv1; { const float* gvp = F.in[I_GGV] + g * 128 + (F.tid & 15) * 8; gv0 = *(const f32x4*)gvp; gv1 = *(const f32x4*)(gvp + 4); }
    __syncthreads();
    if (F.tid < 128) rs[F.tid] = rsqrtf(((vssv.x + vssv.y) + (vssv.z + vssv.w)) * (1.f / 128.f) + EPS);
#pragma unroll
    for (int q = 0; q < 8; ++q) {
        const int idx = F.tid + 512 * q, t = idx >> 5, s4 = (idx & 31) * 4;
        f32x4 w = wv[q];
        if (s4 + 0 > t) w.x = 0.f; if (s4 + 1 > t) w.y = 0.f; if (s4 + 2 > t) w.z = 0.f; if (s4 + 3 > t) w.w = 0.f;
        u32x2 o; o.x = cvt_pk_bf16(w.x, w.y); o.y = cvt_pk_bf16(w.z, w.w);
        *(LAS u32x2*)(Ws + t * WP + s4) = o;
    }
    __syncthreads();
#pragma unroll
    for (int q = 0; q < 4; ++q) {
        const int ch = F.tid + 512 * q, sidx = ch >> 4, dc = ch & 15;
        const float r = rs[sidx];
        u32x4 o;
        o.x = cvt_pk_bf16(bflo(vv[q].x) * r * gv0.x, bfhi(vv[q].x) * r * gv0.y); o.y = cvt_pk_bf16(bflo(vv[q].y) * r * gv0.z, bfhi(vv[q].y) * r * gv0.w);
        o.z = cvt_pk_bf16(bflo(vv[q].z) * r * gv1.x, bfhi(vv[q].z) * r * gv1.y); o.w = cvt_pk_bf16(bflo(vv[q].w) * r * gv1.z, bfhi(vv[q].w) * r * gv1.w);
        *(LAS u32x4*)(Vs + sidx * VP + dc * 8) = o;
    }
    __syncthreads();
    f32x16 acc[2]; acc[0] = (f32x16)(0.f); acc[1] = (f32x16)(0.f);
    {
        const LAS unsigned char* vbase = (const LAS unsigned char*)Vs + (8 * hi + ((F.lane & 15) >> 2)) * (VP * 2) + (64 * dh + 16 * ((F.lane >> 4) & 1) + 4 * (F.lane & 3)) * 2;
        for (int kc = 0; kc < 2 * tb + 2; ++kc) {
            const bf16x8 a = *(const LAS bf16x8*)(Ws + (32 * tb + r32) * WP + 16 * kc + 8 * hi);
#pragma unroll
            for (int db = 0; db < 2; ++db) {
                const v4i16_t lo4 = __builtin_amdgcn_ds_read_tr16_b64_v4i16((LAS v4i16_t*)(vbase + (16 * kc) * (VP * 2) + 64 * db));
                const v4i16_t hi4 = __builtin_amdgcn_ds_read_tr16_b64_v4i16((LAS v4i16_t*)(vbase + (16 * kc + 4) * (VP * 2) + 64 * db));
                const bf16x8 bq = (bf16x8){lo4[0], lo4[1], lo4[2], lo4[3], hi4[0], hi4[1], hi4[2], hi4[3]};
                acc[db] = __builtin_amdgcn_mfma_f32_32x32x16_bf16(a, bq, acc[db], 0, 0, 0);
            }
        }
    }
    __syncthreads();
    {
        const float* bsp = F.in[I_BSP] + g * 128 + 32 * tb + 4 * hi;
        LAS float* sl = stg + (4 * hi) * 64 + r32;
#pragma unroll
        for (int r = 0; r < 16; ++r) { const int rc = (r & 3) + 8 * (r >> 2); const float bias = bsp[rc]; sl[rc * 64] = acc[0][r] + bias; sl[rc * 64 + 32] = acc[1][r] + bias; }
    }
    bf16_t* O = WSP(bf16_t, WS_OCAT); float* ossg = WSP(float, WS_OSSG);
#pragma unroll
    for (int q = 0; q < 4; ++q) {
        const int rl = q * 8 + (F.lane >> 3), ch = F.lane & 7, row = row0 + 32 * tb + rl;
        const f32x4 m0 = *(const LAS f32x4*)(stg + rl * 64 + ch * 8), m1 = *(const LAS f32x4*)(stg + rl * 64 + ch * 8 + 4);
        const float o0 = bflo(uv[q].x) * m0.x, o1 = bfhi(uv[q].x) * m0.y, o2 = bflo(uv[q].y) * m0.z, o3 = bfhi(uv[q].y) * m0.w;
        const float o4 = bflo(uv[q].z) * m1.x, o5 = bfhi(uv[q].z) * m1.y, o6 = bflo(uv[q].w) * m1.z, o7 = bfhi(uv[q].w) * m1.w;
        u32x4 w; w.x = cvt_pk_bf16(o0, o1); w.y = cvt_pk_bf16(o2, o3); w.z = cvt_pk_bf16(o4, o5); w.w = cvt_pk_bf16(o6, o7);
        *(u32x4*)(O + (size_t)row * 2048 + 1024 + g * 128 + 64 * dh + ch * 8) = w;
        float ss = ((o0 * o0 + o1 * o1) + (o2 * o2 + o3 * o3)) + ((o4 * o4 + o5 * o5) + (o6 * o6 + o7 * o7));
        ss += __shfl_xor(ss, 1); ss += __shfl_xor(ss, 2); ss += __shfl_xor(ss, 4);
        if (ch == 0) ossg[(size_t)row * 16 + 2 * g + dh] = ss;
    }
}

__device__ __forceinline__ void phase2b(const Frame& F) {
    const int gw = F.vcu * 8 + F.wave, NGW = F.G * 8;
    LAS float* hs = (LAS float*)F.lds + F.wave * 256;
    for (int it = gw; it < 4096; it += NGW) {
        const int kv = it >> 11, m = it & 2047, n = m & 127;
        bf16_t* dst = WSP(bf16_t, kv ? WS_VCMP : WS_KCMP) + (size_t)m * 64;
        if (n == 127) { dst[F.lane] = 0; continue; }
        {
            f32x4 a = *(const f32x4*)(WSP(float, WS_BIAS1) + kv * 256 + 4 * F.lane);
#pragma unroll
            for (int ks = 0; ks < 4; ++ks) a += *(const f32x4*)(WSP(float, WS_PO) + ((size_t)(ks * 2 + kv) * 2048 + m) * 256 + 4 * F.lane);
            hs[4 * F.lane + 0] = gelu_tanh(a.x); hs[4 * F.lane + 1] = gelu_tanh(a.y); hs[4 * F.lane + 2] = gelu_tanh(a.z); hs[4 * F.lane + 3] = gelu_tanh(a.w);
        }
        const float* w2 = F.in[kv ? I_CW2V : I_CW2K];
        float y = 0.f;
#pragma unroll 8
        for (int k = 0; k < 256; ++k) y += hs[k] * w2[k * 64 + F.lane];
        if (kv == 0) {
            const float rstd = rsqrtf(wave_sum(y * y) * (1.f / 64.f) + EPS);
            const float yn = y * rstd * F.in[I_GK][F.lane];
            const float pr = __shfl_xor(yn, 32);
            float c, s; rope_cs(16.0f * (float)n + 15.5f, F.lane & 31, c, s);
            y = (F.lane < 32) ? yn * c - pr * s : yn * c + pr * s;
        }
        dst[F.lane] = (bf16_t)(cvt_pk_bf16(y, 0.f) & 0xffffu);
    }
}

constexpr int AT_KS = 0, AT_VT = 18432, AT_WSF = 43008, AT_MSK = 45056, AT_FS = 45312, AT_SSQ = 47360, AT_IMP = 48384, AT_G = 56832, AT_L = 90624;
constexpr int KSP = 72, VTP = 96, VTB = 64 * VTP * 2;
constexpr float AT_THR = 20.0f;
struct AttnCtx {
    LAS unsigned char* lds; int tid, lane, wave, r32, hi, g, th, tokl;
    bf16x8 qf[4];
};
__device__ __forceinline__ void at_load(const bf16_t* Kb, const bf16_t* Vb, int tile, int tid, u32x4& kr, u32x4& vr) {
    const size_t off = (size_t)(tile * 64 + (tid >> 3)) * 64 + (tid & 7) * 8;
    kr = *(const u32x4*)(Kb + off); vr = *(const u32x4*)(Vb + off);
}
__device__ __forceinline__ void at_store(LAS unsigned char* lds, int buf, int tid, const u32x4& kr, const u32x4& vr) {
    const int key = tid >> 3, ch = tid & 7;
    *(LAS u32x4*)(lds + AT_KS + buf * 9216 + (key * KSP + ch * 8) * 2) = kr;
    *(LAS u32x4*)(lds + AT_VT + buf * VTB + (key * VTP + ch * 8) * 2) = vr;
}
__device__ __forceinline__ void attn_pass(const int MODE, AttnCtx& C, const bf16_t* Kb, const bf16_t* Vb, int i, int j0, int ntiles, unsigned rowmask, bool want_imp, float gatev, f32x16 (&of)[2],
                                          u32x4& kr, u32x4& vr, const bf16_t* Kn, const bf16_t* Vn, int jn) {
    LAS unsigned char* lds = C.lds;
    LAS float* wsf = (LAS float*)(lds + AT_WSF) + C.wave * 64;
    float mref = 0.f, l = 0.f, m0 = 0.f;
    f32x16 o[2]; o[0] = (f32x16)(0.f); o[1] = (f32x16)(0.f);
    const int vlane = (4 * C.hi + ((C.lane & 15) >> 2)) * (VTP * 2) + (16 * ((C.lane >> 4) & 1) + 4 * (C.lane & 3)) * 2;
    at_store(lds, 0, C.tid, kr, vr);
    __syncthreads();
    for (int tt = 0; tt < ntiles; ++tt) {
        const int buf = tt & 1, j = j0 + tt;
        if (tt + 1 < ntiles) at_load(Kb, Vb, j + 1, C.tid, kr, vr); else if (Kn) at_load(Kn, Vn, jn, C.tid, kr, vr);
        bool active = true;
        if (MODE == 1) active = __any((rowmask >> j) & 1u);
        if (active) {
            f32x16 p0, p1;
            const LAS unsigned char* ks = lds + AT_KS + buf * 9216;
            int wlo = 0, whi = 63;
            if (MODE == 0) { const int t = 64 * i + C.tokl; whi = ((t >= 31) ? ((t - 31) >> 4) : -1) - 64 * tt; }
            else {
                if (MODE == 1 && !((rowmask >> j) & 1u)) wlo = 64;
                if (j == i) whi = C.tokl;
                if (MODE == 2 && j == i - 8) wlo = C.tokl + 1;
            }
            const bf16x8 ka0 = *(const LAS bf16x8*)(ks + (C.r32 * KSP + 8 * C.hi) * 2);
            const bf16x8 ka1 = *(const LAS bf16x8*)(ks + ((32 + C.r32) * KSP + 8 * C.hi) * 2);
            if (__any(wlo > 0 || whi < 63)) {
                f32x16 c0, c1;
#pragma unroll
                for (int r = 0; r < 16; ++r) { const int kl = (r & 3) + 8 * (r >> 2) + 4 * C.hi; c0[r] = (kl < wlo || kl > whi) ? NEGF : 0.f; c1[r] = (kl + 32 < wlo || kl + 32 > whi) ? NEGF : 0.f; }
                p0 = __builtin_amdgcn_mfma_f32_32x32x16_bf16(ka0, C.qf[0], c0, 0, 0, 0); p1 = __builtin_amdgcn_mfma_f32_32x32x16_bf16(ka1, C.qf[0], c1, 0, 0, 0);
            } else {
                const f32x16 z16 = (f32x16)(0.f);
                p0 = __builtin_amdgcn_mfma_f32_32x32x16_bf16(ka0, C.qf[0], z16, 0, 0, 0); p1 = __builtin_amdgcn_mfma_f32_32x32x16_bf16(ka1, C.qf[0], z16, 0, 0, 0);
            }
#pragma unroll
            for (int d0 = 1; d0 < 4; ++d0) {
                const bf16x8 k0 = *(const LAS bf16x8*)(ks + (C.r32 * KSP + 16 * d0 + 8 * C.hi) * 2);
                const bf16x8 k1 = *(const LAS bf16x8*)(ks + ((32 + C.r32) * KSP + 16 * d0 + 8 * C.hi) * 2);
                p0 = __builtin_amdgcn_mfma_f32_32x32x16_bf16(k0, C.qf[d0], p0, 0, 0, 0); p1 = __builtin_amdgcn_mfma_f32_32x32x16_bf16(k1, C.qf[d0], p1, 0, 0, 0);
            }
            if (__any(mref != 0.f)) {
#pragma unroll
                for (int r = 0; r < 16; ++r) { p0[r] -= mref; p1[r] -= mref; }
            }
            float mx = fmaxf(p0[0], p1[0]);
#pragma unroll
            for (int r = 1; r < 16; ++r) mx = fmaxf(fmaxf(mx, p0[r]), p1[r]);
            if (__any(mx > AT_THR)) {
                mx = fmaxf(mx, __shfl_xor(mx, 32));
                const float dl = fmaxf(mx, 0.f); mref += dl;
#pragma unroll
                for (int r = 0; r < 16; ++r) { p0[r] -= dl; p1[r] -= dl; }
                const float f = fexp2(-dl); l *= f;
                if (C.hi == 0) wsf[C.r32] = f;
#pragma unroll
                for (int r = 0; r < 16; ++r) { const float ff = wsf[(r & 3) + 8 * (r >> 2) + 4 * C.hi]; o[0][r] *= ff; o[1][r] *= ff; }
            }
            float rsum = 0.f;
#pragma unroll
            for (int r = 0; r < 16; ++r) { p0[r] = fexp2(p0[r]); p1[r] = fexp2(p1[r]); rsum += p0[r] + p1[r]; }
            l += rsum;
            if (MODE == 0) {
                if (tt == 0) m0 = mref;
                if (want_imp) {
                    LAS float* Gs = (LAS float*)(lds + AT_G) + (C.g * 64 + C.tokl) * 33; LAS float* Ls = (LAS float*)(lds + AT_L) + (C.g * 64 + C.tokl) * 33;
#pragma unroll
                    for (int rg = 0; rg < 4; ++rg) {
                        const int ml = 16 * tt + 2 * rg + C.hi;
                        Gs[ml] = (p0[4 * rg] + p0[4 * rg + 1]) + (p0[4 * rg + 2] + p0[4 * rg + 3]); Ls[ml] = p0[4 * rg + 3];
                        Gs[ml + 8] = (p1[4 * rg] + p1[4 * rg + 1]) + (p1[4 * rg + 2] + p1[4 * rg + 3]); Ls[ml + 8] = p1[4 * rg + 3];
                    }
                }
            }
            bf16x8 pa[4];
#pragma unroll
            for (int c = 0; c < 4; ++c) {
                u32x4 w;
                if (c < 2) { w.x = cvt_pk_bf16(p0[8 * c], p0[8 * c + 1]); w.y = cvt_pk_bf16(p0[8 * c + 2], p0[8 * c + 3]); w.z = cvt_pk_bf16(p0[8 * c + 4], p0[8 * c + 5]); w.w = cvt_pk_bf16(p0[8 * c + 6], p0[8 * c + 7]); }
                else { const int cc = c - 2; w.x = cvt_pk_bf16(p1[8 * cc], p1[8 * cc + 1]); w.y = cvt_pk_bf16(p1[8 * cc + 2], p1[8 * cc + 3]); w.z = cvt_pk_bf16(p1[8 * cc + 4], p1[8 * cc + 5]); w.w = cvt_pk_bf16(p1[8 * cc + 6], p1[8 * cc + 7]); }
                pa[c] = __builtin_bit_cast(bf16x8, w);
            }
            const LAS unsigned char* vb = lds + AT_VT + buf * VTB + vlane;
#pragma unroll
            for (int c = 0; c < 4; ++c) {
                const int koff = (32 * (c >> 1) + 16 * (c & 1)) * (VTP * 2);
#pragma unroll
                for (int db = 0; db < 2; ++db) {
                    const v4i16_t lo = __builtin_amdgcn_ds_read_tr16_b64_v4i16((LAS v4i16_t*)(vb + koff + 64 * db));
                    const v4i16_t hi4 = __builtin_amdgcn_ds_read_tr16_b64_v4i16((LAS v4i16_t*)(vb + koff + 8 * (VTP * 2) + 64 * db));
                    const bf16x8 bv = (bf16x8){lo[0], lo[1], lo[2], lo[3], hi4[0], hi4[1], hi4[2], hi4[3]};
                    o[db] = __builtin_amdgcn_mfma_f32_32x32x16_bf16(pa[c], bv, o[db], 0, 0, 0);
                }
            }
        }
        if (tt + 1 < ntiles) at_store(lds, buf ^ 1, C.tid, kr, vr);
        __syncthreads();
    }
    const float lt = l + __shfl_xor(l, 32);
    const float inv = lt > 0.f ? frcp(lt) : 0.f;
    if (MODE == 0 && want_imp && C.hi == 0) {
        LAS float* fs = (LAS float*)(lds + AT_FS) + (C.g * 64 + C.tokl) * 2;
        fs[0] = (ntiles > 1) ? fexp2(m0 - mref) * inv : inv; fs[1] = inv;
    }
    if (C.hi == 0) wsf[C.r32] = inv * gatev;
#pragma unroll
    for (int r = 0; r < 16; ++r) { const float f = wsf[(r & 3) + 8 * (r >> 2) + 4 * C.hi]; of[0][r] += o[0][r] * f; of[1][r] += o[1][r] * f; }
}
__device__ __forceinline__ void attn_unit(const Frame& F, int b, int kvh, int i) {
    AttnCtx C; C.lds = F.lds; C.tid = F.tid; C.lane = F.lane; C.wave = F.wave; C.r32 = F.lane & 31; C.hi = F.lane >> 5; C.g = F.wave >> 1; C.th = F.wave & 1; C.tokl = 32 * C.th + C.r32;
    const int h = 4 * kvh + C.g, t = 64 * i + C.tokl, row = b * T + t;
    const bf16_t* Qp = WSP(bf16_t, WS_Q) + ((size_t)(b * 16 + h) * 2048 + t) * 64;
#pragma unroll
    for (int d0 = 0; d0 < 4; ++d0) C.qf[d0] = *(const bf16x8*)(Qp + 16 * d0 + 8 * C.hi);
    const float* gp = WSP(float, WS_GATE) + (size_t)row * 48 + h * 3;
    const float g0 = gp[0], g1 = gp[1], g2 = gp[2];
    const size_t kvoff = (size_t)(b * 4 + kvh) * 2048 * 64;
    f32x16 of[2]; of[0] = (f32x16)(0.f); of[1] = (f32x16)(0.f);
    const bool want_imp = i >= 16;
    u32x4 kr, vr;
    at_load(WSP(bf16_t, WS_KCMP) + (size_t)(b * 4 + kvh) * 128 * 64, WSP(bf16_t, WS_VCMP) + (size_t)(b * 4 + kvh) * 128 * 64, 0, C.tid, kr, vr);
    __syncthreads();
    LAS unsigned* msk = (LAS unsigned*)(F.lds + AT_MSK);
    unsigned rowmask = 0u;
#pragma unroll 1
    for (int ps = 0; ps < 3; ++ps) {
        const bf16_t* Kb; const bf16_t* Vb; int j0, ntl; float gv;
        if (ps == 0) { Kb = WSP(bf16_t, WS_KCMP) + (size_t)(b * 4 + kvh) * 128 * 64; Vb = WSP(bf16_t, WS_VCMP) + (size_t)(b * 4 + kvh) * 128 * 64; j0 = 0; ntl = want_imp ? 2 : 1; gv = g0; }
        else if (ps == 1) { Kb = WSP(bf16_t, WS_KV + 2 * KV_STRIDE) + kvoff; Vb = WSP(bf16_t, WS_KV + 3 * KV_STRIDE) + kvoff; j0 = 0; ntl = i + 1; gv = g1; }
        else { Kb = WSP(bf16_t, WS_KV + 4 * KV_STRIDE) + kvoff; Vb = WSP(bf16_t, WS_KV + 5 * KV_STRIDE) + kvoff; j0 = i >= 8 ? i - 8 : 0; ntl = i - j0 + 1; gv = g2; }
        const bf16_t* Kn = nullptr; const bf16_t* Vn = nullptr; int jn = 0;
        if (ps == 0) { Kn = WSP(bf16_t, WS_KV + 2 * KV_STRIDE) + kvoff; Vn = WSP(bf16_t, WS_KV + 3 * KV_STRIDE) + kvoff; jn = 0; }
        else if (ps == 1) { Kn = WSP(bf16_t, WS_KV + 4 * KV_STRIDE) + kvoff; Vn = WSP(bf16_t, WS_KV + 5 * KV_STRIDE) + kvoff; jn = i >= 8 ? i - 8 : 0; }
        attn_pass(ps, C, Kb, Vb, i, j0, ntl, rowmask, want_imp, gv, of, kr, vr, Kn, Vn, jn);
        if (ps == 0) {
            if (want_imp) {
                __syncthreads();
                LAS float* Gs = (LAS float*)(F.lds + AT_G); LAS float* Ls = (LAS float*)(F.lds + AT_L); LAS float* fs = (LAS float*)(F.lds + AT_FS); LAS float* imp = (LAS float*)(F.lds + AT_IMP);
#pragma unroll 1
                for (int q = 0; q < 4; ++q) {
                    const int idx = F.tid + 512 * q, tok = idx >> 5, j = idx & 31; float v = 0.f;
#pragma unroll
                    for (int g = 0; g < 4; ++g) {
                        const int base = (g * 64 + tok);
                        v += fs[base * 2 + (j >> 4)] * Gs[base * 33 + j];
                        if (j > 0) v += fs[base * 2 + ((j - 1) >> 4)] * Ls[base * 33 + j - 1];
                    }
                    imp[tok * 33 + j] = v;
                }
                __syncthreads();
                {
                    const int tok = F.tid >> 3, sub = F.tid & 7;
                    const LAS float* im = imp + tok * 33;
                    float cv[4]; int cj[4];
#pragma unroll
                    for (int q = 0; q < 4; ++q) { cj[q] = 1 + sub + 8 * q; cv[q] = (cj[q] <= i - 2) ? im[cj[q]] : -2.f; }
                    unsigned mk = 1u | (1u << i) | (1u << (i - 1));
                    for (int rnd = 0; rnd < 13; ++rnd) {
                        float best = -1.f; int bj = 99;
#pragma unroll
                        for (int q = 0; q < 4; ++q) if (cv[q] > best) { best = cv[q]; bj = cj[q]; }
#pragma unroll
                        for (int o = 1; o < 8; o <<= 1) { const float ov = __shfl_xor(best, o); const int oj = __shfl_xor(bj, o); if (ov > best || (ov == best && oj < bj)) { best = ov; bj = oj; } }
                        mk |= 1u << bj;
#pragma unroll
                        for (int q = 0; q < 4; ++q) if (cj[q] == bj) cv[q] = -2.f;
                    }
                    if (sub == 0) msk[tok] = mk;
                }
            } else {
                if (F.tid < 64) msk[F.tid] = (2u << i) - 1u;
            }
            __syncthreads();
            rowmask = msk[C.tokl];
        }
    }
    bf16_t* O = WSP(bf16_t, WS_OCAT); LAS float* ssq = (LAS float*)(F.lds + AT_SSQ);
    LAS bf16_t* stg = (LAS bf16_t*)(F.lds + AT_G) + C.wave * 2048;
#pragma unroll
    for (int r = 0; r < 16; ++r) {
        const int rl = (r & 3) + 8 * (r >> 2) + 4 * C.hi;
        stg[rl * 64 + C.r32] = (bf16_t)(cvt_pk_bf16(of[0][r], 0.f) & 0xffffu); stg[rl * 64 + 32 + C.r32] = (bf16_t)(cvt_pk_bf16(of[1][r], 0.f) & 0xffffu);
        float ss = of[0][r] * of[0][r] + of[1][r] * of[1][r];
        ss += __shfl_xor(ss, 1); ss += __shfl_xor(ss, 2); ss += __shfl_xor(ss, 4); ss += __shfl_xor(ss, 8); ss += __shfl_xor(ss, 16);
        if (C.r32 == 0) ssq[C.g * 64 + 32 * C.th + rl] = ss;
    }
    {
        bf16_t* ob = O + (size_t)(b * T + 64 * i + 32 * C.th + (C.lane >> 3)) * 2048 + h * 64 + (C.lane & 7) * 8;
#pragma unroll
        for (int q = 0; q < 4; ++q) { const u32x4 v = *(const LAS u32x4*)(stg + (q * 8 + (C.lane >> 3)) * 64 + (C.lane & 7) * 8); *(u32x4*)(ob + (size_t)q * 8 * 2048) = v; }
    }
    __syncthreads();
    if (F.tid < 64) WSP(float, WS_OSSN)[(size_t)(b * T + 64 * i + F.tid) * 4 + kvh] = (ssq[F.tid] + ssq[64 + F.tid]) + (ssq[128 + F.tid] + ssq[192 + F.tid]);
}

__device__ __forceinline__ void split_bf16(const float (&v)[8], bf16x8& hi, bf16x8& lo) {
    u32x4 h, l;
    unsigned* hp = (unsigned*)&h; unsigned* lp = (unsigned*)&l;
#pragma unroll
    for (int e = 0; e < 4; ++e) {
        const unsigned pk = cvt_pk_bf16(v[2 * e], v[2 * e + 1]); hp[e] = pk;
        lp[e] = cvt_pk_bf16(v[2 * e] - bflo(pk), v[2 * e + 1] - bfhi(pk));
    }
    hi = __builtin_bit_cast(bf16x8, h); lo = __builtin_bit_cast(bf16x8, l);
}
__device__ __forceinline__ void router_unit(const Frame& F, int un) {
    LAS float* rstd_s = (LAS float*)F.lds;
    LAS float* part = (LAS float*)(F.lds + 1024);
    LAS float* sc_s = (LAS float*)(F.lds + 1024 + 65536);
    LAS float* sb_s = sc_s + 32 * 65;
    LAS int* lcnt = (LAS int*)(sb_s + 32 * 65);
    LAS int* lbase = lcnt + 64;
    const int row0 = un * 32, b = row0 >> 11;
    const float* x1 = F.out; const float* mod = WSP(float, WS_MOD) + b * 6 * D;
    __syncthreads();
    if (F.tid < 64) lcnt[F.tid] = 0;
    {
        f32x4 xv[4][8];
#pragma unroll
        for (int q = 0; q < 4; ++q) { const f32x4* xr = (const f32x4*)(x1 + (size_t)(row0 + F.wave * 4 + q) * D) + F.lane;
#pragma unroll
            for (int j = 0; j < 8; ++j) xv[q][j] = xr[64 * j]; }
#pragma unroll
        for (int q = 0; q < 4; ++q) { float s = 0.f;
#pragma unroll
            for (int j = 0; j < 8; ++j) { const f32x4 v = xv[q][j]; s += (v.x * v.x + v.y * v.y) + (v.z * v.z + v.w * v.w); }
            s = wave_sum(s); if (F.lane == 0) rstd_s[F.wave * 4 + q] = rsqrtf(s * (1.f / D) + EPS); }
    }
    __syncthreads();
    const int r32 = F.lane & 31, hi = F.lane >> 5;
    const float rs = rstd_s[r32];
    f32x16 acc[2]; acc[0] = (f32x16)(0.f); acc[1] = (f32x16)(0.f);
    const float* wr_ = F.in[I_WR];
#pragma unroll 4
    for (int kc = 0; kc < 16; ++kc) {
        const int kk = F.wave * 256 + kc * 16 + 8 * hi;
        float hv[8];
        {
            const f32x4 xa = *(const f32x4*)(x1 + (size_t)(row0 + r32) * D + kk), xb = *(const f32x4*)(x1 + (size_t)(row0 + r32) * D + kk + 4);
            const f32x4 ga = *(const f32x4*)(F.in[I_GN2] + kk), gb = *(const f32x4*)(F.in[I_GN2] + kk + 4);
            const f32x4 sa = *(const f32x4*)(mod + 4 * D + kk), sb2 = *(const f32x4*)(mod + 4 * D + kk + 4);
            const f32x4 ha = *(const f32x4*)(mod + 3 * D + kk), hb = *(const f32x4*)(mod + 3 * D + kk + 4);
            const f32x4 ra = xa * rs * ga * (sa + 1.0f) + ha, rb = xb * rs * gb * (sb2 + 1.0f) + hb;
            hv[0] = ra.x; hv[1] = ra.y; hv[2] = ra.z; hv[3] = ra.w; hv[4] = rb.x; hv[5] = rb.y; hv[6] = rb.z; hv[7] = rb.w;
        }
        bf16x8 ah, al; split_bf16(hv, ah, al);
        { u32x2 h8; h8.x = pk4_fp8(hv[0], hv[1], hv[2], hv[3]); h8.y = pk4_fp8(hv[4], hv[5], hv[6], hv[7]); *(u32x2*)(WSP(unsigned char, WS_H) + (size_t)(row0 + r32) * D + kk) = h8; }
#pragma unroll
        for (int nb = 0; nb < 2; ++nb) {
            float wv[8];
#pragma unroll
            for (int j = 0; j < 8; ++j) wv[j] = wr_[(size_t)(kk + j) * 64 + 32 * nb + r32];
            bf16x8 bh, bl; split_bf16(wv, bh, bl);
            acc[nb] = __builtin_amdgcn_mfma_f32_32x32x16_bf16(ah, bh, acc[nb], 0, 0, 0);
            acc[nb] = __builtin_amdgcn_mfma_f32_32x32x16_bf16(ah, bl, acc[nb], 0, 0, 0);
            acc[nb] = __builtin_amdgcn_mfma_f32_32x32x16_bf16(al, bh, acc[nb], 0, 0, 0);
        }
    }
#pragma unroll
    for (int nb = 0; nb < 2; ++nb)
#pragma unroll
        for (int r = 0; r < 16; ++r) part[(F.wave * 32 + (r & 3) + 8 * (r >> 2) + 4 * hi) * 64 + 32 * nb + r32] = acc[nb][r];
    __syncthreads();
    int eid[8]; int lp[8]; float wk[8];
    const int tok = F.tid >> 4, sub = F.tid & 15;
    {
        const int e4 = sub * 4; f32x4 sacc = (f32x4){0.f, 0.f, 0.f, 0.f};
#pragma unroll
        for (int w = 0; w < 8; ++w) sacc += *(const LAS f32x4*)(part + (w * 32 + tok) * 64 + e4);
        const f32x4 rb = *(const f32x4*)(F.in[I_RB] + e4);
        float s4[4], sb4[4];
#pragma unroll
        for (int v = 0; v < 4; ++v) { s4[v] = 1.0f / (1.0f + expf(-sacc[v])); sb4[v] = s4[v] + rb[v]; }
        float a1 = -3.0e38f, a2 = -3.0e38f;
#pragma unroll
        for (int v = 0; v < 4; ++v) { if (sb4[v] > a1) { a2 = a1; a1 = sb4[v]; } else if (sb4[v] > a2) a2 = sb4[v]; }
        const float b1 = __shfl_xor(a1, 1), b2 = __shfl_xor(a2, 1);
        const float gs = fmaxf(a1, b1) + fmaxf(fminf(a1, b1), fmaxf(a2, b2));
        int rank = 0; const int g = sub >> 1;
#pragma unroll
        for (int gg = 0; gg < 8; ++gg) { const float v = __shfl(gs, (F.lane & ~15) | (2 * gg)); rank += (v > gs || (v == gs && gg < g)) ? 1 : 0; }
        const bool gsel = rank < 4;
        float cv[4];
#pragma unroll
        for (int v = 0; v < 4; ++v) cv[v] = gsel ? sb4[v] : -3.0e38f;
        float wsum = 0.f;
#pragma unroll 1
        for (int k = 0; k < 8; ++k) {
            float best = -3.9e38f; int be = 99; float bs = 0.f;
#pragma unroll
            for (int v = 0; v < 4; ++v) if (cv[v] > best) { best = cv[v]; be = e4 + v; bs = s4[v]; }
#pragma unroll
            for (int o = 1; o < 16; o <<= 1) { const float ov = __shfl_xor(best, o); const int oe = __shfl_xor(be, o); const float os = __shfl_xor(bs, o);
                if (ov > best || (ov == best && oe < be)) { best = ov; be = oe; bs = os; } }
#pragma unroll
            for (int v = 0; v < 4; ++v) if (e4 + v == be) cv[v] = -3.9e38f;
#pragma unroll
            for (int kk = 0; kk < 8; ++kk) if (kk == k) { eid[kk] = be; wk[kk] = bs; }
            wsum += bs;
        }
        const float sc = 2.5f / wsum;
        if (sub == 0) {
#pragma unroll
            for (int k = 0; k < 8; ++k) { wk[k] *= sc; lp[k] = atomicAdd((int*)(lcnt + eid[k]), 1); }
        }
    }
    __syncthreads();
    if (F.tid < 64) { const int c = lcnt[F.tid]; lbase[F.tid] = c ? (int)atomicAdd((unsigned*)(F.ws + WS_CTL) + CW_CNT + F.tid, (unsigned)c) : 0; }
    __syncthreads();
    if (sub == 0) {
        const int row = row0 + tok;
#pragma unroll
        for (int k = 0; k < 8; ++k) { const int pos = lbase[eid[k]] + lp[k];
            WSP(int, WS_EIDX)[row * 8 + k] = eid[k]; WSP(int, WS_POS)[row * 8 + k] = pos; WSP(float, WS_WTS)[row * 8 + k] = wk[k];
            WSP(int, WS_LIST)[eid[k] * 8192 + pos] = row; }
    }
}

__device__ __forceinline__ void phase8(const Frame& F, const LAS int* tb) {
    const int gw = F.vcu * 8 + F.wave, NGW = F.G * 8;
    const unsigned char* PO = WSP(unsigned char, WS_PO);
    for (int row = gw; row < NTOK; row += NGW) {
        const int b = row >> 11;
        size_t pr[9]; float w[9];
#pragma unroll
        for (int k = 0; k < 8; ++k) { const int e = WSP(int, WS_EIDX)[row * 8 + k], pos = WSP(int, WS_POS)[row * 8 + k]; w[k] = WSP(float, WS_WTS)[row * 8 + k] * (1.0f / PO8SCALE); pr[k] = ((size_t)tb[e] * 256 + pos) * 2048; }
        pr[8] = ((size_t)tb[64] * 256 + row) * 2048; w[8] = 1.0f / PO8SCALE;
        const float* gt2 = WSP(float, WS_MOD) + b * 6 * D + 5 * D;
#pragma unroll
        for (int j = 0; j < 2; ++j) {
            const int col = 16 * F.lane + 1024 * j; float a[16];
#pragma unroll
            for (int e = 0; e < 16; ++e) a[e] = 0.f;
#pragma unroll
            for (int k = 0; k < 9; ++k) {
                const u32x4 v = *(const u32x4*)(PO + pr[k] + col);
                const unsigned vv[4] = {v.x, v.y, v.z, v.w};
#pragma unroll
                for (int q = 0; q < 4; ++q) {
                    const f32x2 lo = __builtin_amdgcn_cvt_pk_f32_fp8((int)vv[q], false), hi = __builtin_amdgcn_cvt_pk_f32_fp8((int)vv[q], true);
                    a[4 * q] += w[k] * lo.x; a[4 * q + 1] += w[k] * lo.y; a[4 * q + 2] += w[k] * hi.x; a[4 * q + 3] += w[k] * hi.y;
                }
            }
            float* op = F.out + (size_t)row * D + col;
#pragma unroll
            for (int q = 0; q < 4; ++q) {
                const f32x4 x0 = *(const f32x4*)(op + 4 * q), g0 = *(const f32x4*)(gt2 + col + 4 * q);
                *(f32x4*)(op + 4 * q) = x0 + g0 * (f32x4){a[4 * q], a[4 * q + 1], a[4 * q + 2], a[4 * q + 3]};
            }
        }
    }
}

constexpr int N_PHASES = 11;
__global__ void __launch_bounds__(512, 2) mk_fwd(Params p) {
    extern __shared__ __attribute__((aligned(16))) unsigned char lds_raw[];
    Frame F;
    F.lds = (LAS unsigned char*)lds_raw; F.ws = p.ws; F.in = p.in; F.out = p.out;
    F.tid = threadIdx.x; F.lane = F.tid & 63; F.wave = __builtin_amdgcn_readfirstlane(F.tid >> 6);
    F.G = gridDim.x; { const int bx = blockIdx.x; F.vcu = (F.G % 8 == 0) ? (bx % 8) * (F.G / 8) + bx / 8 : bx; }
    volatile LAS unsigned* MISC = (volatile LAS unsigned*)(F.lds + MISC_OFF);
    if (F.tid < 64) MISC[F.tid] = 0u;
    __syncthreads();
    const int lo = p.ph_lo, hi = p.ph_hi;
    const bool multi = (hi - lo) > 1;
    XcdBarrier bar; bar.bar = (unsigned*)(p.ws + WS_CTL) + CW_BAR; bar.x = 0; bar.st = nullptr;
    if (multi) bar = xcd_barrier_post((unsigned*)(p.ws + WS_CTL) + CW_BAR, MISC + 8);
#ifndef PH_MASK
#define PH_MASK 0xffff
#endif
#define IN(k) (((PH_MASK >> (k)) & 1) && lo <= (k) && (k) < hi)
#define SEAM(k) do { if (IN(k) && IN((k) + 1)) xcd_barrier(bar); } while (0)
#define REP(k) for (int rep_ = 0; rep_ < ((((PROBE_MASK) >> (k)) & 1) ? 2 : 1); ++rep_)
    LAS int* mtab = (LAS int*)(F.lds + LDSX_OFF + 4096);

    if (IN(0)) REP(0) { phase0a(F); SEAM(0); }
    if (IN(1)) REP(1) { phase0b(F); SEAM(1); }
    if (IN(2)) REP(2) {
        const bool split = (F.G == 256);
        if (!split || (int)blockIdx.x < NG_INPROJ) {
            InProjP P; P.A = WSP(bf16_t, WS_H); P.Bt = WSP(bf16_t, WS_WIN_T); P.lda = D; P.G = split ? NG_INPROJ : F.G; P.c = blockIdx.x; P.ws = p.ws; P.gq = p.in[I_GQ]; P.gk = p.in[I_GK];
            pg8::gemm_phase(F.lds, P);
        } else conv_range3(F, CV_EARLY, CV_NT4 - CV_DEFER2, ((int)blockIdx.x - NG_INPROJ) * 8 + F.wave, (256 - NG_INPROJ) * 8);
        SEAM(2);
    }
    if (IN(3) && DUP(3)) {
        {
            CmpP P; P.A = WSP(bf16_t, WS_KV); P.Bt = WSP(bf16_t, WS_WCMP_T); P.lda = 1024; P.G = F.G; P.c = F.vcu; P.ws = p.ws;
            pg8::gemm_phase(F.lds, P);
        }
        if (F.G >= 128) {
            if (F.vcu < 64) gmlp_unit(F, F.vcu);
            else { for (int n = 64 + (F.vcu - 64); n < 512; n += F.G - 64) gmlp_unit(F, n);
                   __syncthreads(); conv_range(F, CV_NT4 - CV_DEFER - CV_DEFER2, CV_NT4 - CV_DEFER, (F.vcu - 64) * 8 + F.wave, (F.G - 64) * 8); }
        } else { for (int n = F.vcu; n < 512; n += F.G) gmlp_unit(F, n); __syncthreads(); conv_range(F, CV_NT4 - CV_DEFER - CV_DEFER2, CV_NT4 - CV_DEFER, F.vcu * 8 + F.wave, F.G * 8); }
        SEAM(3);
    }
    if (IN(3)) {
        {
            CmpP P; P.A = WSP(bf16_t, WS_KV); P.Bt = WSP(bf16_t, WS_WCMP_T); P.lda = 1024; P.G = F.G; P.c = F.vcu; P.ws = p.ws;
            pg8::gemm_phase(F.lds, P);
        }
        if (F.G >= 128) {
            if (F.vcu < 64) gmlp_unit(F, F.vcu);
            else { for (int n = 64 + (F.vcu - 64); n < 512; n += F.G - 64) gmlp_unit(F, n);
                   __syncthreads(); conv_range(F, CV_NT4 - CV_DEFER - CV_DEFER2, CV_NT4 - CV_DEFER, (F.vcu - 64) * 8 + F.wave, (F.G - 64) * 8); }
        } else { for (int n = F.vcu; n < 512; n += F.G) gmlp_unit(F, n); __syncthreads(); conv_range(F, CV_NT4 - CV_DEFER - CV_DEFER2, CV_NT4 - CV_DEFER, F.vcu * 8 + F.wave, F.G * 8); }
        SEAM(3);
    }
    if (IN(4)) REP(4) { phase2b(F); SEAM(4); }
    if (IN(5)) REP(5) {
        for (int n = F.vcu; n < 512; n += F.G) {
            int combo, i; if (n < 256) { combo = n >> 4; i = 31 - (n & 15); } else { combo = (n - 256) >> 4; i = n & 15; }
            attn_unit(F, combo >> 2, combo & 3, i);
        }
        SEAM(5);
    }
    if (IN(6) && DUP(6)) {
        OutProjP P; P.A = WSP(bf16_t, WS_OCAT); P.Bt = WSP(bf16_t, WS_WOUT_T); P.lda = D; P.G = F.G; P.c = blockIdx.x; P.ws = p.ws; P.x = p.in[I_X]; P.out = p.out; P.tab = (LAS f32x2*)(F.lds + LDSX_OFF);
        pg8::gemm_phase(F.lds, P); SEAM(6);
    }
    if (IN(6)) {
        OutProjP P; P.A = WSP(bf16_t, WS_OCAT); P.Bt = WSP(bf16_t, WS_WOUT_T); P.lda = D; P.G = F.G; P.c = blockIdx.x; P.ws = p.ws; P.x = p.in[I_X]; P.out = p.out; P.tab = (LAS f32x2*)(F.lds + LDSX_OFF);
        pg8::gemm_phase(F.lds, P); SEAM(6);
    }
    if (IN(7)) { for (int un = F.vcu; un < 256; un += F.G) router_unit(F, un); SEAM(7); }
    if (IN(8)) REP(8) {
        moe_table(F, mtab);
        { MoeUpP<false> P; P.A = WSP(unsigned char, WS_H); P.Bt = WSP(unsigned char, WS_WGU_T); P.lda = D; P.G = F.G; P.c = F.vcu; P.ws = p.ws; P.tb = mtab; P.c0 = 0; P.idtab = (LAS unsigned*)(F.lds + LDSX_OFF + 10240);
          pg8::gemm_phase(F.lds, P); }
        { MoeUpP<true> P; P.A = WSP(unsigned char, WS_H); P.Bt = WSP(unsigned char, WS_WGU_T); P.lda = D; P.G = F.G; P.c = F.vcu; P.ws = p.ws; P.tb = mtab; P.c0 = (mtab[66] * 4) % F.G; P.idtab = (LAS unsigned*)(F.lds + LDSX_OFF + 10240);
          pg8::gemm_phase(F.lds, P); }
        SEAM(8);
    }
    if (IN(9) && DUP(9)) {
        moe_table(F, mtab);
        { MoeDownP<false> P; P.A = WSP(unsigned char, WS_HID); P.Bt = WSP(unsigned char, WS_WD_T); P.lda = EDIM; P.G = F.G; P.c = F.vcu; P.ws = p.ws; P.tb = mtab; P.c0 = 0;
          pg8::gemm_phase(F.lds, P); }
        { MoeDownP<true> P; P.A = WSP(unsigned char, WS_HID); P.Bt = WSP(unsigned char, WS_WD_T); P.lda = EDIM; P.G = F.G; P.c = F.vcu; P.ws = p.ws; P.tb = mtab; P.c0 = (mtab[66] * 8) % F.G;
          pg8::gemm_phase(F.lds, P); } SEAM(9);
    }
    if (IN(9)) {
        moe_table(F, mtab);
        { MoeDownP<false> P; P.A = WSP(unsigned char, WS_HID); P.Bt = WSP(unsigned char, WS_WD_T); P.lda = EDIM; P.G = F.G; P.c = F.vcu; P.ws = p.ws; P.tb = mtab; P.c0 = 0;
          pg8::gemm_phase(F.lds, P); }
        { MoeDownP<true> P; P.A = WSP(unsigned char, WS_HID); P.Bt = WSP(unsigned char, WS_WD_T); P.lda = EDIM; P.G = F.G; P.c = F.vcu; P.ws = p.ws; P.tb = mtab; P.c0 = (mtab[66] * 8) % F.G;
          pg8::gemm_phase(F.lds, P); } SEAM(9);
    }
    if (IN(10)) { moe_table(F, mtab); phase8(F, mtab); }
#undef IN
#undef SEAM
}

extern "C" void kernel_launch(void* const* d_in, const int* in_sizes, int n_in, void* d_out, int out_size, void* d_ws, size_t ws_size, hipStream_t stream) {
    static int grid = 0;
    if (grid == 0) {
        if (n_in != 29 || out_size != NTOK * D || ws_size < WS_END) { fprintf(stderr, "kernel_launch: unexpected shapes (n_in %d out %d ws %zu)\n", n_in, out_size, ws_size); grid = -1; return; }
        int dev = 0, cus = 0, per_cu = 0;
        hipGetDevice(&dev); hipDeviceGetAttribute(&cus, hipDeviceAttributeMultiprocessorCount, dev);
        if (hipFuncSetAttribute((const void*)mk_fwd, hipFuncAttributeMaxDynamicSharedMemorySize, LDS_BYTES) != hipSuccess) { fprintf(stderr, "kernel_launch: hipFuncSetAttribute failed\n"); grid = -1; return; }
        if (hipOccupancyMaxActiveBlocksPerMultiprocessor(&per_cu, (const void*)mk_fwd, 512, LDS_BYTES) != hipSuccess || per_cu < 1) { fprintf(stderr, "kernel_launch: occupancy query says %d\n", per_cu); per_cu = 1; }
        (void)hipGetLastError();
        grid = cus;
    }
    if (grid < 0) return;
    hipMemsetAsync((char*)d_ws + WS_CTL, 0, CTL_BYTES, stream);
    Params p{};
    for (int i = 0; i < 29; ++i) p.in[i] = (const float*)d_in[i];
    p.out = (float*)d_out; p.ws = (unsigned char*)d_ws;
#if MK_N_LAUNCHES == 1
    p.ph_lo = 0; p.ph_hi = N_PHASES;
    void* args[] = {&p};
    hipError_t e = hipLaunchCooperativeKernel((const void*)mk_fwd, dim3(grid), dim3(512), args, LDS_BYTES, stream);
    if (e != hipSuccess) fprintf(stderr, "kernel_launch: cooperative launch failed: %s (grid %d)\n", hipGetErrorString(e), grid);
#else
    for (int ph = 0; ph < N_PHASES; ++ph) { p.ph_lo = ph; p.ph_hi = ph + 1; hipLaunchKernelGGL(mk_fwd, dim3(grid), dim3(512), LDS_BYTES, stream, p); }
#endif
}
```

```cpp
#include <hip/hip_runtime.h>
#include <hip/hip_cooperative_groups.h>
#include <cstdio>
#include <cstdint>
namespace cg = cooperative_groups;

#ifndef MK_N_LAUNCHES
#define MK_N_LAUNCHES 1
#endif

#ifndef PROBE_MASK
#define PROBE_MASK 0
#endif
#define DUP(k) ((((PROBE_MASK) >> (k)) & 1) != 0)
#define LAS __attribute__((address_space(3)))
#define GAS __attribute__((address_space(1)))
typedef unsigned short bf16_t;
typedef short bf16x8 __attribute__((ext_vector_type(8)));
typedef short s16x4 __attribute__((ext_vector_type(4)));
typedef float f32x4 __attribute__((ext_vector_type(4)));
typedef float f32x2 __attribute__((ext_vector_type(2)));
typedef float f32x16 __attribute__((ext_vector_type(16)));
typedef unsigned u32x4 __attribute__((ext_vector_type(4)));
typedef unsigned u32x2 __attribute__((ext_vector_type(2)));
typedef short v4i16_t __attribute__((ext_vector_type(4)));
typedef int v4i32 __attribute__((ext_vector_type(4)));
typedef int v8i32 __attribute__((ext_vector_type(8)));

constexpr int NB = 4, T = 2048, D = 2048, NTOK = NB * T;
constexpr int NH = 16, KVH = 4, HD = 64;
constexpr int NCMP = 127;
constexpr int NEXP = 64, TOPK = 8, EDIM = 512;
constexpr int IN_COLS = 4656, NIN_T = 19 * 256;
constexpr float EPS = 1e-6f;
constexpr float QSCALE = 0.125f * 1.4426950408889634f;
constexpr float NEGF = -1e30f;
constexpr float W8SCALE = 32.0f, H8SCALE = 4.0f, PO8SCALE = 16.0f;

constexpr size_t MiB = 1u << 20, KiB = 1024;
constexpr size_t WS_CTL = 0, CTL_BYTES = 1 * MiB;
constexpr size_t WS_MOD = 1 * MiB;
constexpr size_t WS_ROPE = 1 * MiB + 256 * KiB;
constexpr size_t WS_BIAS1 = 1 * MiB + 768 * KiB;
constexpr size_t WS_KCMP = 2 * MiB;
constexpr size_t WS_VCMP = 2 * MiB + 256 * KiB;
constexpr size_t WS_OSSN = 2 * MiB + 512 * KiB;
constexpr size_t WS_OSSG = 2 * MiB + 768 * KiB;
constexpr size_t WS_VSS = 3 * MiB + 512 * KiB;
constexpr size_t WS_EIDX = 5 * MiB;
constexpr size_t WS_POS = 5 * MiB + 256 * KiB;
constexpr size_t WS_WTS = 5 * MiB + 512 * KiB;
constexpr size_t WS_LIST = 6 * MiB;
constexpr size_t WS_GATE = 8 * MiB;
constexpr size_t WS_HIDC = 10 * MiB;
constexpr size_t WS_KV = 12 * MiB;
constexpr size_t KV_STRIDE = 4 * MiB;
constexpr size_t WS_Q = 36 * MiB;
constexpr size_t WS_U = 52 * MiB;
constexpr size_t WS_V = 68 * MiB;
constexpr size_t WS_H = 84 * MiB;
constexpr size_t WS_OCAT = 116 * MiB;
constexpr size_t WS_WIN_T = 148 * MiB;
constexpr size_t WS_WOUT_T = 168 * MiB;
constexpr size_t WS_WCMP_T = 176 * MiB;
constexpr size_t WS_WGU_T = 178 * MiB;
constexpr size_t WS_WD_T = 438 * MiB;
constexpr size_t WS_HID = 568 * MiB;
constexpr size_t WS_PO = 656 * MiB;
constexpr size_t WS_END = 1008 * MiB;
constexpr int CW_CNT = 256;
constexpr int CW_BAR = 4096;

constexpr int RING_BYTES = 131072;
constexpr int LDSX_OFF = RING_BYTES;
constexpr int MISC_OFF = RING_BYTES + 12288;
constexpr int LDS_BYTES = 147456;

__device__ __forceinline__ unsigned cvt_pk_bf16(float lo, float hi) { unsigned r; asm volatile("v_cvt_pk_bf16_f32 %0, %1, %2" : "=v"(r) : "v"(lo), "v"(hi)); return r; }
__device__ __forceinline__ unsigned pk4_fp8(float a, float b, float c, float d) { int w = 0; w = __builtin_amdgcn_cvt_pk_fp8_f32(a, b, w, false); w = __builtin_amdgcn_cvt_pk_fp8_f32(c, d, w, true); return (unsigned)w; }
__device__ __forceinline__ float bf2f(unsigned short h) { return __uint_as_float(((unsigned)h) << 16); }
__device__ __forceinline__ float bflo(unsigned w) { return __uint_as_float(w << 16); }
__device__ __forceinline__ float bfhi(unsigned w) { return __uint_as_float(w & 0xffff0000u); }
__device__ __forceinline__ float fexp2(float x) { return __builtin_amdgcn_exp2f(x); }
__device__ __forceinline__ float frcp(float x) { return __builtin_amdgcn_rcpf(x); }
__device__ __forceinline__ float sigmoidf_(float x) { return frcp(1.0f + fexp2(-1.4426950408889634f * x)); }
__device__ __forceinline__ float siluf_(float x) { return x * sigmoidf_(x); }
__device__ __forceinline__ float gelu_tanh(float x) {
    const float u = x * (1.0f + 0.044715f * x * x);
    return x * frcp(1.0f + fexp2(u * (-2.0f * 0.7978845608028654f * 1.4426950408889634f)));
}
__device__ __forceinline__ float wave_sum(float v) {
#pragma unroll
    for (int o = 1; o < 64; o <<= 1) v += __shfl_xor(v, o);
    return v;
}
__device__ __forceinline__ void rope_cs(float pos, int i, float& c, float& s) {
    const float fr = exp2f(-(float)i * (13.287712379549449f / 32.0f));
    const float ang = pos * fr;
    const double rev = (double)ang * 0.15915494309189535;
    const double fr_ = rev - rint(rev);
    const float r = (float)(fr_ * 6.283185307179586);
    c = cosf(r); s = sinf(r);
}

#define XB_TMO      128
#define XB_XCNT(j)  (256  + 64 * (j))
#define XB_XSUB(j)  (1280 + 64 * (j))
#define XB_XGEN(j)  (2304 + 64 * (j))
#define XB_TOP      3328
#define XB_TOPGEN   3392
#define XCD_BAR_WORDS 3456
#define XB_SPIN_CAP (1u << 22)
__device__ __forceinline__ unsigned xb_ld(unsigned* p)              { return __hip_atomic_load(p, __ATOMIC_RELAXED, __HIP_MEMORY_SCOPE_AGENT); }
__device__ __forceinline__ unsigned xb_add(unsigned* p, unsigned v) { return __hip_atomic_fetch_add(p, v, __ATOMIC_RELAXED, __HIP_MEMORY_SCOPE_AGENT); }
__device__ __forceinline__ unsigned xb_xcc_id() { return (unsigned)__builtin_amdgcn_s_getreg((3 << 11) | 20) & 0xFu; }
#define XB_SPIN(cond, bar) do { unsigned _sp = 0; while (cond) { __builtin_amdgcn_s_sleep(1); \
    if ((++_sp & 255u) == 0u) { if (xb_ld(&(bar)[XB_TMO])) break; if (_sp > XB_SPIN_CAP) { atomicAdd(&(bar)[XB_TMO], 1u); break; } } } } while (0)
struct XcdBarrier { unsigned* bar; unsigned x; volatile LAS unsigned* st; };
__device__ __forceinline__ XcdBarrier xcd_barrier_post(unsigned* bar, volatile LAS unsigned* st) {
    XcdBarrier b; b.bar = bar; b.x = xb_xcc_id(); b.st = st;
    if (threadIdx.x == 0) (void)xb_add(&bar[XB_XCNT(b.x)], 1u);
    return b;
}
__device__ __forceinline__ void xcd_barrier_complete(unsigned* bar, unsigned x, unsigned& nloc, unsigned& nx) {
    const unsigned G = gridDim.x * gridDim.y * gridDim.z;
    unsigned sum, cnt, mine, sp = 0u;
    for (;;) {
        sum = 0u; cnt = 0u; mine = 0u;
#pragma unroll
        for (unsigned j = 0; j < 16; ++j) { const unsigned c = xb_ld(&bar[XB_XCNT(j)]); sum += c; cnt += (c > 0u) ? 1u : 0u; mine = (j == x) ? c : mine; }
        if (sum == G) break;
        __builtin_amdgcn_s_sleep(1);
        if ((++sp & 255u) == 0u) { if (xb_ld(&bar[XB_TMO])) break; if (sp > XB_SPIN_CAP) { atomicAdd(&bar[XB_TMO], 1u); break; } }
    }
    nloc = mine > 0u ? mine : 1u; nx = cnt > 0u ? cnt : 1u;
}
__device__ __forceinline__ void xcd_barrier(const XcdBarrier& b) {
    asm volatile("s_waitcnt vmcnt(0)" ::: "memory");
    __syncthreads();
    if (threadIdx.x == 0) {
        unsigned* bar = b.bar;
        __builtin_amdgcn_s_waitcnt(0);
        unsigned nloc = b.st[0], nx = b.st[1];
        if (nloc == 0u) { xcd_barrier_complete(bar, b.x, nloc, nx); b.st[0] = nloc; b.st[1] = nx; }
        const unsigned old = xb_add(&bar[XB_XSUB(b.x)], 1u);
        const unsigned gen = old / nloc;
        if (old + 1u == (gen + 1u) * nloc) {
            __builtin_amdgcn_fence(__ATOMIC_RELEASE, "agent");
            asm volatile("s_waitcnt vmcnt(0)" ::: "memory");
            const unsigned og = xb_add(&bar[XB_TOP], 1u);
            const unsigned tg = og / nx;
            if (og + 1u == (tg + 1u) * nx) xb_add(&bar[XB_TOPGEN], 1u);
            else XB_SPIN(xb_ld(&bar[XB_TOPGEN]) == tg, bar);
            __builtin_amdgcn_fence(__ATOMIC_ACQUIRE, "agent");
            xb_add(&bar[XB_XGEN(b.x)], 1u);
            asm volatile("s_waitcnt vmcnt(0)" ::: "memory");
        } else {
            XB_SPIN(xb_ld(&bar[XB_XGEN(b.x)]) == gen, bar);
            __builtin_amdgcn_fence(__ATOMIC_ACQUIRE, "agent");
            asm volatile("s_waitcnt vmcnt(0)" ::: "memory");
        }
    }
    __syncthreads();
}

struct Params { const float* in[29]; float* out; unsigned char* ws; int ph_lo, ph_hi; };
enum { I_X = 0, I_C, I_WADA, I_BADA, I_GN1, I_WIN, I_GQ, I_GK, I_CPK, I_CPV, I_CW1K, I_CW2K, I_CW1V, I_CW2V, I_GGV, I_WSP, I_BSP, I_GON, I_GOG, I_WOUT, I_GN2,
       I_WR, I_RB, I_WG, I_WU, I_WD, I_SG, I_SU, I_SD };

namespace pg8 {
constexpr int BM = 256, BK = 64, HALF = 128, HTB = HALF * BK * 2, NXCD = 8, WGM = 8;
__device__ __forceinline__ int lds_byte(int r, int c) { const int st = (r >> 4) * 2 + (c >> 5), rr = r & 15, cc = c & 31, ob = rr * 64 + cc * 2; return st * 1024 + (ob ^ (((ob >> 9) & 1) << 5)); }
__device__ __forceinline__ void stage_rc(int b, int& R, int& C) { const int st = b / 1024, sb = b % 1024, swz = sb ^ (((sb >> 9) & 1) << 5); R = (st >> 1) * 16 + swz / 64; C = (st & 1) * 32 + (swz % 64) / 2; }
__device__ __forceinline__ int perm32(int rho) { const int n = rho >> 4, i = rho & 15; return 8 * (i >> 2) + 4 * n + (i & 3); }
struct Unit { int pm, pn, e, aux; };

__device__ __forceinline__ bool dense_next(int i, int G, int c, int nM, int nN, Unit& u) {
    const int nwg = nM * nN; const long L = (long)i * G + c; if (L >= nwg) return false;
    int wgid = (int)L; { const int q = nwg / NXCD, r = nwg % NXCD, xcd = wgid % NXCD, off = wgid / NXCD; wgid = (xcd < r ? xcd * (q + 1) : r * (q + 1) + (xcd - r) * q) + off; }
    const int nig = WGM * nN, gid = wgid / nig, fm = gid * WGM, gsz = (nM - fm) < WGM ? (nM - fm) : WGM;
    u.pm = fm + ((wgid % nig) % gsz); u.pn = (wgid % nig) / gsz; u.e = 0; u.aux = 0; return true;
}

template <class P>
__device__ __forceinline__ void gemm_phase(LAS unsigned char* lds, const P& prm) {
    const int tid = threadIdx.x, wid = __builtin_amdgcn_readfirstlane(tid >> 6), lane = tid & 63, wr = wid >> 2, wc = wid & 3, fr = lane & 15, fq = lane >> 4;
    constexpr int K = P::K, ESZ = P::ESZ, nt = (K * ESZ) / 128;
    const unsigned lda2 = (unsigned)prm.lda * (unsigned)ESZ;
    int Rl[2], Cl[2]; unsigned voffB[2];
#pragma unroll
    for (int i = 0; i < 2; ++i) { int R, C; stage_rc(tid * 16 + i * 8192, R, C); Rl[i] = R; Cl[i] = C; const int Rb = (R & ~31) + perm32(R & 31); voffB[i] = (unsigned)(Rb * P::LDB * ESZ + C * 2); }
    const size_t kstep = (size_t)(BK * 2);
    const size_t hstepB = (size_t)HALF * P::LDB * ESZ;
    const unsigned ldsw = (unsigned)wid * 1024u;
    const int fcol = fq * 8;
    const int aoff = lds_byte(wr * 64 + fr, fcol), boff = lds_byte(wc * 32 + fr, fcol);
    constexpr int fkst = 1024;
#define PG8_SA(b, h) (((b) * 2 + (h)) * HTB)
#define PG8_SB(b, h) ((4 + (b) * 2 + (h)) * HTB)
#define PG8_STAGE(bufoff, gbase, voff) do { _Pragma("unroll") for (int _i = 0; _i < 2; ++_i) \
        __builtin_amdgcn_global_load_lds((const unsigned*)((const char*)(gbase) + (voff)[_i]), (LAS unsigned*)(lds + (bufoff) + ldsw + _i * 8192), 16, 0, 0); } while (0)
#define PG8_LDA(dst, b, h) do { _Pragma("unroll") for (int m = 0; m < 4; ++m) _Pragma("unroll") for (int k = 0; k < 2; ++k) dst[m][k] = *(const LAS bf16x8*)(lds + PG8_SA(b, h) + aoff + m * 2048 + k * fkst); } while (0)
#define PG8_LDB(dst, b, h) do { _Pragma("unroll") for (int n = 0; n < 2; ++n) _Pragma("unroll") for (int k = 0; k < 2; ++k) dst[n][k] = *(const LAS bf16x8*)(lds + PG8_SB(b, h) + boff + n * 2048 + k * fkst); } while (0)
#define PG8_MMA(ai, bj, At, Bt) do { __builtin_amdgcn_s_setprio(1); \
        if constexpr (ESZ == 2) { _Pragma("unroll") for (int m = 0; m < 4; ++m) _Pragma("unroll") for (int n = 0; n < 2; ++n) _Pragma("unroll") for (int k = 0; k < 2; ++k) \
            acc[ai][bj][m][n] = __builtin_amdgcn_mfma_f32_16x16x32_bf16(Bt[n][k], At[m][k], acc[ai][bj][m][n], 0, 0, 0); } \
        else { _Pragma("unroll") for (int m = 0; m < 4; ++m) _Pragma("unroll") for (int n = 0; n < 2; ++n) { \
            const v8i32 a8_ = __builtin_shufflevector(__builtin_bit_cast(v4i32, At[m][0]), __builtin_bit_cast(v4i32, At[m][1]), 0, 1, 2, 3, 4, 5, 6, 7); \
            const v8i32 b8_ = __builtin_shufflevector(__builtin_bit_cast(v4i32, Bt[n][0]), __builtin_bit_cast(v4i32, Bt[n][1]), 0, 1, 2, 3, 4, 5, 6, 7); \
            acc[ai][bj][m][n] = __builtin_amdgcn_mfma_scale_f32_16x16x128_f8f6f4(b8_, a8_, acc[ai][bj][m][n], 0, 0, 0, 0x7f7f7f7f, 0, 0x7f7f7f7f); } } \
        __builtin_amdgcn_s_setprio(0); } while (0)
#define PG8_WAIT_V(n) asm volatile("s_waitcnt vmcnt(" #n ")" ::: "memory")
#define PG8_WAIT_L(n) asm volatile("s_waitcnt lgkmcnt(" #n ")" ::: "memory")
#define PG8_WAIT_VK() do { if constexpr (P::HALFONLY) asm volatile("s_waitcnt vmcnt(6)" ::: "memory"); else asm volatile("s_waitcnt vmcnt(8)" ::: "memory"); } while (0)
#define PG8_BAR __builtin_amdgcn_s_barrier()
#define PG8_SCHED __builtin_amdgcn_sched_barrier(0)
    Unit cur, nxt; int ui = 0;
    if (!prm.next(0, cur)) return;
    f32x4 acc[2][2][4][2];
#pragma unroll
    for (int a = 0; a < 2; ++a)
#pragma unroll
        for (int b = 0; b < 2; ++b)
#pragma unroll
            for (int m = 0; m < 4; ++m)
#pragma unroll
                for (int n = 0; n < 2; ++n) acc[a][b][m][n] = (f32x4){0.f, 0.f, 0.f, 0.f};
    bf16x8 At[4][2], B0[2][2], B1[2][2];
    const char* Ab = (const char*)prm.A;
    unsigned offA0[2], offA1[2];
#pragma unroll
    for (int i = 0; i < 2; ++i) { offA0[i] = prm.row_id(cur, Rl[i]) * lda2 + (unsigned)Cl[i] * 2u + prm.a_koff(cur); offA1[i] = prm.row_id(cur, Rl[i] + HALF) * lda2 + (unsigned)Cl[i] * 2u + prm.a_koff(cur); }
    const char* cB = prm.b_base(cur);
    PG8_STAGE(PG8_SB(0, 0), cB, voffB); PG8_STAGE(PG8_SB(0, 1), cB + hstepB, voffB); PG8_STAGE(PG8_SA(0, 0), Ab, offA0); if constexpr (!P::HALFONLY) PG8_STAGE(PG8_SA(0, 1), Ab, offA1);
    if (wr == 1) PG8_BAR;
    if constexpr (P::HALFONLY) PG8_WAIT_V(0); else PG8_WAIT_V(2);
    PG8_BAR;
    PG8_STAGE(PG8_SB(1, 0), cB + kstep, voffB); PG8_STAGE(PG8_SA(1, 0), Ab + kstep, offA0); PG8_STAGE(PG8_SB(1, 1), cB + hstepB + kstep, voffB);
    PG8_WAIT_V(6); PG8_BAR;
    for (;;) {
        const bool has_next = prm.next(ui + 1, nxt);
        const char* nB = has_next ? prm.b_base(nxt) : cB;
        prm.unit_begin(cur, ui);
        unsigned idn[4] = {0u, 0u, 0u, 0u};
#pragma unroll 1
        for (int t = 0; t < nt; t += 2) {
            const bool last = (t == nt - 2);
            if (t == nt - 4 && has_next) {
                if constexpr (P::IDLDS) prm.ids_prefetch(nxt, wid, lane);
                else {
#pragma unroll
                    for (int i = 0; i < 2; ++i) { idn[i] = prm.row_id(nxt, Rl[i]); idn[2 + i] = prm.row_id(nxt, Rl[i] + HALF); }
                }
            }
            const char* a1 = Ab + (size_t)(t + 1) * kstep;
            const char* a2 = last ? Ab : Ab + (size_t)(t + 2) * kstep; const char* b2 = last ? nB : cB + (size_t)(t + 2) * kstep;
            const char* a3 = a2 + kstep; const char* b3 = b2 + kstep;
            if constexpr (P::MIDK) { if (t == nt / 2) prm.midk(acc, cur, ui, wr, fr); }
            PG8_LDB(B0, 0, 0); PG8_LDB(B1, 0, 1); PG8_SCHED; PG8_LDA(At, 0, 0); if constexpr (!P::HALFONLY) PG8_STAGE(PG8_SA(1, 1), a1, offA1);
            if (last && has_next) {
                if constexpr (P::IDLDS) {
#pragma unroll
                    for (int i = 0; i < 2; ++i) { idn[i] = prm.ids_read(nxt, Rl[i]); idn[2 + i] = prm.ids_read(nxt, Rl[i] + HALF); }
                }
#pragma unroll
                for (int i = 0; i < 2; ++i) { offA0[i] = idn[i] * lda2 + (unsigned)Cl[i] * 2u + prm.a_koff(nxt); offA1[i] = idn[2 + i] * lda2 + (unsigned)Cl[i] * 2u + prm.a_koff(nxt); }
            }
            PG8_WAIT_VK(); PG8_WAIT_L(0); PG8_BAR; PG8_MMA(0, 0, At, B0); PG8_MMA(0, 1, At, B1); PG8_BAR; PG8_SCHED;
            if constexpr (!P::HALFONLY) PG8_LDA(At, 0, 1); PG8_STAGE(PG8_SB(0, 0), b2, voffB); PG8_STAGE(PG8_SB(0, 1), b2 + hstepB, voffB); PG8_STAGE(PG8_SA(0, 0), a2, offA0);
            PG8_WAIT_VK(); PG8_WAIT_L(0); PG8_BAR; if constexpr (!P::HALFONLY) { PG8_MMA(1, 0, At, B0); PG8_MMA(1, 1, At, B1); } PG8_BAR; PG8_SCHED;
            PG8_LDB(B0, 1, 0); PG8_LDB(B1, 1, 1); PG8_SCHED; PG8_LDA(At, 1, 0); if constexpr (!P::HALFONLY) PG8_STAGE(PG8_SA(0, 1), a2, offA1);
            PG8_WAIT_VK(); PG8_WAIT_L(0); PG8_BAR; PG8_MMA(0, 0, At, B0); PG8_MMA(0, 1, At, B1); PG8_BAR; PG8_SCHED;
            if constexpr (!P::HALFONLY) PG8_LDA(At, 1, 1); PG8_STAGE(PG8_SB(1, 0), b3, voffB); PG8_STAGE(PG8_SB(1, 1), b3 + hstepB, voffB); PG8_STAGE(PG8_SA(1, 0), a3, offA0);
            PG8_WAIT_VK(); PG8_WAIT_L(0); PG8_BAR; if constexpr (!P::HALFONLY) { PG8_MMA(1, 0, At, B0); PG8_MMA(1, 1, At, B1); } PG8_BAR; PG8_SCHED;
        }
        if (wr == 0) PG8_BAR;
        prm.epi(acc, cur, ui, wr, wc, fr, fq);
        if (DUP(16)) { asm volatile("" ::: "memory"); prm.epi(acc, cur, ui, wr, wc, fr, fq); }
        if (!has_next) break;
#pragma unroll
        for (int a = 0; a < 2; ++a)
#pragma unroll
            for (int b = 0; b < 2; ++b)
#pragma unroll
                for (int m = 0; m < 4; ++m)
#pragma unroll
                    for (int n = 0; n < 2; ++n) acc[a][b][m][n] = (f32x4){0.f, 0.f, 0.f, 0.f};
        cur = nxt; cB = nB; ++ui;
        if (wr == 1) PG8_BAR;
    }
    PG8_WAIT_V(0);
    PG8_BAR;
#undef PG8_SA
#undef PG8_SB
#undef PG8_STAGE
#undef PG8_LDA
#undef PG8_LDB
#undef PG8_MMA
#undef PG8_WAIT_V
#undef PG8_WAIT_L
#undef PG8_WAIT_VK
#undef PG8_BAR
#undef PG8_SCHED
}
}
using pg8::Unit;
typedef f32x4 Acc[2][2][4][2];

struct Frame {
    LAS unsigned char* lds;
    unsigned char* ws;
    const float* const* in;
    float* out;
    int tid, lane, wave, G, vcu;
};
#define WSP(T_, off) ((T_*)(F.ws + (off)))

struct ConvItem { const float* src; int ldn; int k0; int n0; bf16_t* dst; int Kd; int drow0; int mode; int nvalid; int fp8; const float* rs0; const float* rs1; };
constexpr int CV_WIN = 16 * 38, CV_WOUT = 256, CV_CMP = 64, CV_GU = 65 * 128, CV_DN = 65 * 64;
constexpr int CV_TOTAL = CV_WIN + CV_WOUT + CV_CMP + CV_GU + CV_DN;
__device__ __forceinline__ void conv_decode(const Frame& F, int it, ConvItem& c) {
    c.mode = 0; c.nvalid = 128; c.fp8 = 0; c.rs0 = nullptr; c.rs1 = nullptr;
    if (it < CV_WIN) {
        const int kb = it / 38, nb = it % 38; c.src = F.in[I_WIN]; c.ldn = IN_COLS; c.k0 = kb * 128; c.dst = WSP(bf16_t, WS_WIN_T); c.Kd = 2048;
        if (nb < 20) { c.n0 = nb * 128; c.drow0 = (nb >> 1) * 256; c.mode = 1 + (nb & 1); }
        else if (nb < 28) { c.n0 = 2608 + (nb - 20) * 128; c.drow0 = 2560 + (nb - 20) * 128; }
        else if (nb < 36) { c.n0 = 3632 + (nb - 28) * 128; c.drow0 = 3584 + (nb - 28) * 128; }
        else if (nb == 36) { c.n0 = 2560; c.drow0 = 4608; c.nvalid = 48; }
        else { c.n0 = 2560; c.drow0 = 4736; c.nvalid = 0; }
        return;
    }
    it -= CV_WIN;
    if (it < CV_WOUT) { const int kb = it / 16, nb = it % 16; c.src = F.in[I_WOUT]; c.ldn = 2048; c.k0 = kb * 128; c.n0 = nb * 128; c.dst = WSP(bf16_t, WS_WOUT_T); c.Kd = 2048; c.drow0 = nb * 128;
        c.rs0 = F.in[I_GON]; c.rs1 = F.in[I_GOG]; return; }
    it -= CV_WOUT;
    if (it < CV_CMP) { const int kv = it / 32, r = it % 32, kb = r / 2, nb = r % 2; c.src = F.in[kv ? I_CW1V : I_CW1K]; c.ldn = 256; c.k0 = kb * 128; c.n0 = nb * 128;
        c.dst = WSP(bf16_t, WS_WCMP_T) + (size_t)kv * 256 * 2048; c.Kd = 2048; c.drow0 = nb * 128; return; }
    it -= CV_CMP;
    if (it < CV_GU) { const int e = it / 128, r = it % 128, up = r / 64, kb = (r % 64) / 4, nb = r % 4;
        c.src = (e < 64) ? F.in[up ? I_WU : I_WG] + (size_t)e * 2048 * 512 : F.in[up ? I_SU : I_SG];
        c.ldn = 512; c.k0 = kb * 128; c.n0 = nb * 128; c.dst = (bf16_t*)(WSP(unsigned char, WS_WGU_T) + (size_t)e * 1024 * 2048); c.Kd = 2048; c.drow0 = nb * 256 + up * 128; c.fp8 = 1; return; }
    it -= CV_GU;
    { const int e = it / 64, r = it % 64, kb = r / 16, nb = r % 16;
      c.src = (e < 64) ? F.in[I_WD] + (size_t)e * 512 * 2048 : F.in[I_SD];
      c.ldn = 2048; c.k0 = kb * 128; c.n0 = nb * 128; c.dst = (bf16_t*)(WSP(unsigned char, WS_WD_T) + (size_t)e * 2048 * 512); c.Kd = 512; c.drow0 = nb * 128; c.fp8 = 1; c.mode = 3; }
}
__device__ __forceinline__ void conv_load(const ConvItem& c, int sub, int lane, f32x4 (&v)[16]) {
    const int n4 = lane & 15, kq = lane >> 4, nl = 64 * (sub & 1) + 4 * n4;
    const bool ok = nl < c.nvalid;
    if (c.fp8) {
        const float* s = c.src + (size_t)(c.k0 + 64 * (sub >> 1) + 4 * kq) * c.ldn + c.n0 + nl;
#pragma unroll
        for (int i = 0; i < 4; ++i)
#pragma unroll
            for (int j = 0; j < 4; ++j) v[4 * i + j] = __builtin_nontemporal_load((const f32x4*)(s + (size_t)(16 * i + j) * c.ldn));
        return;
    }
    const float* s = c.src + (size_t)(c.k0 + 64 * (sub >> 1) + 2 * kq) * c.ldn + c.n0 + nl;
#pragma unroll
    for (int i = 0; i < 8; ++i) {
        v[2 * i] = ok ? __builtin_nontemporal_load((const f32x4*)(s + (size_t)(8 * i) * c.ldn)) : (f32x4){0.f, 0.f, 0.f, 0.f};
        v[2 * i + 1] = ok ? __builtin_nontemporal_load((const f32x4*)(s + (size_t)(8 * i + 1) * c.ldn)) : (f32x4){0.f, 0.f, 0.f, 0.f};
    }
}
__device__ __forceinline__ void conv_process(const ConvItem& c, int sub, int lane, const f32x4 (&v)[16], LAS unsigned* tile) {
    const int n4 = lane & 15, kq = lane >> 4, kb = c.k0 + 64 * (sub >> 1);
    if (c.fp8) {
#pragma unroll
        for (int i = 0; i < 4; ++i)
#pragma unroll
            for (int cc = 0; cc < 4; ++cc) tile[(4 * n4 + cc) * 129 + 4 * i + kq] = pk4_fp8(v[4 * i][cc] * W8SCALE, v[4 * i + 1][cc] * W8SCALE, v[4 * i + 2][cc] * W8SCALE, v[4 * i + 3][cc] * W8SCALE);
        return;
    }
#pragma unroll
    for (int i = 0; i < 8; ++i) {
        float s0 = 1.f, s1 = 1.f;
        if (c.rs0) { const int k = kb + 8 * i + 2 * kq; s0 = (k < 1024) ? c.rs0[k] : c.rs1[k - 1024]; s1 = (k + 1 < 1024) ? c.rs0[k + 1] : c.rs1[k + 1 - 1024]; }
#pragma unroll
        for (int cc = 0; cc < 4; ++cc) tile[(4 * n4 + cc) * 33 + 4 * i + kq] = cvt_pk_bf16(v[2 * i][cc] * s0, v[2 * i + 1][cc] * s1);
    }
#pragma unroll
    for (int j = 0; j < 8; ++j) {
        const int row = (lane >> 3) + 8 * j, c8 = lane & 7;
        const LAS unsigned* sp = tile + row * 33 + 4 * c8;
        u32x4 o; o.x = sp[0]; o.y = sp[1]; o.z = sp[2]; o.w = sp[3];
        const int n = 64 * (sub & 1) + row;
        int drow = c.drow0 + n;
        if (c.mode) { const int l = (c.mode - 1) * 128 + n, wc = l >> 6, bj = (l >> 5) & 1, jj = l & 31; drow = c.drow0 + 128 * bj + 32 * wc + jj; }
        __builtin_nontemporal_store(o, (u32x4*)(c.dst + (size_t)drow * c.Kd + kb + 8 * c8));
    }
}
template <int R>
__device__ __forceinline__ void gemv_item(const Frame& F, const LAS float* a_lds, LAS float* red, const float* W, int ldn, int n0, const float* bias, float* out, int ldo) {
    const int ks = F.tid >> 4, c4 = F.tid & 15;
    float acc[R][4];
#pragma unroll
    for (int r = 0; r < R; ++r) { acc[r][0] = 0.f; acc[r][1] = 0.f; acc[r][2] = 0.f; acc[r][3] = 0.f; }
    const float* wp = W + (size_t)(ks * 64) * ldn + n0 + 4 * c4;
#pragma unroll 16
    for (int kk = 0; kk < 64; ++kk) {
        const f32x4 w = *(const f32x4*)(wp + (size_t)kk * ldn);
#pragma unroll
        for (int r = 0; r < R; ++r) { const float a = a_lds[r * 2048 + ks * 64 + kk]; acc[r][0] += a * w.x; acc[r][1] += a * w.y; acc[r][2] += a * w.z; acc[r][3] += a * w.w; }
    }
#pragma unroll
    for (int r = 0; r < R; ++r) *(LAS f32x4*)(red + (ks * R + r) * 64 + 4 * c4) = (f32x4){acc[r][0], acc[r][1], acc[r][2], acc[r][3]};
    __syncthreads();
    if (F.tid < R * 64) {
        const int r = F.tid >> 6, n = F.tid & 63; float s = bias ? bias[n0 + n] : 0.f;
        for (int k = 0; k < 32; ++k) s += red[(k * R + r) * 64 + n];
        out[(size_t)r * ldo + n0 + n] = s;
    }
    __syncthreads();
}
constexpr int CV_NT4 = CV_TOTAL * 4;
constexpr int CV_DEFER = 0;
constexpr int CV_EARLY = 76 * 32;
constexpr int CV_EARLY_ALL = 76 * 32 + 32 * 32 + 2 * 4 * 32;
constexpr int NG_INPROJ = 132;
constexpr int CV_DEFER2 = 0;
__device__ __forceinline__ void tile_decode(int T, int& item, int& sub) {
    constexpr int T_WIN = 76 * 32, T_WOUT = 32 * 32, T_CMP = 2 * 4 * 32, T_GU = 65 * 2 * 8 * 32;
    int kb, nb;
    if (T < T_WIN) { kb = T & 31; nb = T >> 5; item = (kb >> 1) * 38 + (nb >> 1); }
    else if ((T -= T_WIN) < T_WOUT) { kb = T & 31; nb = T >> 5; item = CV_WIN + (kb >> 1) * 16 + (nb >> 1); }
    else if ((T -= T_WOUT) < T_CMP) { kb = T & 31; nb = (T >> 5) & 3; const int kv = T >> 7; item = CV_WIN + CV_WOUT + kv * 32 + (kb >> 1) * 2 + (nb >> 1); }
    else if ((T -= T_CMP) < T_GU) { kb = T & 31; nb = (T >> 5) & 7; const int eu = T >> 8; item = CV_WIN + CV_WOUT + CV_CMP + eu * 64 + (kb >> 1) * 4 + (nb >> 1); }
    else { T -= T_GU; kb = T & 7; nb = (T >> 3) & 31; const int e = T >> 8; item = CV_WIN + CV_WOUT + CV_CMP + CV_GU + e * 64 + (kb >> 1) * 16 + (nb >> 1); }
    sub = ((kb & 1) << 1) | (nb & 1);
}
__device__ __forceinline__ void conv_coop_store(const ConvItem& c0, int s0, int tid, const LAS unsigned* img) {
    unsigned char* d8 = (unsigned char*)c0.dst; const int kbase = c0.k0 + 64 * (s0 >> 1);
#pragma unroll
    for (int q = 0; q < 4; ++q) {
        const int ch = tid + 512 * q, row = ch >> 5, c16 = ch & 31;
        const LAS unsigned* sp = img + row * 129 + 4 * c16;
        u32x4 o; o.x = sp[0]; o.y = sp[1]; o.z = sp[2]; o.w = sp[3];
        int drow = c0.drow0 + 64 * (s0 & 1) + row;
        if (c0.mode == 3) { const int L = drow & 255; drow = (drow & ~255) + 128 * ((L >> 3) & 1) + 32 * (L >> 6) + 8 * ((L >> 4) & 3) + (L & 7); }
        __builtin_nontemporal_store(o, (u32x4*)(d8 + (size_t)drow * c0.Kd + kbase + 16 * c16));
    }
}
__device__ __forceinline__ void conv_range(const Frame& F, int t0, int t1, int wid, int nw) {
    LAS unsigned* tile = (LAS unsigned*)F.lds + F.wave * (64 * 33);
    LAS unsigned* img0 = (LAS unsigned*)(F.lds + 67584);
    int ta = t0 + wid; const int te = t1; int par = 0;
    ConvItem ca, cb, c0; f32x4 va[16], vb[16]; int ia, sa, ib, sb, i0, s0;
    if (ta < te) { tile_decode(ta, ia, sa); conv_decode(F, ia, ca); conv_load(ca, sa, F.lane, va); }
    while (ta < te) {
        const int tb = ta + nw;
        if (tb < te) { tile_decode(tb, ib, sb); conv_decode(F, ib, cb); conv_load(cb, sb, F.lane, vb); }
        if (ca.fp8) {
            LAS unsigned* img = img0 + par * (64 * 129);
            conv_process(ca, sa, F.lane, va, img + 16 * F.wave);
            __syncthreads();
            tile_decode(ta - F.wave, i0, s0); conv_decode(F, i0, c0); conv_coop_store(c0, s0, F.tid, img); par ^= 1;
        } else conv_process(ca, sa, F.lane, va, tile);
        if (tb >= te) break;
        ta = tb + nw;
        if (ta < te) { tile_decode(ta, ia, sa); conv_decode(F, ia, ca); conv_load(ca, sa, F.lane, va); }
        if (cb.fp8) {
            LAS unsigned* img = img0 + par * (64 * 129);
            conv_process(cb, sb, F.lane, vb, img + 16 * F.wave);
            __syncthreads();
            tile_decode(tb - F.wave, i0, s0); conv_decode(F, i0, c0); conv_coop_store(c0, s0, F.tid, img); par ^= 1;
        } else conv_process(cb, sb, F.lane, vb, tile);
    }
}
__device__ __forceinline__ void conv_process8_wave(const ConvItem& c, int sub, int lane, const f32x4 (&v)[16], LAS unsigned* tile) {
    const int n4 = lane & 15, kq = lane >> 4, kb = c.k0 + 64 * (sub >> 1);
#pragma unroll
    for (int i = 0; i < 4; ++i)
#pragma unroll
        for (int cc = 0; cc < 4; ++cc) tile[(4 * n4 + cc) * 17 + 4 * i + kq] = pk4_fp8(v[4 * i][cc] * W8SCALE, v[4 * i + 1][cc] * W8SCALE, v[4 * i + 2][cc] * W8SCALE, v[4 * i + 3][cc] * W8SCALE);
    unsigned char* d8 = (unsigned char*)c.dst;
#pragma unroll
    for (int j = 0; j < 4; ++j) {
        const int row = (lane >> 2) + 16 * j, c4 = lane & 3;
        const LAS unsigned* sp = tile + row * 17 + 4 * c4;
        u32x4 o; o.x = sp[0]; o.y = sp[1]; o.z = sp[2]; o.w = sp[3];
        int drow = c.drow0 + 64 * (sub & 1) + row;
        if (c.mode == 3) { const int L = drow & 255; drow = (drow & ~255) + 128 * ((L >> 3) & 1) + 32 * (L >> 6) + 8 * ((L >> 4) & 3) + (L & 7); }
        __builtin_nontemporal_store(o, (u32x4*)(d8 + (size_t)drow * c.Kd + kb + 16 * c4));
    }
}
__device__ __forceinline__ void conv_step(const Frame& F, const ConvItem& c, int sid, const f32x4 (&v)[16], int tcur, LAS unsigned* tile, LAS unsigned* img0, int& par) {
    if (c.fp8) { conv_process8_wave(c, sid, F.lane, v, tile);
    } else conv_process(c, sid, F.lane, v, tile);
}
__device__ __forceinline__ void conv_range3(const Frame& F, int t0, int t1, int wid, int nw) {
    LAS unsigned* tile = (LAS unsigned*)F.lds + F.wave * (64 * 33);
    LAS unsigned* img0 = (LAS unsigned*)(F.lds + 67584);
    int par = 0; const int te = t1;
    ConvItem ca, cb, cc; f32x4 va[16], vb[16], vc[16]; int ia, sa, ib, sb, ic, sc;
    int ta = t0 + wid, tb = ta + nw, tc = tb + nw;
    if (ta < te) { tile_decode(ta, ia, sa); conv_decode(F, ia, ca); conv_load(ca, sa, F.lane, va); }
    if (tb < te) { tile_decode(tb, ib, sb); conv_decode(F, ib, cb); conv_load(cb, sb, F.lane, vb); }
    while (ta < te) {
        if (tc < te) { tile_decode(tc, ic, sc); conv_decode(F, ic, cc); conv_load(cc, sc, F.lane, vc); }
        conv_step(F, ca, sa, va, ta, tile, img0, par);
        ta = tc + nw;
        if (tb >= te) break;
        if (ta < te) { tile_decode(ta, ia, sa); conv_decode(F, ia, ca); conv_load(ca, sa, F.lane, va); }
        conv_step(F, cb, sb, vb, tb, tile, img0, par);
        tb = ta + nw;
        if (tc >= te) break;
        if (tb < te) { tile_decode(tb, ib, sb); conv_decode(F, ib, cb); conv_load(cb, sb, F.lane, vb); }
        conv_step(F, cc, sc, vc, tc, tile, img0, par);
        tc = tb + nw;
    }
}
__device__ __forceinline__ void phase0a(const Frame& F) {
    LAS float* a_lds = (LAS float*)F.lds;
    LAS float* red = (LAS float*)(F.lds + 32768);
    for (int it = F.vcu; it < 200; it += F.G) {
        if (it < 192) {
            for (int i = F.tid; i < 4 * 2048; i += 512) a_lds[i] = siluf_(F.in[I_C][i]);
            __syncthreads();
            gemv_item<4>(F, a_lds, red, F.in[I_WADA], 6 * D, it * 64, F.in[I_BADA], WSP(float, WS_MOD), 6 * D);
        } else {
            const int kv = (it - 192) >> 2, nb = (it - 192) & 3;
            for (int i = F.tid; i < 2048; i += 512) a_lds[i] = F.in[kv ? I_CPV : I_CPK][i];
            __syncthreads();
            gemv_item<1>(F, a_lds, red, F.in[kv ? I_CW1V : I_CW1K], 256, nb * 64, nullptr, WSP(float, WS_BIAS1) + kv * 256, 256);
        }
    }
    for (int it = F.vcu; it < 128; it += F.G) {
        const int idx = it * 512 + F.tid, pos = idx >> 5, i = idx & 31; float c, s; rope_cs((float)pos, i, c, s);
        WSP(float, WS_ROPE)[idx] = c; WSP(float, WS_ROPE)[65536 + idx] = s;
    }
    __syncthreads();
    if (F.G == 256) {
        constexpr int HEAD = 56 * 8 * 3;
        if (F.vcu >= 200) conv_range(F, 0, HEAD, (F.vcu - 200) * 8 + F.wave, 56 * 8);
        conv_range(F, HEAD, CV_EARLY, F.vcu * 8 + F.wave, F.G * 8);
    }
    else conv_range(F, 0, CV_NT4 - CV_DEFER2, F.vcu * 8 + F.wave, F.G * 8);
}

__device__ __forceinline__ void phase0b(const Frame& F) {
    const int gw = F.vcu * 8 + F.wave, NGW = F.G * 8;
    const float* mod = WSP(float, WS_MOD);
    for (int r0 = gw * 4; r0 < NTOK; r0 += NGW * 4) {
        const int b = r0 >> 11;
        f32x4 ga[8], sh[8];
#pragma unroll
        for (int j = 0; j < 8; ++j) { const int k = 4 * F.lane + 256 * j;
            ga[j] = *(const f32x4*)(F.in[I_GN1] + k) * (*(const f32x4*)(mod + b * 6 * D + D + k) + 1.0f); sh[j] = *(const f32x4*)(mod + b * 6 * D + k); }
#pragma unroll 1
        for (int hf = 0; hf < 2; ++hf) {
            f32x4 v[2][8];
#pragma unroll
            for (int q = 0; q < 2; ++q) { const f32x4* xr = (const f32x4*)(F.in[I_X] + (size_t)(r0 + 2 * hf + q) * D) + F.lane;
#pragma unroll
                for (int j = 0; j < 8; ++j) v[q][j] = xr[64 * j]; }
#pragma unroll
            for (int q = 0; q < 2; ++q) {
                float s = 0.f;
#pragma unroll
                for (int j = 0; j < 8; ++j) s += (v[q][j].x * v[q][j].x + v[q][j].y * v[q][j].y) + (v[q][j].z * v[q][j].z + v[q][j].w * v[q][j].w);
                const float rstd = rsqrtf(wave_sum(s) * (1.f / D) + EPS);
                u32x2* o = (u32x2*)(WSP(bf16_t, WS_H) + (size_t)(r0 + 2 * hf + q) * D) + F.lane;
#pragma unroll
                for (int j = 0; j < 8; ++j) { const f32x4 h = v[q][j] * rstd * ga[j] + sh[j]; u32x2 w; w.x = cvt_pk_bf16(h.x, h.y); w.y = cvt_pk_bf16(h.z, h.w); o[64 * j] = w; }
            }
        }
    }
}

struct InProjP {
    static constexpr int K = 2048, ESZ = 2, LDB = 2048; static constexpr bool IDLDS = false; static constexpr bool HALFONLY = false; static constexpr bool MIDK = false;
    const bf16_t* A; const bf16_t* Bt; int lda; int G, c;
    unsigned char* ws; const float* gq; const float* gk;
    __device__ __forceinline__ bool next(int i, Unit& u) const { return pg8::dense_next(i, G, c, 32, 19, u); }
    __device__ __forceinline__ unsigned row_id(const Unit& u, int r) const { return (unsigned)(u.pm * 256 + r); }
    __device__ __forceinline__ const char* b_base(const Unit& u) const { return (const char*)(Bt + (size_t)u.pn * 256 * K); }
    __device__ __forceinline__ void unit_begin(const Unit&, int) const {}
    __device__ __forceinline__ unsigned a_koff(const Unit&) const { return 0u; }
    __device__ __forceinline__ void midk(Acc&, const Unit&, int, int, int) const {}
    __device__ __forceinline__ void epi(const Acc& acc, const Unit& u, int ui, int wr, int wc, int fr, int fq) const {
        const int pn = u.pn;
        if (pn < 10) {
            const bool donorm = (pn < 4) || pn == 6 || pn == 8;
            const float* g = (pn < 4) ? gq : gk;
            float glo[8], ghi[8];
#pragma unroll
            for (int j = 0; j < 8; ++j) { glo[j] = g[8 * fq + j]; ghi[j] = g[32 + 8 * fq + j]; }
            const float qs = (pn < 4) ? QSCALE : 1.0f;
            const float* cosT = (const float*)(ws + WS_ROPE); const float* sinT = cosT + 65536;
#pragma unroll
            for (int ai = 0; ai < 2; ++ai)
#pragma unroll
                for (int m = 0; m < 4; ++m) {
                    const int row = u.pm * 256 + ai * 128 + wr * 64 + m * 16 + fr, b = row >> 11, t = row & 2047;
                    float lo[8], hi[8];
#pragma unroll
                    for (int n = 0; n < 2; ++n)
#pragma unroll
                        for (int v = 0; v < 4; ++v) { lo[4 * n + v] = acc[ai][0][m][n][v]; hi[4 * n + v] = acc[ai][1][m][n][v]; }
                    if (donorm) {
                        float ss = 0.f;
#pragma unroll
                        for (int j = 0; j < 8; ++j) ss += lo[j] * lo[j] + hi[j] * hi[j];
                        ss += __shfl_xor(ss, 16); ss += __shfl_xor(ss, 32);
                        const float rstd = rsqrtf(ss * (1.f / 64.f) + EPS) * qs;
                        const f32x4 c0 = *(const f32x4*)(cosT + t * 32 + 8 * fq), c1 = *(const f32x4*)(cosT + t * 32 + 8 * fq + 4);
                        const f32x4 s0 = *(const f32x4*)(sinT + t * 32 + 8 * fq), s1 = *(const f32x4*)(sinT + t * 32 + 8 * fq + 4);
#pragma unroll
                        for (int j = 0; j < 8; ++j) {
                            const float cc = j < 4 ? c0[j & 3] : c1[j & 3], sn = j < 4 ? s0[j & 3] : s1[j & 3];
                            const float yl = lo[j] * rstd * glo[j], yh = hi[j] * rstd * ghi[j];
                            lo[j] = yl * cc - yh * sn; hi[j] = yh * cc + yl * sn;
                        }
                    }
                    bf16_t* dst = (pn < 4) ? (bf16_t*)(ws + WS_Q) + ((size_t)((b * 16 + 4 * pn + wc) * 2048 + t)) * 64
                                           : (bf16_t*)(ws + WS_KV + (size_t)(pn - 4) * KV_STRIDE) + ((size_t)((b * 4 + wc) * 2048 + t)) * 64;
                    u32x4 w0, w1;
                    w0.x = cvt_pk_bf16(lo[0], lo[1]); w0.y = cvt_pk_bf16(lo[2], lo[3]); w0.z = cvt_pk_bf16(lo[4], lo[5]); w0.w = cvt_pk_bf16(lo[6], lo[7]);
                    w1.x = cvt_pk_bf16(hi[0], hi[1]); w1.y = cvt_pk_bf16(hi[2], hi[3]); w1.z = cvt_pk_bf16(hi[4], hi[5]); w1.w = cvt_pk_bf16(hi[6], hi[7]);
                    *(u32x4*)(dst + 8 * fq) = w0; *(u32x4*)(dst + 32 + 8 * fq) = w1;
                }
        } else if (pn < 18) {
            const bool isv = pn >= 14; const int tb = isv ? pn - 14 : pn - 10;
            bf16_t* O = (bf16_t*)(ws + (isv ? WS_V : WS_U)); float* vss = (float*)(ws + WS_VSS);
#pragma unroll
            for (int ai = 0; ai < 2; ++ai)
#pragma unroll
                for (int m = 0; m < 4; ++m) {
                    const int row = u.pm * 256 + ai * 128 + wr * 64 + m * 16 + fr;
#pragma unroll
                    for (int bj = 0; bj < 2; ++bj) {
                        float y[8]; float ss = 0.f;
#pragma unroll
                        for (int n = 0; n < 2; ++n)
#pragma unroll
                            for (int v = 0; v < 4; ++v) { const float gl = gelu_tanh(acc[ai][bj][m][n][v]); y[4 * n + v] = gl; ss += gl * gl; }
                        u32x4 w; w.x = cvt_pk_bf16(y[0], y[1]); w.y = cvt_pk_bf16(y[2], y[3]); w.z = cvt_pk_bf16(y[4], y[5]); w.w = cvt_pk_bf16(y[6], y[7]);
                        *(u32x4*)(O + (size_t)row * 1024 + tb * 256 + bj * 128 + wc * 32 + 8 * fq) = w;
                        if (isv) { ss += __shfl_xor(ss, 16); ss += __shfl_xor(ss, 32); if (fq == 0) vss[(size_t)row * 32 + (2 * tb + bj) * 4 + wc] = ss; }
                    }
                }
        } else {
            float* gate = (float*)(ws + WS_GATE);
            const int col = wc * 32 + 8 * fq;
            if (col < 48) {
#pragma unroll
                for (int ai = 0; ai < 2; ++ai)
#pragma unroll
                    for (int m = 0; m < 4; ++m) {
                        const int row = u.pm * 256 + ai * 128 + wr * 64 + m * 16 + fr;
#pragma unroll
                        for (int n = 0; n < 2; ++n) { f32x4 a = acc[ai][0][m][n]; f32x4 o; o.x = sigmoidf_(a.x); o.y = sigmoidf_(a.y); o.z = sigmoidf_(a.z); o.w = sigmoidf_(a.w);
                            *(f32x4*)(gate + (size_t)row * 48 + col + 4 * n) = o; }
                    }
            }
        }
    }
};

struct CmpP {
    static constexpr int K = 512, ESZ = 2, LDB = 2048; static constexpr bool IDLDS = false; static constexpr bool HALFONLY = false; static constexpr bool MIDK = false;
    const bf16_t* A; const bf16_t* Bt; int lda; int G, c;
    unsigned char* ws;
    __device__ __forceinline__ bool next(int i, Unit& u) const { const int L = i * G + c; if (L >= 64) return false; u.e = L >> 5; u.pm = (L >> 2) & 7; u.aux = L & 3; u.pn = 0; return true; }
    __device__ __forceinline__ unsigned row_id(const Unit& u, int r) const { return (unsigned)(u.e * 2048 + u.pm * 256 + r); }
    __device__ __forceinline__ unsigned a_koff(const Unit& u) const { return (unsigned)u.aux * 1024u; }
    __device__ __forceinline__ const char* b_base(const Unit& u) const { return (const char*)(Bt + (size_t)u.e * 256 * 2048 + u.aux * 512); }
    __device__ __forceinline__ void unit_begin(const Unit&, int) const {}
    __device__ __forceinline__ void midk(Acc&, const Unit&, int, int, int) const {}
    __device__ __forceinline__ void epi(const Acc& acc, const Unit& u, int ui, int wr, int wc, int fr, int fq) const {
        float* O = (float*)(ws + WS_PO) + ((size_t)(u.aux * 2 + u.e) * 2048) * 256;
#pragma unroll
        for (int bj = 0; bj < 2; ++bj) {
            const int col = bj * 128 + wc * 32 + 8 * fq;
#pragma unroll
            for (int ai = 0; ai < 2; ++ai)
#pragma unroll
                for (int m = 0; m < 4; ++m) {
                    const int row = u.pm * 256 + ai * 128 + wr * 64 + m * 16 + fr;
                    *(f32x4*)(O + (size_t)row * 256 + col) = acc[ai][bj][m][0]; *(f32x4*)(O + (size_t)row * 256 + col + 4) = acc[ai][bj][m][1];
                }
        }
    }
};

struct OutProjP {
    static constexpr int K = 2048, ESZ = 2, LDB = 2048; static constexpr bool IDLDS = false; static constexpr bool HALFONLY = false; static constexpr bool MIDK = true;
    const bf16_t* A; const bf16_t* Bt; int lda; int G, c;
    unsigned char* ws; const float* x; float* out; LAS f32x2* tab;
    __device__ __forceinline__ bool next(int i, Unit& u) const { return pg8::dense_next(i, G, c, 32, 8, u); }
    __device__ __forceinline__ unsigned row_id(const Unit& u, int r) const { return (unsigned)(u.pm * 256 + r); }
    __device__ __forceinline__ const char* b_base(const Unit& u) const { return (const char*)(Bt + (size_t)u.pn * 256 * K); }
    __device__ __forceinline__ unsigned a_koff(const Unit&) const { return 0u; }
    __device__ __forceinline__ void unit_begin(const Unit& u, int ui) const {
        if (threadIdx.x < 256) {
            const int row = u.pm * 256 + threadIdx.x;
            const f32x4 a = *(const f32x4*)((const float*)(ws + WS_OSSN) + (size_t)row * 4);
            const f32x4* gp = (const f32x4*)((const float*)(ws + WS_OSSG) + (size_t)row * 16);
            const f32x4 g0 = gp[0], g1 = gp[1], g2 = gp[2], g3 = gp[3];
            const float sn = (a.x + a.y) + (a.z + a.w);
            const float sg = ((g0.x + g0.y) + (g0.z + g0.w)) + ((g1.x + g1.y) + (g1.z + g1.w)) + ((g2.x + g2.y) + (g2.z + g2.w)) + ((g3.x + g3.y) + (g3.z + g3.w));
            const float rn = rsqrtf(sn * (1.f / 1024.f) + EPS), rg = rsqrtf(sg * (1.f / 1024.f) + EPS);
            tab[(ui & 1) * 256 + threadIdx.x] = (f32x2){rn / rg, rg};
        }
    }
    __device__ __forceinline__ void midk(Acc& acc, const Unit& u, int ui, int wr, int fr) const {
#pragma unroll
        for (int ai = 0; ai < 2; ++ai)
#pragma unroll
            for (int m = 0; m < 4; ++m) { const float s = tab[(ui & 1) * 256 + ai * 128 + wr * 64 + m * 16 + fr].x;
#pragma unroll
                for (int bj = 0; bj < 2; ++bj)
#pragma unroll
                    for (int n = 0; n < 2; ++n) acc[ai][bj][m][n] *= s; }
    }
    __device__ __forceinline__ void epi(const Acc& acc, const Unit& u, int ui, int wr, int wc, int fr, int fq) const {
        const float* mod = (const float*)(ws + WS_MOD);
#pragma unroll
        for (int ai = 0; ai < 2; ++ai)
#pragma unroll
            for (int m = 0; m < 4; ++m) {
                const int r = ai * 128 + wr * 64 + m * 16 + fr, row = u.pm * 256 + r, b = row >> 11; const float s = tab[(ui & 1) * 256 + r].y;
#pragma unroll
                for (int bj = 0; bj < 2; ++bj) {
                    const int col = u.pn * 256 + bj * 128 + wc * 32 + 8 * fq;
#pragma unroll
                    for (int n = 0; n < 2; ++n) {
                        const f32x4 gt = *(const f32x4*)(mod + b * 6 * D + 2 * D + col + 4 * n), xv = *(const f32x4*)(x + (size_t)row * D + col + 4 * n);
                        *(f32x4*)(out + (size_t)row * D + col + 4 * n) = xv + gt * (acc[ai][bj][m][n] * s);
                    }
                }
            }
    }
};

__device__ __forceinline__ void moe_table(const Frame& F, LAS int* tb) {
    if (F.tid < 64) {
        const unsigned* cnt = (const unsigned*)(F.ws + WS_CTL) + CW_CNT;
        const int c = (int)__hip_atomic_load(cnt + F.tid, __ATOMIC_RELAXED, __HIP_MEMORY_SCOPE_AGENT);
        const int tl = (c + 255) >> 8; int inc = tl;
#pragma unroll
        for (int o = 1; o < 64; o <<= 1) { const int v = __shfl_up(inc, o); if (F.lane >= o) inc += v; }
        tb[F.tid] = inc - tl; tb[128 + F.tid] = c;
        if (F.tid == 63) { tb[64] = inc; tb[65] = inc + (NTOK >> 8); tb[128 + 64] = NTOK; }
    }
    __syncthreads();
    if (F.tid < 384) {
        int lo = 0, hi = 64; while (lo < hi) { const int mid = (lo + hi + 1) >> 1; if (tb[mid] <= F.tid) lo = mid; else hi = mid - 1; }
        tb[256 + F.tid] = lo;
        const int nv = tb[128 + lo] - (F.tid - tb[lo]) * 256;
        tb[640 + F.tid] = (F.tid < tb[65] && lo < 64 && nv <= 128) ? 1 : 0;
    }
    __syncthreads();
    {
        const int TT = tb[65];
        const unsigned long long bm = __ballot(F.tid < 384 && tb[640 + (F.tid < 384 ? F.tid : 0)] != 0);
        if (F.tid < 384 && F.lane == 0) { tb[1500 + 2 * F.wave] = (int)(unsigned)bm; tb[1501 + 2 * F.wave] = (int)(unsigned)(bm >> 32); }
        __syncthreads();
        if (F.tid < 384) {
            int nhb = 0, nh = 0;
#pragma unroll
            for (int w = 0; w < 6; ++w) { const int c = __popc((unsigned)tb[1500 + 2 * w]) + __popc((unsigned)tb[1501 + 2 * w]); nh += c; if (w < F.wave) nhb += c; }
            nhb += __popcll(bm & ((1ull << F.lane) - 1ull));
            const int nf = TT - nh;
            if (F.tid < TT) tb[1024 + (tb[640 + F.tid] ? nf + nhb : F.tid - nhb)] = F.tid;
            if (F.tid == 0) tb[66] = nf;
        }
    }
    __syncthreads();
}

template <bool HALF> struct MoeUpP {
    LAS unsigned* idtab;
    static constexpr int K = 2048, ESZ = 1, LDB = 2048; static constexpr bool IDLDS = true; static constexpr bool HALFONLY = HALF; static constexpr bool MIDK = false;
    const unsigned char* A; const unsigned char* Bt; int lda; int G, c;
    unsigned char* ws; const LAS int* tb; int c0;
    __device__ __forceinline__ bool next(int i, Unit& u) const {
        const int nf = tb[66]; int k;
        if (!HALF) { const int L = i * G + c; if (L >= nf * 4) return false; k = L >> 2; u.pn = L & 3; }
        else { if (c < c0) return false; const int L = i * (G - c0) + (c - c0); if (L >= (tb[65] - nf) * 4) return false; k = nf + (L >> 2); u.pn = L & 3; }
        const int mt = tb[1024 + k]; u.e = tb[256 + mt]; u.pm = mt; u.aux = mt - tb[u.e]; return true; }
    __device__ __forceinline__ unsigned row_id(const Unit& u, int r) const {
        const int base = u.aux * 256; const int nv = tb[128 + u.e] - base; const int rr = r < nv ? r : 0;
        if (u.e == 64) return (unsigned)(base + rr);
        return (unsigned)((const int*)(ws + WS_LIST))[u.e * 8192 + base + rr];
    }
    __device__ __forceinline__ const char* b_base(const Unit& u) const { return (const char*)(Bt + ((size_t)u.e * 1024 + u.pn * 256) * K); }
    __device__ __forceinline__ void ids_prefetch(const Unit& u, int wid, int lane) const {
        if (u.e == 64) return;
        const int r = 64 * (wid & 3) + lane, base = u.aux * 256, nv = tb[128 + u.e] - base, rr = r < nv ? r : 0;
        __builtin_amdgcn_global_load_lds((const unsigned*)((const int*)(ws + WS_LIST) + u.e * 8192 + base + rr), (LAS unsigned*)(idtab + (wid >> 2) * 256 + 64 * (wid & 3)), 4, 0, 0);
    }
    __device__ __forceinline__ unsigned ids_read(const Unit& u, int r) const {
        if (u.e == 64) { const int base = u.aux * 256, nv = tb[128 + u.e] - base; return (unsigned)(base + (r < nv ? r : 0)); }
        return idtab[r];
    }
    __device__ __forceinline__ void unit_begin(const Unit&, int) const {}
    __device__ __forceinline__ unsigned a_koff(const Unit&) const { return 0u; }
    __device__ __forceinline__ void midk(Acc&, const Unit&, int, int, int) const {}
    __device__ __forceinline__ void epi(const Acc& acc, const Unit& u, int ui, int wr, int wc, int fr, int fq) const {
        unsigned char* O = ws + WS_HID; const float ws_ = 1.0f / W8SCALE;
#pragma unroll
        for (int ai = 0; ai < (HALF ? 1 : 2); ++ai)
#pragma unroll
            for (int m = 0; m < 4; ++m) {
                const size_t row = (size_t)u.pm * 256 + ai * 128 + wr * 64 + m * 16 + fr; float y[8];
#pragma unroll
                for (int n = 0; n < 2; ++n)
#pragma unroll
                    for (int v = 0; v < 4; ++v) y[4 * n + v] = siluf_(acc[ai][0][m][n][v] * ws_) * (acc[ai][1][m][n][v] * (ws_ * H8SCALE));
                u32x2 w; w.x = pk4_fp8(y[0], y[1], y[2], y[3]); w.y = pk4_fp8(y[4], y[5], y[6], y[7]);
                *(u32x2*)(O + row * 512 + u.pn * 128 + wc * 32 + 8 * fq) = w;
            }
    }
};
template <bool HALF> struct MoeDownP {
    static constexpr int K = 512, ESZ = 1, LDB = 512; static constexpr bool IDLDS = false; static constexpr bool HALFONLY = HALF; static constexpr bool MIDK = false;
    const unsigned char* A; const unsigned char* Bt; int lda; int G, c;
    unsigned char* ws; const LAS int* tb; int c0;
    __device__ __forceinline__ bool next(int i, Unit& u) const {
        const int nf = tb[66]; int k;
        if (!HALF) { const int L = i * G + c; if (L >= nf * 8) return false; k = L >> 3; u.pn = L & 7; }
        else { if (c < c0) return false; const int L = i * (G - c0) + (c - c0); if (L >= (tb[65] - nf) * 8) return false; k = nf + (L >> 3); u.pn = L & 7; }
        const int mt = tb[1024 + k]; u.e = tb[256 + mt]; u.pm = mt; u.aux = 0; return true; }
    __device__ __forceinline__ unsigned row_id(const Unit& u, int r) const { return (unsigned)(u.pm * 256 + r); }
    __device__ __forceinline__ const char* b_base(const Unit& u) const { return (const char*)(Bt + ((size_t)u.e * 2048 + u.pn * 256) * K); }
    __device__ __forceinline__ void unit_begin(const Unit&, int) const {}
    __device__ __forceinline__ unsigned a_koff(const Unit&) const { return 0u; }
    __device__ __forceinline__ void midk(Acc&, const Unit&, int, int, int) const {}
    __device__ __forceinline__ void epi(const Acc& acc, const Unit& u, int ui, int wr, int wc, int fr, int fq) const {
        unsigned char* O = ws + WS_PO; const float sc_ = PO8SCALE / (W8SCALE * H8SCALE);
#pragma unroll
        for (int ai = 0; ai < (HALF ? 1 : 2); ++ai)
#pragma unroll
            for (int m = 0; m < 4; ++m) {
                const size_t row = (size_t)u.pm * 256 + ai * 128 + wr * 64 + m * 16 + fr;
                const f32x4 a0 = acc[ai][0][m][0] * sc_, a1 = acc[ai][0][m][1] * sc_, b0 = acc[ai][1][m][0] * sc_, b1 = acc[ai][1][m][1] * sc_;
                u32x4 w; w.x = pk4_fp8(a0.x, a0.y, a0.z, a0.w); w.y = pk4_fp8(a1.x, a1.y, a1.z, a1.w); w.z = pk4_fp8(b0.x, b0.y, b0.z, b0.w); w.w = pk4_fp8(b1.x, b1.y, b1.z, b1.w);
                *(u32x4*)(O + row * 2048 + u.pn * 256 + wc * 64 + 16 * fq) = w;
            }
    }
};

__device__ __forceinline__ void gmlp_unit(const Frame& F, int n) {
    const int b = n >> 7, c = (n >> 3) & 15, g = n & 7;
    constexpr int WP = 136, VP = 160;
    LAS bf16_t* Ws = (LAS bf16_t*)F.lds;
    LAS bf16_t* Vs = (LAS bf16_t*)(F.lds + 34816);
    LAS float* rs = (LAS float*)(F.lds + 75776);
    LAS float* stg = (LAS float*)F.lds + F.wave * 2048;
    const int row0 = b * T + c * 128;
    const int tb = F.wave & 3, dh = F.wave >> 2, r32 = F.lane & 31, hi = F.lane >> 5;
    f32x4 vssv = (f32x4){0.f, 0.f, 0.f, 0.f};
    if (F.tid < 128) vssv = *(const f32x4*)(WSP(float, WS_VSS) + (size_t)(row0 + F.tid) * 32 + g * 4);
    const float* wsp = F.in[I_WSP] + (size_t)g * 128 * 128;
    f32x4 wv[8];
#pragma unroll
    for (int q = 0; q < 8; ++q) { const int idx = F.tid + 512 * q; wv[q] = *(const f32x4*)(wsp + (idx >> 5) * 128 + (idx & 31) * 4); }
    const bf16_t* Vg = WSP(bf16_t, WS_V);
    u32x4 vv[4];
#pragma unroll
    for (int q = 0; q < 4; ++q) { const int ch = F.tid + 512 * q; vv[q] = *(const u32x4*)(Vg + (size_t)(row0 + (ch >> 4)) * 1024 + g * 128 + (ch & 15) * 8); }
    const bf16_t* U = WSP(bf16_t, WS_U);
    u32x4 uv[4];
#pragma unroll
    for (int q = 0; q < 4; ++q) uv[q] = *(const u32x4*)(U + (size_t)(row0 + 32 * tb + q * 8 + (F.lane >> 3)) * 1024 + g * 128 + 64 * dh + (F.lane & 7) * 8);
    f32x4 gv0, gv1; { const float* gvp = F.in[I_GGV] + g * 128 + (F.tid & 15) * 8; gv0 = *(const f32x4*)gvp; gv1 = *(const f32x4*)(gvp + 4); }
    __syncthreads();
    if (F.tid < 128) rs[F.tid] = rsqrtf(((vssv.x + vssv.y) + (vssv.z + vssv.w)) * (1.f / 128.f) + EPS);
#pragma unroll
    for (int q = 0; q < 8; ++q) {
        const int idx = F.tid + 512 * q, t = idx >> 5, s4 = (idx & 31) * 4;
        f32x4 w = wv[q];
        if (s4 + 0 > t) w.x = 0.f; if (s4 + 1 > t) w.y = 0.f; if (s4 + 2 > t) w.z = 0.f; if (s4 + 3 > t) w.w = 0.f;
        u32x2 o; o.x = cvt_pk_bf16(w.x, w.y); o.y = cvt_pk_bf16(w.z, w.w);
        *(LAS u32x2*)(Ws + t * WP + s4) = o;
    }
    __syncthreads();
#pragma unroll
    for (int q = 0; q < 4; ++q) {
        const int ch = F.tid + 512 * q, sidx = ch >> 4, dc = ch & 15;
        const float r = rs[sidx];
        u32x4 o;
        o.x = cvt_pk_bf16(bflo(vv[q].x) * r * gv0.x, bfhi(vv[q].x) * r * gv0.y); o.y = cvt_pk_bf16(bflo(vv[q].y) * r * gv0.z, bfhi(vv[q].y) * r * gv0.w);
        o.z = cvt_pk_bf16(bflo(vv[q].z) * r * gv1.x, bfhi(vv[q].z) * r * gv1.y); o.w = cvt_pk_bf16(bflo(vv[q].w) * r * gv1.z, bfhi(vv[q].w) * r * gv1.w);
        *(LAS u32x4*)(Vs + sidx * VP + dc * 8) = o;
    }
    __syncthreads();
    f32x16 acc[2]; acc[0] = (f32x16)(0.f); acc[1] = (f32x16)(0.f);
    {
        const LAS unsigned char* vbase = (const LAS unsigned char*)Vs + (8 * hi + ((F.lane & 15) >> 2)) * (VP * 2) + (64 * dh + 16 * ((F.lane >> 4) & 1) + 4 * (F.lane & 3)) * 2;
        for (int kc = 0; kc < 2 * tb + 2; ++kc) {
            const bf16x8 a = *(const LAS bf16x8*)(Ws + (32 * tb + r32) * WP + 16 * kc + 8 * hi);
#pragma unroll
            for (int db = 0; db < 2; ++db) {
                const v4i16_t lo4 = __builtin_amdgcn_ds_read_tr16_b64_v4i16((LAS v4i16_t*)(vbase + (16 * kc) * (VP * 2) + 64 * db));
                const v4i16_t hi4 = __builtin_amdgcn_ds_read_tr16_b64_v4i16((LAS v4i16_t*)(vbase + (16 * kc + 4) * (VP * 2) + 64 * db));
                const bf16x8 bq = (bf16x8){lo4[0], lo4[1], lo4[2], lo4[3], hi4[0], hi4[1], hi4[2], hi4[3]};
                acc[db] = __builtin_amdgcn_mfma_f32_32x32x16_bf16(a, bq, acc[db], 0, 0, 0);
            }
        }
    }
    __syncthreads();
    {
        const float* bsp = F.in[I_BSP] + g * 128 + 32 * tb + 4 * hi;
        LAS float* sl = stg + (4 * hi) * 64 + r32;
#pragma unroll
        for (int r = 0; r < 16; ++r) { const int rc = (r & 3) + 8 * (r >> 2); const float bias = bsp[rc]; sl[rc * 64] = acc[0][r] + bias; sl[rc * 64 + 32] = acc[1][r] + bias; }
    }
    bf16_t* O = WSP(bf16_t, WS_OCAT); float* ossg = WSP(float, WS_OSSG);
#pragma unroll
    for (int q = 0; q < 4; ++q) {
        const int rl = q * 8 + (F.lane >> 3), ch = F.lane & 7, row = row0 + 32 * tb + rl;
        const f32x4 m0 = *(const LAS f32x4*)(stg + rl * 64 + ch * 8), m1 = *(const LAS f32x4*)(stg + rl * 64 + ch * 8 + 4);
        const float o0 = bflo(uv[q].x) * m0.x, o1 = bfhi(uv[q].x) * m0.y, o2 = bflo(uv[q].y) * m0.z, o3 = bfhi(uv[q].y) * m0.w;
        const float o4 = bflo(uv[q].z) * m1.x, o5 = bfhi(uv[q].z) * m1.y, o6 = bflo(uv[q].w) * m1.z, o7 = bfhi(uv[q].w) * m1.w;
        u32x4 w; w.x = cvt_pk_bf16(o0, o1); w.y = cvt_pk_bf16(o2, o3); w.z = cvt_pk_bf16(o4, o5); w.w = cvt_pk_bf16(o6, o7);
        *(u32x4*)(O + (size_t)row * 2048 + 1024 + g * 128 + 64 * dh + ch * 8) = w;
        float ss = ((o0 * o0 + o1 * o1) + (o2 * o2 + o3 * o3)) + ((o4 * o4 + o5 * o5) + (o6 * o6 + o7 * o7));
        ss += __shfl_xor(ss, 1); ss += __shfl_xor(ss, 2); ss += __shfl_xor(ss, 4);
        if (ch == 0) ossg[(size_t)row * 16 + 2 * g + dh] = ss;
    }
}

__device__ __forceinline__ void phase2b(const Frame& F) {
    const int gw = F.vcu * 8 + F.wave, NGW = F.G * 8;
    LAS float* hs = (LAS float*)F.lds + F.wave * 256;
    for (int it = gw; it < 4096; it += NGW) {
        const int kv = it >> 11, m = it & 2047, n = m & 127;
        bf16_t* dst = WSP(bf16_t, kv ? WS_VCMP : WS_KCMP) + (size_t)m * 64;
        if (n == 127) { dst[F.lane] = 0; continue; }
        {
            f32x4 a = *(const f32x4*)(WSP(float, WS_BIAS1) + kv * 256 + 4 * F.lane);
#pragma unroll
            for (int ks = 0; ks < 4; ++ks) a += *(const f32x4*)(WSP(float, WS_PO) + ((size_t)(ks * 2 + kv) * 2048 + m) * 256 + 4 * F.lane);
            hs[4 * F.lane + 0] = gelu_tanh(a.x); hs[4 * F.lane + 1] = gelu_tanh(a.y); hs[4 * F.lane + 2] = gelu_tanh(a.z); hs[4 * F.lane + 3] = gelu_tanh(a.w);
        }
        const float* w2 = F.in[kv ? I_CW2V : I_CW2K];
        float y0 = 0.f, y1 = 0.f, y2 = 0.f, y3 = 0.f;
#pragma unroll 8
        for (int k = 0; k < 256; k += 4) {
            const f32x4 h4 = *(const LAS f32x4*)(hs + k);
            y0 += h4.x * w2[k * 64 + F.lane]; y1 += h4.y * w2[(k + 1) * 64 + F.lane]; y2 += h4.z * w2[(k + 2) * 64 + F.lane]; y3 += h4.w * w2[(k + 3) * 64 + F.lane];
        }
        float y = (y0 + y1) + (y2 + y3);
        if (kv == 0) {
            const float rstd = rsqrtf(wave_sum(y * y) * (1.f / 64.f) + EPS);
            const float yn = y * rstd * F.in[I_GK][F.lane];
            const float pr = __shfl_xor(yn, 32);
            float c, s; rope_cs(16.0f * (float)n + 15.5f, F.lane & 31, c, s);
            y = (F.lane < 32) ? yn * c - pr * s : yn * c + pr * s;
        }
        dst[F.lane] = (bf16_t)(cvt_pk_bf16(y, 0.f) & 0xffffu);
    }
}

constexpr int AT_KS = 0, AT_VT = 18432, AT_WSF = 43008, AT_MSK = 45056, AT_FS = 45312, AT_SSQ = 47360, AT_IMP = 48384, AT_G = 56832, AT_L = 90624;
constexpr int KSP = 72, VTP = 96, VTB = 64 * VTP * 2;
constexpr float AT_THR = 20.0f;
struct AttnCtx {
    LAS unsigned char* lds; int tid, lane, wave, r32, hi, g, th, tokl;
    bf16x8 qf[4];
};
__device__ __forceinline__ void at_load(const bf16_t* Kb, const bf16_t* Vb, int tile, int tid, u32x4& kr, u32x4& vr) {
    const size_t off = (size_t)(tile * 64 + (tid >> 3)) * 64 + (tid & 7) * 8;
    kr = *(const u32x4*)(Kb + off); vr = *(const u32x4*)(Vb + off);
}
__device__ __forceinline__ void at_store(LAS unsigned char* lds, int buf, int tid, const u32x4& kr, const u32x4& vr) {
    const int key = tid >> 3, ch = tid & 7;
    *(LAS u32x4*)(lds + AT_KS + buf * 9216 + (key * KSP + ch * 8) * 2) = kr;
    *(LAS u32x4*)(lds + AT_VT + buf * VTB + (key * VTP + ch * 8) * 2) = vr;
}
__device__ __forceinline__ void attn_pass(const int MODE, AttnCtx& C, const bf16_t* Kb, const bf16_t* Vb, int i, int j0, int ntiles, unsigned rowmask, bool want_imp, float gatev, f32x16 (&of)[2],
                                          u32x4& kr, u32x4& vr, const bf16_t* Kn, const bf16_t* Vn, int jn) {
    LAS unsigned char* lds = C.lds;
    LAS float* wsf = (LAS float*)(lds + AT_WSF) + C.wave * 64;
    float mref = 0.f, l = 0.f, m0 = 0.f;
    f32x16 o[2]; o[0] = (f32x16)(0.f); o[1] = (f32x16)(0.f);
    const int vlane = (4 * C.hi + ((C.lane & 15) >> 2)) * (VTP * 2) + (16 * ((C.lane >> 4) & 1) + 4 * (C.lane & 3)) * 2;
    at_store(lds, 0, C.tid, kr, vr);
    __syncthreads();
    for (int tt = 0; tt < ntiles; ++tt) {
        const int buf = tt & 1, j = j0 + tt;
        if (tt + 1 < ntiles) at_load(Kb, Vb, j + 1, C.tid, kr, vr); else if (Kn) at_load(Kn, Vn, jn, C.tid, kr, vr);
        bool active = true;
        if (MODE == 1) active = __any((rowmask >> j) & 1u);
        if (active) {
            f32x16 p0, p1;
            const LAS unsigned char* ks = lds + AT_KS + buf * 9216;
            int wlo = 0, whi = 63;
            if (MODE == 0) { const int t = 64 * i + C.tokl; whi = ((t >= 31) ? ((t - 31) >> 4) : -1) - 64 * tt; }
            else {
                if (MODE == 1 && !((rowmask >> j) & 1u)) wlo = 64;
                if (j == i) whi = C.tokl;
                if (MODE == 2 && j == i - 8) wlo = C.tokl + 1;
            }
            const bf16x8 ka0 = *(const LAS bf16x8*)(ks + (C.r32 * KSP + 8 * C.hi) * 2);
            const bf16x8 ka1 = *(const LAS bf16x8*)(ks + ((32 + C.r32) * KSP + 8 * C.hi) * 2);
            if (__any(wlo > 0 || whi < 63)) {
                f32x16 c0, c1;
#pragma unroll
                for (int r = 0; r < 16; ++r) { const int kl = (r & 3) + 8 * (r >> 2) + 4 * C.hi; c0[r] = (kl < wlo || kl > whi) ? NEGF : 0.f; c1[r] = (kl + 32 < wlo || kl + 32 > whi) ? NEGF : 0.f; }
                p0 = __builtin_amdgcn_mfma_f32_32x32x16_bf16(ka0, C.qf[0], c0, 0, 0, 0); p1 = __builtin_amdgcn_mfma_f32_32x32x16_bf16(ka1, C.qf[0], c1, 0, 0, 0);
            } else {
                const f32x16 z16 = (f32x16)(0.f);
                p0 = __builtin_amdgcn_mfma_f32_32x32x16_bf16(ka0, C.qf[0], z16, 0, 0, 0); p1 = __builtin_amdgcn_mfma_f32_32x32x16_bf16(ka1, C.qf[0], z16, 0, 0, 0);
            }
#pragma unroll
            for (int d0 = 1; d0 < 4; ++d0) {
                const bf16x8 k0 = *(const LAS bf16x8*)(ks + (C.r32 * KSP + 16 * d0 + 8 * C.hi) * 2);
                const bf16x8 k1 = *(const LAS bf16x8*)(ks + ((32 + C.r32) * KSP + 16 * d0 + 8 * C.hi) * 2);
                p0 = __builtin_amdgcn_mfma_f32_32x32x16_bf16(k0, C.qf[d0], p0, 0, 0, 0); p1 = __builtin_amdgcn_mfma_f32_32x32x16_bf16(k1, C.qf[d0], p1, 0, 0, 0);
            }
            if (__any(mref != 0.f)) {
#pragma unroll
                for (int r = 0; r < 16; ++r) { p0[r] -= mref; p1[r] -= mref; }
            }
            float mx = fmaxf(p0[0], p1[0]);
#pragma unroll
            for (int r = 1; r < 16; ++r) mx = fmaxf(fmaxf(mx, p0[r]), p1[r]);
            if (__any(mx > AT_THR)) {
                mx = fmaxf(mx, __shfl_xor(mx, 32));
                const float dl = fmaxf(mx, 0.f); mref += dl;
#pragma unroll
                for (int r = 0; r < 16; ++r) { p0[r] -= dl; p1[r] -= dl; }
                const float f = fexp2(-dl); l *= f;
                if (C.hi == 0) wsf[C.r32] = f;
#pragma unroll
                for (int r = 0; r < 16; ++r) { const float ff = wsf[(r & 3) + 8 * (r >> 2) + 4 * C.hi]; o[0][r] *= ff; o[1][r] *= ff; }
            }
            float rsum = 0.f;
#pragma unroll
            for (int r = 0; r < 16; ++r) { p0[r] = fexp2(p0[r]); p1[r] = fexp2(p1[r]); rsum += p0[r] + p1[r]; }
            l += rsum;
            if (MODE == 0) {
                if (tt == 0) m0 = mref;
                if (want_imp) {
                    LAS float* Gs = (LAS float*)(lds + AT_G) + (C.g * 64 + C.tokl) * 33; LAS float* Ls = (LAS float*)(lds + AT_L) + (C.g * 64 + C.tokl) * 33;
#pragma unroll
                    for (int rg = 0; rg < 4; ++rg) {
                        const int ml = 16 * tt + 2 * rg + C.hi;
                        Gs[ml] = (p0[4 * rg] + p0[4 * rg + 1]) + (p0[4 * rg + 2] + p0[4 * rg + 3]); Ls[ml] = p0[4 * rg + 3];
                        Gs[ml + 8] = (p1[4 * rg] + p1[4 * rg + 1]) + (p1[4 * rg + 2] + p1[4 * rg + 3]); Ls[ml + 8] = p1[4 * rg + 3];
                    }
                }
            }
            bf16x8 pa[4];
#pragma unroll
            for (int c = 0; c < 4; ++c) {
                u32x4 w;
                if (c < 2) { w.x = cvt_pk_bf16(p0[8 * c], p0[8 * c + 1]); w.y = cvt_pk_bf16(p0[8 * c + 2], p0[8 * c + 3]); w.z = cvt_pk_bf16(p0[8 * c + 4], p0[8 * c + 5]); w.w = cvt_pk_bf16(p0[8 * c + 6], p0[8 * c + 7]); }
                else { const int cc = c - 2; w.x = cvt_pk_bf16(p1[8 * cc], p1[8 * cc + 1]); w.y = cvt_pk_bf16(p1[8 * cc + 2], p1[8 * cc + 3]); w.z = cvt_pk_bf16(p1[8 * cc + 4], p1[8 * cc + 5]); w.w = cvt_pk_bf16(p1[8 * cc + 6], p1[8 * cc + 7]); }
                pa[c] = __builtin_bit_cast(bf16x8, w);
            }
            const LAS unsigned char* vb = lds + AT_VT + buf * VTB + vlane;
#pragma unroll
            for (int c = 0; c < 4; ++c) {
                const int koff = (32 * (c >> 1) + 16 * (c & 1)) * (VTP * 2);
#pragma unroll
                for (int db = 0; db < 2; ++db) {
                    const v4i16_t lo = __builtin_amdgcn_ds_read_tr16_b64_v4i16((LAS v4i16_t*)(vb + koff + 64 * db));
                    const v4i16_t hi4 = __builtin_amdgcn_ds_read_tr16_b64_v4i16((LAS v4i16_t*)(vb + koff + 8 * (VTP * 2) + 64 * db));
                    const bf16x8 bv = (bf16x8){lo[0], lo[1], lo[2], lo[3], hi4[0], hi4[1], hi4[2], hi4[3]};
                    o[db] = __builtin_amdgcn_mfma_f32_32x32x16_bf16(pa[c], bv, o[db], 0, 0, 0);
                }
            }
        }
        if (tt + 1 < ntiles) at_store(lds, buf ^ 1, C.tid, kr, vr);
        __syncthreads();
    }
    const float lt = l + __shfl_xor(l, 32);
    const float inv = lt > 0.f ? frcp(lt) : 0.f;
    if (MODE == 0 && want_imp && C.hi == 0) {
        LAS float* fs = (LAS float*)(lds + AT_FS) + (C.g * 64 + C.tokl) * 2;
        fs[0] = (ntiles > 1) ? fexp2(m0 - mref) * inv : inv; fs[1] = inv;
    }
    if (C.hi == 0) wsf[C.r32] = inv * gatev;
#pragma unroll
    for (int r = 0; r < 16; ++r) { const float f = wsf[(r & 3) + 8 * (r >> 2) + 4 * C.hi]; of[0][r] += o[0][r] * f; of[1][r] += o[1][r] * f; }
}
__device__ __forceinline__ void attn_unit(const Frame& F, int b, int kvh, int i) {
    AttnCtx C; C.lds = F.lds; C.tid = F.tid; C.lane = F.lane; C.wave = F.wave; C.r32 = F.lane & 31; C.hi = F.lane >> 5; C.g = F.wave >> 1; C.th = F.wave & 1; C.tokl = 32 * C.th + C.r32;
    const int h = 4 * kvh + C.g, t = 64 * i + C.tokl, row = b * T + t;
    const bf16_t* Qp = WSP(bf16_t, WS_Q) + ((size_t)(b * 16 + h) * 2048 + t) * 64;
#pragma unroll
    for (int d0 = 0; d0 < 4; ++d0) C.qf[d0] = *(const bf16x8*)(Qp + 16 * d0 + 8 * C.hi);
    const float* gp = WSP(float, WS_GATE) + (size_t)row * 48 + h * 3;
    const float g0 = gp[0], g1 = gp[1], g2 = gp[2];
    const size_t kvoff = (size_t)(b * 4 + kvh) * 2048 * 64;
    f32x16 of[2]; of[0] = (f32x16)(0.f); of[1] = (f32x16)(0.f);
    const bool want_imp = i >= 16;
    u32x4 kr, vr;
    at_load(WSP(bf16_t, WS_KCMP) + (size_t)(b * 4 + kvh) * 128 * 64, WSP(bf16_t, WS_VCMP) + (size_t)(b * 4 + kvh) * 128 * 64, 0, C.tid, kr, vr);
    __syncthreads();
    LAS unsigned* msk = (LAS unsigned*)(F.lds + AT_MSK);
    unsigned rowmask = 0u;
#pragma unroll 1
    for (int ps = 0; ps < 3; ++ps) {
        const bf16_t* Kb; const bf16_t* Vb; int j0, ntl; float gv;
        if (ps == 0) { Kb = WSP(bf16_t, WS_KCMP) + (size_t)(b * 4 + kvh) * 128 * 64; Vb = WSP(bf16_t, WS_VCMP) + (size_t)(b * 4 + kvh) * 128 * 64; j0 = 0; ntl = want_imp ? 2 : 1; gv = g0; }
        else if (ps == 1) { Kb = WSP(bf16_t, WS_KV + 2 * KV_STRIDE) + kvoff; Vb = WSP(bf16_t, WS_KV + 3 * KV_STRIDE) + kvoff; j0 = 0; ntl = i + 1; gv = g1; }
        else { Kb = WSP(bf16_t, WS_KV + 4 * KV_STRIDE) + kvoff; Vb = WSP(bf16_t, WS_KV + 5 * KV_STRIDE) + kvoff; j0 = i >= 8 ? i - 8 : 0; ntl = i - j0 + 1; gv = g2; }
        const bf16_t* Kn = nullptr; const bf16_t* Vn = nullptr; int jn = 0;
        if (ps == 0) { Kn = WSP(bf16_t, WS_KV + 2 * KV_STRIDE) + kvoff; Vn = WSP(bf16_t, WS_KV + 3 * KV_STRIDE) + kvoff; jn = 0; }
        else if (ps == 1) { Kn = WSP(bf16_t, WS_KV + 4 * KV_STRIDE) + kvoff; Vn = WSP(bf16_t, WS_KV + 5 * KV_STRIDE) + kvoff; jn = i >= 8 ? i - 8 : 0; }
        attn_pass(ps, C, Kb, Vb, i, j0, ntl, rowmask, want_imp, gv, of, kr, vr, Kn, Vn, jn);
        if (ps == 0) {
            if (want_imp) {
                __syncthreads();
                LAS float* Gs = (LAS float*)(F.lds + AT_G); LAS float* Ls = (LAS float*)(F.lds + AT_L); LAS float* fs = (LAS float*)(F.lds + AT_FS); LAS float* imp = (LAS float*)(F.lds + AT_IMP);
#pragma unroll 1
                for (int q = 0; q < 4; ++q) {
                    const int idx = F.tid + 512 * q, tok = idx >> 5, j = idx & 31; float v = 0.f;
#pragma unroll
                    for (int g = 0; g < 4; ++g) {
                        const int base = (g * 64 + tok);
                        v += fs[base * 2 + (j >> 4)] * Gs[base * 33 + j];
                        if (j > 0) v += fs[base * 2 + ((j - 1) >> 4)] * Ls[base * 33 + j - 1];
                    }
                    imp[tok * 33 + j] = v;
                }
                __syncthreads();
                {
                    const int tok = F.tid >> 3, sub = F.tid & 7;
                    const LAS float* im = imp + tok * 33;
                    float cv[4]; int cj[4];
#pragma unroll
                    for (int q = 0; q < 4; ++q) { cj[q] = 1 + sub + 8 * q; cv[q] = (cj[q] <= i - 2) ? im[cj[q]] : -2.f; }
                    unsigned mk = 1u | (1u << i) | (1u << (i - 1));
                    for (int rnd = 0; rnd < 13; ++rnd) {
                        float best = -1.f; int bj = 99;
#pragma unroll
                        for (int q = 0; q < 4; ++q) if (cv[q] > best) { best = cv[q]; bj = cj[q]; }
#pragma unroll
                        for (int o = 1; o < 8; o <<= 1) { const float ov = __shfl_xor(best, o); const int oj = __shfl_xor(bj, o); if (ov > best || (ov == best && oj < bj)) { best = ov; bj = oj; } }
                        mk |= 1u << bj;
#pragma unroll
                        for (int q = 0; q < 4; ++q) if (cj[q] == bj) cv[q] = -2.f;
                    }
                    if (sub == 0) msk[tok] = mk;
                }
            } else {
                if (F.tid < 64) msk[F.tid] = (2u << i) - 1u;
            }
            __syncthreads();
            rowmask = msk[C.tokl];
        }
    }
    bf16_t* O = WSP(bf16_t, WS_OCAT); LAS float* ssq = (LAS float*)(F.lds + AT_SSQ);
    LAS bf16_t* stg = (LAS bf16_t*)(F.lds + AT_G) + C.wave * 2048;
#pragma unroll
    for (int r = 0; r < 16; ++r) {
        const int rl = (r & 3) + 8 * (r >> 2) + 4 * C.hi;
        stg[rl * 64 + C.r32] = (bf16_t)(cvt_pk_bf16(of[0][r], 0.f) & 0xffffu); stg[rl * 64 + 32 + C.r32] = (bf16_t)(cvt_pk_bf16(of[1][r], 0.f) & 0xffffu);
        float ss = of[0][r] * of[0][r] + of[1][r] * of[1][r];
        ss += __shfl_xor(ss, 1); ss += __shfl_xor(ss, 2); ss += __shfl_xor(ss, 4); ss += __shfl_xor(ss, 8); ss += __shfl_xor(ss, 16);
        if (C.r32 == 0) ssq[C.g * 64 + 32 * C.th + rl] = ss;
    }
    {
        bf16_t* ob = O + (size_t)(b * T + 64 * i + 32 * C.th + (C.lane >> 3)) * 2048 + h * 64 + (C.lane & 7) * 8;
#pragma unroll
        for (int q = 0; q < 4; ++q) { const u32x4 v = *(const LAS u32x4*)(stg + (q * 8 + (C.lane >> 3)) * 64 + (C.lane & 7) * 8); *(u32x4*)(ob + (size_t)q * 8 * 2048) = v; }
    }
    __syncthreads();
    if (F.tid < 64) WSP(float, WS_OSSN)[(size_t)(b * T + 64 * i + F.tid) * 4 + kvh] = (ssq[F.tid] + ssq[64 + F.tid]) + (ssq[128 + F.tid] + ssq[192 + F.tid]);
}

__device__ __forceinline__ void split_bf16(const float (&v)[8], bf16x8& hi, bf16x8& lo) {
    u32x4 h, l;
    unsigned* hp = (unsigned*)&h; unsigned* lp = (unsigned*)&l;
#pragma unroll
    for (int e = 0; e < 4; ++e) {
        const unsigned pk = cvt_pk_bf16(v[2 * e], v[2 * e + 1]); hp[e] = pk;
        lp[e] = cvt_pk_bf16(v[2 * e] - bflo(pk), v[2 * e + 1] - bfhi(pk));
    }
    hi = __builtin_bit_cast(bf16x8, h); lo = __builtin_bit_cast(bf16x8, l);
}
__device__ __forceinline__ void router_unit(const Frame& F, int un) {
    LAS float* rstd_s = (LAS float*)F.lds;
    LAS float* part = (LAS float*)(F.lds + 1024);
    LAS float* sc_s = (LAS float*)(F.lds + 1024 + 65536);
    LAS float* sb_s = sc_s + 32 * 65;
    LAS int* lcnt = (LAS int*)(sb_s + 32 * 65);
    LAS int* lbase = lcnt + 64;
    const int row0 = un * 32, b = row0 >> 11;
    const float* x1 = F.out; const float* mod = WSP(float, WS_MOD) + b * 6 * D;
    __syncthreads();
    if (F.tid < 64) lcnt[F.tid] = 0;
    {
        f32x4 xv[4][8];
#pragma unroll
        for (int q = 0; q < 4; ++q) { const f32x4* xr = (const f32x4*)(x1 + (size_t)(row0 + F.wave * 4 + q) * D) + F.lane;
#pragma unroll
            for (int j = 0; j < 8; ++j) xv[q][j] = xr[64 * j]; }
#pragma unroll
        for (int q = 0; q < 4; ++q) { float s = 0.f;
#pragma unroll
            for (int j = 0; j < 8; ++j) { const f32x4 v = xv[q][j]; s += (v.x * v.x + v.y * v.y) + (v.z * v.z + v.w * v.w); }
            s = wave_sum(s); if (F.lane == 0) rstd_s[F.wave * 4 + q] = rsqrtf(s * (1.f / D) + EPS); }
    }
    __syncthreads();
    const int r32 = F.lane & 31, hi = F.lane >> 5;
    const float rs = rstd_s[r32];
    f32x16 acc[2]; acc[0] = (f32x16)(0.f); acc[1] = (f32x16)(0.f);
    const float* wr_ = F.in[I_WR];
#pragma unroll 4
    for (int kc = 0; kc < 16; ++kc) {
        const int kk = F.wave * 256 + kc * 16 + 8 * hi;
        float hv[8];
        {
            const f32x4 xa = *(const f32x4*)(x1 + (size_t)(row0 + r32) * D + kk), xb = *(const f32x4*)(x1 + (size_t)(row0 + r32) * D + kk + 4);
            const f32x4 ga = *(const f32x4*)(F.in[I_GN2] + kk), gb = *(const f32x4*)(F.in[I_GN2] + kk + 4);
            const f32x4 sa = *(const f32x4*)(mod + 4 * D + kk), sb2 = *(const f32x4*)(mod + 4 * D + kk + 4);
            const f32x4 ha = *(const f32x4*)(mod + 3 * D + kk), hb = *(const f32x4*)(mod + 3 * D + kk + 4);
            const f32x4 ra = xa * rs * ga * (sa + 1.0f) + ha, rb = xb * rs * gb * (sb2 + 1.0f) + hb;
            hv[0] = ra.x; hv[1] = ra.y; hv[2] = ra.z; hv[3] = ra.w; hv[4] = rb.x; hv[5] = rb.y; hv[6] = rb.z; hv[7] = rb.w;
        }
        bf16x8 ah, al; split_bf16(hv, ah, al);
        { u32x2 h8; h8.x = pk4_fp8(hv[0], hv[1], hv[2], hv[3]); h8.y = pk4_fp8(hv[4], hv[5], hv[6], hv[7]); *(u32x2*)(WSP(unsigned char, WS_H) + (size_t)(row0 + r32) * D + kk) = h8; }
#pragma unroll
        for (int nb = 0; nb < 2; ++nb) {
            float wv[8];
#pragma unroll
            for (int j = 0; j < 8; ++j) wv[j] = wr_[(size_t)(kk + j) * 64 + 32 * nb + r32];
            bf16x8 bh, bl; split_bf16(wv, bh, bl);
            acc[nb] = __builtin_amdgcn_mfma_f32_32x32x16_bf16(ah, bh, acc[nb], 0, 0, 0);
            acc[nb] = __builtin_amdgcn_mfma_f32_32x32x16_bf16(ah, bl, acc[nb], 0, 0, 0);
            acc[nb] = __builtin_amdgcn_mfma_f32_32x32x16_bf16(al, bh, acc[nb], 0, 0, 0);
        }
    }
#pragma unroll
    for (int nb = 0; nb < 2; ++nb)
#pragma unroll
        for (int r = 0; r < 16; ++r) part[(F.wave * 32 + (r & 3) + 8 * (r >> 2) + 4 * hi) * 64 + 32 * nb + r32] = acc[nb][r];
    __syncthreads();
    int eid[8]; int lp[8]; float wk[8];
    const int tok = F.tid >> 4, sub = F.tid & 15;
    {
        const int e4 = sub * 4; f32x4 sacc = (f32x4){0.f, 0.f, 0.f, 0.f};
#pragma unroll
        for (int w = 0; w < 8; ++w) sacc += *(const LAS f32x4*)(part + (w * 32 + tok) * 64 + e4);
        const f32x4 rb = *(const f32x4*)(F.in[I_RB] + e4);
        float s4[4], sb4[4];
#pragma unroll
        for (int v = 0; v < 4; ++v) { s4[v] = 1.0f / (1.0f + expf(-sacc[v])); sb4[v] = s4[v] + rb[v]; }
        float a1 = -3.0e38f, a2 = -3.0e38f;
#pragma unroll
        for (int v = 0; v < 4; ++v) { if (sb4[v] > a1) { a2 = a1; a1 = sb4[v]; } else if (sb4[v] > a2) a2 = sb4[v]; }
        const float b1 = __shfl_xor(a1, 1), b2 = __shfl_xor(a2, 1);
        const float gs = fmaxf(a1, b1) + fmaxf(fminf(a1, b1), fmaxf(a2, b2));
        int rank = 0; const int g = sub >> 1;
#pragma unroll
        for (int gg = 0; gg < 8; ++gg) { const float v = __shfl(gs, (F.lane & ~15) | (2 * gg)); rank += (v > gs || (v == gs && gg < g)) ? 1 : 0; }
        const bool gsel = rank < 4;
        float cv[4];
#pragma unroll
        for (int v = 0; v < 4; ++v) cv[v] = gsel ? sb4[v] : -3.0e38f;
        float wsum = 0.f;
#pragma unroll 1
        for (int k = 0; k < 8; ++k) {
            float best = -3.9e38f; int be = 99; float bs = 0.f;
#pragma unroll
            for (int v = 0; v < 4; ++v) if (cv[v] > best) { best = cv[v]; be = e4 + v; bs = s4[v]; }
#pragma unroll
            for (int o = 1; o < 16; o <<= 1) { const float ov = __shfl_xor(best, o); const int oe = __shfl_xor(be, o); const float os = __shfl_xor(bs, o);
                if (ov > best || (ov == best && oe < be)) { best = ov; be = oe; bs = os; } }
#pragma unroll
            for (int v = 0; v < 4; ++v) if (e4 + v == be) cv[v] = -3.9e38f;
#pragma unroll
            for (int kk = 0; kk < 8; ++kk) if (kk == k) { eid[kk] = be; wk[kk] = bs; }
            wsum += bs;
        }
        const float sc = 2.5f / wsum;
        if (sub == 0) {
#pragma unroll
            for (int k = 0; k < 8; ++k) { wk[k] *= sc; lp[k] = atomicAdd((int*)(lcnt + eid[k]), 1); }
        }
    }
    __syncthreads();
    if (F.tid < 64) { const int c = lcnt[F.tid]; lbase[F.tid] = c ? (int)atomicAdd((unsigned*)(F.ws + WS_CTL) + CW_CNT + F.tid, (unsigned)c) : 0; }
    __syncthreads();
    if (sub == 0) {
        const int row = row0 + tok;
#pragma unroll
        for (int k = 0; k < 8; ++k) { const int pos = lbase[eid[k]] + lp[k];
            WSP(int, WS_EIDX)[row * 8 + k] = eid[k]; WSP(int, WS_POS)[row * 8 + k] = pos; WSP(float, WS_WTS)[row * 8 + k] = wk[k];
            WSP(int, WS_LIST)[eid[k] * 8192 + pos] = row; }
    }
}

__device__ __forceinline__ void phase8(const Frame& F, const LAS int* tb) {
    const int gw = F.vcu * 8 + F.wave, NGW = F.G * 8;
    const unsigned char* PO = WSP(unsigned char, WS_PO);
    for (int row = gw; row < NTOK; row += NGW) {
        const int b = row >> 11;
        size_t pr[9]; float w[9];
#pragma unroll
        for (int k = 0; k < 8; ++k) { const int e = WSP(int, WS_EIDX)[row * 8 + k], pos = WSP(int, WS_POS)[row * 8 + k]; w[k] = WSP(float, WS_WTS)[row * 8 + k] * (1.0f / PO8SCALE); pr[k] = ((size_t)tb[e] * 256 + pos) * 2048; }
        pr[8] = ((size_t)tb[64] * 256 + row) * 2048; w[8] = 1.0f / PO8SCALE;
        const float* gt2 = WSP(float, WS_MOD) + b * 6 * D + 5 * D;
#pragma unroll
        for (int j = 0; j < 2; ++j) {
            const int col = 16 * F.lane + 1024 * j; float a[16];
#pragma unroll
            for (int e = 0; e < 16; ++e) a[e] = 0.f;
#pragma unroll
            for (int k = 0; k < 9; ++k) {
                const u32x4 v = *(const u32x4*)(PO + pr[k] + col);
                const unsigned vv[4] = {v.x, v.y, v.z, v.w};
#pragma unroll
                for (int q = 0; q < 4; ++q) {
                    const f32x2 lo = __builtin_amdgcn_cvt_pk_f32_fp8((int)vv[q], false), hi = __builtin_amdgcn_cvt_pk_f32_fp8((int)vv[q], true);
                    a[4 * q] += w[k] * lo.x; a[4 * q + 1] += w[k] * lo.y; a[4 * q + 2] += w[k] * hi.x; a[4 * q + 3] += w[k] * hi.y;
                }
            }
            float* op = F.out + (size_t)row * D + col;
#pragma unroll
            for (int q = 0; q < 4; ++q) {
                const f32x4 x0 = *(const f32x4*)(op + 4 * q), g0 = *(const f32x4*)(gt2 + col + 4 * q);
                *(f32x4*)(op + 4 * q) = x0 + g0 * (f32x4){a[4 * q], a[4 * q + 1], a[4 * q + 2], a[4 * q + 3]};
            }
        }
    }
}

constexpr int N_PHASES = 11;
__global__ void __launch_bounds__(512, 2) mk_fwd(Params p) {
    extern __shared__ __attribute__((aligned(16))) unsigned char lds_raw[];
    Frame F;
    F.lds = (LAS unsigned char*)lds_raw; F.ws = p.ws; F.in = p.in; F.out = p.out;
    F.tid = threadIdx.x; F.lane = F.tid & 63; F.wave = __builtin_amdgcn_readfirstlane(F.tid >> 6);
    F.G = gridDim.x; { const int bx = blockIdx.x; F.vcu = (F.G % 8 == 0) ? (bx % 8) * (F.G / 8) + bx / 8 : bx; }
    volatile LAS unsigned* MISC = (volatile LAS unsigned*)(F.lds + MISC_OFF);
    if (F.tid < 64) MISC[F.tid] = 0u;
    __syncthreads();
    const int lo = p.ph_lo, hi = p.ph_hi;
    const bool multi = (hi - lo) > 1;
    XcdBarrier bar; bar.bar = (unsigned*)(p.ws + WS_CTL) + CW_BAR; bar.x = 0; bar.st = nullptr;
    if (multi) bar = xcd_barrier_post((unsigned*)(p.ws + WS_CTL) + CW_BAR, MISC + 8);
#ifndef PH_MASK
#define PH_MASK 0xffff
#endif
#define IN(k) (((PH_MASK >> (k)) & 1) && lo <= (k) && (k) < hi)
#define SEAM(k) do { if (IN(k) && IN((k) + 1)) xcd_barrier(bar); } while (0)
#define REP(k) for (int rep_ = 0; rep_ < ((((PROBE_MASK) >> (k)) & 1) ? 2 : 1); ++rep_)
    LAS int* mtab = (LAS int*)(F.lds + LDSX_OFF + 4096);

    if (IN(0)) REP(0) { phase0a(F); SEAM(0); }
    if (IN(1)) REP(1) { phase0b(F); SEAM(1); }
    if (IN(2)) REP(2) {
        const bool split = (F.G == 256);
        if (!split || (int)blockIdx.x < NG_INPROJ) {
            InProjP P; P.A = WSP(bf16_t, WS_H); P.Bt = WSP(bf16_t, WS_WIN_T); P.lda = D; P.G = split ? NG_INPROJ : F.G; P.c = blockIdx.x; P.ws = p.ws; P.gq = p.in[I_GQ]; P.gk = p.in[I_GK];
            pg8::gemm_phase(F.lds, P);
        } else conv_range3(F, CV_EARLY, CV_NT4 - CV_DEFER2, ((int)blockIdx.x - NG_INPROJ) * 8 + F.wave, (256 - NG_INPROJ) * 8);
        SEAM(2);
    }
    if (IN(3) && DUP(3)) {
        {
            CmpP P; P.A = WSP(bf16_t, WS_KV); P.Bt = WSP(bf16_t, WS_WCMP_T); P.lda = 1024; P.G = F.G; P.c = F.vcu; P.ws = p.ws;
            pg8::gemm_phase(F.lds, P);
        }
        if (F.G >= 128) {
            if (F.vcu < 64) gmlp_unit(F, F.vcu);
            else { for (int n = 64 + (F.vcu - 64); n < 512; n += F.G - 64) gmlp_unit(F, n);
                   __syncthreads(); conv_range(F, CV_NT4 - CV_DEFER - CV_DEFER2, CV_NT4 - CV_DEFER, (F.vcu - 64) * 8 + F.wave, (F.G - 64) * 8); }
        } else { for (int n = F.vcu; n < 512; n += F.G) gmlp_unit(F, n); __syncthreads(); conv_range(F, CV_NT4 - CV_DEFER - CV_DEFER2, CV_NT4 - CV_DEFER, F.vcu * 8 + F.wave, F.G * 8); }
        SEAM(3);
    }
    if (IN(3)) {
        {
            CmpP P; P.A = WSP(bf16_t, WS_KV); P.Bt = WSP(bf16_t, WS_WCMP_T); P.lda = 1024; P.G = F.G; P.c = F.vcu; P.ws = p.ws;
            pg8::gemm_phase(F.lds, P);
        }
        if (F.G >= 128) {
            if (F.vcu < 64) gmlp_unit(F, F.vcu);
            else { for (int n = 64 + (F.vcu - 64); n < 512; n += F.G - 64) gmlp_unit(F, n);
                   __syncthreads(); conv_range(F, CV_NT4 - CV_DEFER - CV_DEFER2, CV_NT4 - CV_DEFER, (F.vcu - 64) * 8 + F.wave, (F.G - 64) * 8); }
        } else { for (int n = F.vcu; n < 512; n += F.G) gmlp_unit(F, n); __syncthreads(); conv_range(F, CV_NT4 - CV_DEFER - CV_DEFER2, CV_NT4 - CV_DEFER, F.vcu * 8 + F.wave, F.G * 8); }
        SEAM(3);
    }
    if (IN(4)) REP(4) { phase2b(F); SEAM(4); }
    if (IN(5)) REP(5) {
        for (int n = F.vcu; n < 512; n += F.G) {
            int combo, i; if (n < 256) { combo = n >> 4; i = 31 - (n & 15); } else { combo = (n - 256) >> 4; i = n & 15; }
            attn_unit(F, combo >> 2, combo & 3, i);
        }
        SEAM(5);
    }
    if (IN(6) && DUP(6)) {
        OutProjP P; P.A = WSP(bf16_t, WS_OCAT); P.Bt = WSP(bf16_t, WS_WOUT_T); P.lda = D; P.G = F.G; P.c = blockIdx.x; P.ws = p.ws; P.x = p.in[I_X]; P.out = p.out; P.tab = (LAS f32x2*)(F.lds + LDSX_OFF);
        pg8::gemm_phase(F.lds, P); SEAM(6);
    }
    if (IN(6)) {
        OutProjP P; P.A = WSP(bf16_t, WS_OCAT); P.Bt = WSP(bf16_t, WS_WOUT_T); P.lda = D; P.G = F.G; P.c = blockIdx.x; P.ws = p.ws; P.x = p.in[I_X]; P.out = p.out; P.tab = (LAS f32x2*)(F.lds + LDSX_OFF);
        pg8::gemm_phase(F.lds, P); SEAM(6);
    }
    if (IN(7)) { for (int un = F.vcu; un < 256; un += F.G) router_unit(F, un); SEAM(7); }
    if (IN(8)) REP(8) {
        moe_table(F, mtab);
        { MoeUpP<false> P; P.A = WSP(unsigned char, WS_H); P.Bt = WSP(unsigned char, WS_WGU_T); P.lda = D; P.G = F.G; P.c = F.vcu; P.ws = p.ws; P.tb = mtab; P.c0 = 0; P.idtab = (LAS unsigned*)(F.lds + LDSX_OFF + 10240);
          pg8::gemm_phase(F.lds, P); }
        { MoeUpP<true> P; P.A = WSP(unsigned char, WS_H); P.Bt = WSP(unsigned char, WS_WGU_T); P.lda = D; P.G = F.G; P.c = F.vcu; P.ws = p.ws; P.tb = mtab; P.c0 = (mtab[66] * 4) % F.G; P.idtab = (LAS unsigned*)(F.lds + LDSX_OFF + 10240);
          pg8::gemm_phase(F.lds, P); }
        SEAM(8);
    }
    if (IN(9) && DUP(9)) {
        moe_table(F, mtab);
        { MoeDownP<false> P; P.A = WSP(unsigned char, WS_HID); P.Bt = WSP(unsigned char, WS_WD_T); P.lda = EDIM; P.G = F.G; P.c = F.vcu; P.ws = p.ws; P.tb = mtab; P.c0 = 0;
          pg8::gemm_phase(F.lds, P); }
        { MoeDownP<true> P; P.A = WSP(unsigned char, WS_HID); P.Bt = WSP(unsigned char, WS_WD_T); P.lda = EDIM; P.G = F.G; P.c = F.vcu; P.ws = p.ws; P.tb = mtab; P.c0 = (mtab[66] * 8) % F.G;
          pg8::gemm_phase(F.lds, P); } SEAM(9);
    }
    if (IN(9)) {
        moe_table(F, mtab);
        { MoeDownP<false> P; P.A = WSP(unsigned char, WS_HID); P.Bt = WSP(unsigned char, WS_WD_T); P.lda = EDIM; P.G = F.G; P.c = F.vcu; P.ws = p.ws; P.tb = mtab; P.c0 = 0;
          pg8::gemm_phase(F.lds, P); }
        { MoeDownP<true> P; P.A = WSP(unsigned char, WS_HID); P.Bt = WSP(unsigned char, WS_WD_T); P.lda = EDIM; P.G = F.G; P.c = F.vcu; P.ws = p.ws; P.tb = mtab; P.c0 = (mtab[66] * 8) % F.G;
          pg8::gemm_phase(F.lds, P); } SEAM(9);
    }
    if (IN(10)) { moe_table(F, mtab); phase8(F, mtab); }
#undef IN
#undef SEAM
}

extern "C" void kernel_launch(void* const* d_in, const int* in_sizes, int n_in, void* d_out, int out_size, void* d_ws, size_t ws_size, hipStream_t stream) {
    static int grid = 0;
    if (grid == 0) {
        if (n_in != 29 || out_size != NTOK * D || ws_size < WS_END) { fprintf(stderr, "kernel_launch: unexpected shapes (n_in %d out %d ws %zu)\n", n_in, out_size, ws_size); grid = -1; return; }
        int dev = 0, cus = 0, per_cu = 0;
        hipGetDevice(&dev); hipDeviceGetAttribute(&cus, hipDeviceAttributeMultiprocessorCount, dev);
        if (hipFuncSetAttribute((const void*)mk_fwd, hipFuncAttributeMaxDynamicSharedMemorySize, LDS_BYTES) != hipSuccess) { fprintf(stderr, "kernel_launch: hipFuncSetAttribute failed\n"); grid = -1; return; }
        if (hipOccupancyMaxActiveBlocksPerMultiprocessor(&per_cu, (const void*)mk_fwd, 512, LDS_BYTES) != hipSuccess || per_cu < 1) { fprintf(stderr, "kernel_launch: occupancy query says %d\n", per_cu); per_cu = 1; }
        (void)hipGetLastError();
        grid = cus;
    }
    if (grid < 0) return;
    hipMemsetAsync((char*)d_ws + WS_CTL, 0, CTL_BYTES, stream);
    Params p{};
    for (int i = 0; i < 29; ++i) p.in[i] = (const float*)d_in[i];
    p.out = (float*)d_out; p.ws = (unsigned char*)d_ws;
#if MK_N_LAUNCHES == 1
    p.ph_lo = 0; p.ph_hi = N_PHASES;
    void* args[] = {&p};
    hipError_t e = hipLaunchCooperativeKernel((const void*)mk_fwd, dim3(grid), dim3(512), args, LDS_BYTES, stream);
    if (e != hipSuccess) fprintf(stderr, "kernel_launch: cooperative launch failed: %s (grid %d)\n", hipGetErrorString(e), grid);
#else
    for (int ph = 0; ph < N_PHASES; ++ph) { p.ph_lo = ph; p.ph_hi = ph + 1; hipLaunchKernelGGL(mk_fwd, dim3(grid), dim3(512), LDS_BYTES, stream, p); }
#endif
}
```

```cpp
#include <hip/hip_runtime.h>
#include <hip/hip_cooperative_groups.h>
#include <cstdio>
#include <cstdint>
namespace cg = cooperative_groups;

#ifndef MK_N_LAUNCHES
#define MK_N_LAUNCHES 1
#endif

#ifndef PROBE_MASK
#define PROBE_MASK 0
#endif
#define DUP(k) ((((PROBE_MASK) >> (k)) & 1) != 0)
#define LAS __attribute__((address_space(3)))
#define GAS __attribute__((address_space(1)))
typedef unsigned short bf16_t;
typedef short bf16x8 __attribute__((ext_vector_type(8)));
typedef short s16x4 __attribute__((ext_vector_type(4)));
typedef float f32x4 __attribute__((ext_vector_type(4)));
typedef float f32x2 __attribute__((ext_vector_type(2)));
typedef float f32x16 __attribute__((ext_vector_type(16)));
typedef unsigned u32x4 __attribute__((ext_vector_type(4)));
typedef unsigned u32x2 __attribute__((ext_vector_type(2)));
typedef short v4i16_t __attribute__((ext_vector_type(4)));
typedef int v4i32 __attribute__((ext_vector_type(4)));
typedef int v8i32 __attribute__((ext_vector_type(8)));

constexpr int NB = 4, T = 2048, D = 2048, NTOK = NB * T;
constexpr int NH = 16, KVH = 4, HD = 64;
constexpr int NCMP = 127;
constexpr int NEXP = 64, TOPK = 8, EDIM = 512;
constexpr int IN_COLS = 4656, NIN_T = 19 * 256;
constexpr float EPS = 1e-6f;
constexpr float QSCALE = 0.125f * 1.4426950408889634f;
constexpr float NEGF = -1e30f;
constexpr float W8SCALE = 32.0f, H8SCALE = 4.0f, PO8SCALE = 16.0f;

constexpr size_t MiB = 1u << 20, KiB = 1024;
constexpr size_t WS_CTL = 0, CTL_BYTES = 1 * MiB;
constexpr size_t WS_MOD = 1 * MiB;
constexpr size_t WS_ROPE = 1 * MiB + 256 * KiB;
constexpr size_t WS_BIAS1 = 1 * MiB + 768 * KiB;
constexpr size_t WS_KCMP = 2 * MiB;
constexpr size_t WS_VCMP = 2 * MiB + 256 * KiB;
constexpr size_t WS_OSSN = 2 * MiB + 512 * KiB;
constexpr size_t WS_OSSG = 2 * MiB + 768 * KiB;
constexpr size_t WS_VSS = 3 * MiB + 512 * KiB;
constexpr size_t WS_EIDX = 5 * MiB;
constexpr size_t WS_POS = 5 * MiB + 256 * KiB;
constexpr size_t WS_WTS = 5 * MiB + 512 * KiB;
constexpr size_t WS_LIST = 6 * MiB;
constexpr size_t WS_GATE = 8 * MiB;
constexpr size_t WS_HIDC = 10 * MiB;
constexpr size_t WS_KV = 12 * MiB;
constexpr size_t KV_STRIDE = 4 * MiB;
constexpr size_t WS_Q = 36 * MiB;
constexpr size_t WS_U = 52 * MiB;
constexpr size_t WS_V = 68 * MiB;
constexpr size_t WS_H = 84 * MiB;
constexpr size_t WS_OCAT = 116 * MiB;
constexpr size_t WS_WIN_T = 148 * MiB;
constexpr size_t WS_WOUT_T = 168 * MiB;
constexpr size_t WS_WCMP_T = 176 * MiB;
constexpr size_t WS_WGU_T = 178 * MiB;
constexpr size_t WS_WD_T = 438 * MiB;
constexpr size_t WS_HID = 568 * MiB;
constexpr size_t WS_PO = 656 * MiB;
constexpr size_t WS_END = 1008 * MiB;
constexpr int CW_CNT = 256;
constexpr int CW_BAR = 4096;

constexpr int RING_BYTES = 131072;
constexpr int LDSX_OFF = RING_BYTES;
constexpr int MISC_OFF = RING_BYTES + 12288;
constexpr int LDS_BYTES = 147456;

__device__ __forceinline__ unsigned cvt_pk_bf16(float lo, float hi) { unsigned r; asm volatile("v_cvt_pk_bf16_f32 %0, %1, %2" : "=v"(r) : "v"(lo), "v"(hi)); return r; }
__device__ __forceinline__ unsigned pk4_fp8(float a, float b, float c, float d) { int w = 0; w = __builtin_amdgcn_cvt_pk_fp8_f32(a, b, w, false); w = __builtin_amdgcn_cvt_pk_fp8_f32(c, d, w, true); return (unsigned)w; }
__device__ __forceinline__ float bf2f(unsigned short h) { return __uint_as_float(((unsigned)h) << 16); }
__device__ __forceinline__ float bflo(unsigned w) { return __uint_as_float(w << 16); }
__device__ __forceinline__ float bfhi(unsigned w) { return __uint_as_float(w & 0xffff0000u); }
__device__ __forceinline__ float fexp2(float x) { return __builtin_amdgcn_exp2f(x); }
__device__ __forceinline__ float frcp(float x) { return __builtin_amdgcn_rcpf(x); }
__device__ __forceinline__ float sigmoidf_(float x) { return frcp(1.0f + fexp2(-1.4426950408889634f * x)); }
__device__ __forceinline__ float siluf_(float x) { return x * sigmoidf_(x); }
__device__ __forceinline__ float gelu_tanh(float x) {
    const float u = x * (1.0f + 0.044715f * x * x);
    return x * frcp(1.0f + fexp2(u * (-2.0f * 0.7978845608028654f * 1.4426950408889634f)));
}
__device__ __forceinline__ float wave_sum(float v) {
#pragma unroll
    for (int o = 1; o < 64; o <<= 1) v += __shfl_xor(v, o);
    return v;
}
__device__ __forceinline__ void rope_cs(float pos, int i, float& c, float& s) {
    const float fr = exp2f(-(float)i * (13.287712379549449f / 32.0f));
    const float ang = pos * fr;
    const double rev = (double)ang * 0.15915494309189535;
    const double fr_ = rev - rint(rev);
    const float r = (float)(fr_ * 6.283185307179586);
    c = cosf(r); s = sinf(r);
}

#define XB_TMO      128
#define XB_XCNT(j)  (256  + 64 * (j))
#define XB_XSUB(j)  (1280 + 64 * (j))
#define XB_XGEN(j)  (2304 + 64 * (j))
#define XB_TOP      3328
#define XB_TOPGEN   3392
#define XCD_BAR_WORDS 3456
#define XB_SPIN_CAP (1u << 22)
__device__ __forceinline__ unsigned xb_ld(unsigned* p)              { return __hip_atomic_load(p, __ATOMIC_RELAXED, __HIP_MEMORY_SCOPE_AGENT); }
__device__ __forceinline__ unsigned xb_add(unsigned* p, unsigned v) { return __hip_atomic_fetch_add(p, v, __ATOMIC_RELAXED, __HIP_MEMORY_SCOPE_AGENT); }
__device__ __forceinline__ unsigned xb_xcc_id() { return (unsigned)__builtin_amdgcn_s_getreg((3 << 11) | 20) & 0xFu; }
#define XB_SPIN(cond, bar) do { unsigned _sp = 0; while (cond) { __builtin_amdgcn_s_sleep(1); \
    if ((++_sp & 255u) == 0u) { if (xb_ld(&(bar)[XB_TMO])) break; if (_sp > XB_SPIN_CAP) { atomicAdd(&(bar)[XB_TMO], 1u); break; } } } } while (0)
struct XcdBarrier { unsigned* bar; unsigned x; volatile LAS unsigned* st; };
__device__ __forceinline__ XcdBarrier xcd_barrier_post(unsigned* bar, volatile LAS unsigned* st) {
    XcdBarrier b; b.bar = bar; b.x = xb_xcc_id(); b.st = st;
    if (threadIdx.x == 0) (void)xb_add(&bar[XB_XCNT(b.x)], 1u);
    return b;
}
__device__ __forceinline__ void xcd_barrier_complete(unsigned* bar, unsigned x, unsigned& nloc, unsigned& nx) {
    const unsigned G = gridDim.x * gridDim.y * gridDim.z;
    unsigned sum, cnt, mine, sp = 0u;
    for (;;) {
        sum = 0u; cnt = 0u; mine = 0u;
#pragma unroll
        for (unsigned j = 0; j < 16; ++j) { const unsigned c = xb_ld(&bar[XB_XCNT(j)]); sum += c; cnt += (c > 0u) ? 1u : 0u; mine = (j == x) ? c : mine; }
        if (sum == G) break;
        __builtin_amdgcn_s_sleep(1);
        if ((++sp & 255u) == 0u) { if (xb_ld(&bar[XB_TMO])) break; if (sp > XB_SPIN_CAP) { atomicAdd(&bar[XB_TMO], 1u); break; } }
    }
    nloc = mine > 0u ? mine : 1u; nx = cnt > 0u ? cnt : 1u;
}
__device__ __forceinline__ void xcd_barrier(const XcdBarrier& b) {
    asm volatile("s_waitcnt vmcnt(0)" ::: "memory");
    __syncthreads();
    if (threadIdx.x == 0) {
        unsigned* bar = b.bar;
        __builtin_amdgcn_s_waitcnt(0);
        unsigned nloc = b.st[0], nx = b.st[1];
        if (nloc == 0u) { xcd_barrier_complete(bar, b.x, nloc, nx); b.st[0] = nloc; b.st[1] = nx; }
        const unsigned old = xb_add(&bar[XB_XSUB(b.x)], 1u);
        const unsigned gen = old / nloc;
        if (old + 1u == (gen + 1u) * nloc) {
            __builtin_amdgcn_fence(__ATOMIC_RELEASE, "agent");
            asm volatile("s_waitcnt vmcnt(0)" ::: "memory");
            const unsigned og = xb_add(&bar[XB_TOP], 1u);
            const unsigned tg = og / nx;
            if (og + 1u == (tg + 1u) * nx) xb_add(&bar[XB_TOPGEN], 1u);
            else XB_SPIN(xb_ld(&bar[XB_TOPGEN]) == tg, bar);
            __builtin_amdgcn_fence(__ATOMIC_ACQUIRE, "agent");
            xb_add(&bar[XB_XGEN(b.x)], 1u);
            asm volatile("s_waitcnt vmcnt(0)" ::: "memory");
        } else {
            XB_SPIN(xb_ld(&bar[XB_XGEN(b.x)]) == gen, bar);
            __builtin_amdgcn_fence(__ATOMIC_ACQUIRE, "agent");
            asm volatile("s_waitcnt vmcnt(0)" ::: "memory");
        }
    }
    __syncthreads();
}

struct Params { const float* in[29]; float* out; unsigned char* ws; int ph_lo, ph_hi; };
enum { I_X = 0, I_C, I_WADA, I_BADA, I_GN1, I_WIN, I_GQ, I_GK, I_CPK, I_CPV, I_CW1K, I_CW2K, I_CW1V, I_CW2V, I_GGV, I_WSP, I_BSP, I_GON, I_GOG, I_WOUT, I_GN2,
       I_WR, I_RB, I_WG, I_WU, I_WD, I_SG, I_SU, I_SD };

namespace pg8 {
constexpr int BM = 256, BK = 64, HALF = 128, HTB = HALF * BK * 2, NXCD = 8, WGM = 8;
__device__ __forceinline__ int lds_byte(int r, int c) { const int st = (r >> 4) * 2 + (c >> 5), rr = r & 15, cc = c & 31, ob = rr * 64 + cc * 2; return st * 1024 + (ob ^ (((ob >> 9) & 1) << 5)); }
__device__ __forceinline__ void stage_rc(int b, int& R, int& C) { const int st = b / 1024, sb = b % 1024, swz = sb ^ (((sb >> 9) & 1) << 5); R = (st >> 1) * 16 + swz / 64; C = (st & 1) * 32 + (swz % 64) / 2; }
__device__ __forceinline__ int perm32(int rho) { const int n = rho >> 4, i = rho & 15; return 8 * (i >> 2) + 4 * n + (i & 3); }
struct Unit { int pm, pn, e, aux; };

__device__ __forceinline__ bool dense_next(int i, int G, int c, int nM, int nN, Unit& u) {
    const int nwg = nM * nN; const long L = (long)i * G + c; if (L >= nwg) return false;
    int wgid = (int)L; { const int q = nwg / NXCD, r = nwg % NXCD, xcd = wgid % NXCD, off = wgid / NXCD; wgid = (xcd < r ? xcd * (q + 1) : r * (q + 1) + (xcd - r) * q) + off; }
    const int nig = WGM * nN, gid = wgid / nig, fm = gid * WGM, gsz = (nM - fm) < WGM ? (nM - fm) : WGM;
    u.pm = fm + ((wgid % nig) % gsz); u.pn = (wgid % nig) / gsz; u.e = 0; u.aux = 0; return true;
}

template <class P>
__device__ __forceinline__ void gemm_phase(LAS unsigned char* lds, const P& prm) {
    const int tid = threadIdx.x, wid = __builtin_amdgcn_readfirstlane(tid >> 6), lane = tid & 63, wr = wid >> 2, wc = wid & 3, fr = lane & 15, fq = lane >> 4;
    constexpr int K = P::K, ESZ = P::ESZ, nt = (K * ESZ) / 128;
    const unsigned lda2 = (unsigned)prm.lda * (unsigned)ESZ;
    int Rl[2], Cl[2]; unsigned voffB[2];
#pragma unroll
    for (int i = 0; i < 2; ++i) { int R, C; stage_rc(tid * 16 + i * 8192, R, C); Rl[i] = R; Cl[i] = C; const int Rb = (R & ~31) + perm32(R & 31); voffB[i] = (unsigned)(Rb * P::LDB * ESZ + C * 2); }
    const size_t kstep = (size_t)(BK * 2);
    const size_t hstepB = (size_t)HALF * P::LDB * ESZ;
    const unsigned ldsw = (unsigned)wid * 1024u;
    const int fcol = fq * 8;
    const int aoff = lds_byte(wr * 64 + fr, fcol), boff = lds_byte(wc * 32 + fr, fcol);
    constexpr int fkst = 1024;
#define PG8_SA(b, h) (((b) * 2 + (h)) * HTB)
#define PG8_SB(b, h) ((4 + (b) * 2 + (h)) * HTB)
#define PG8_STAGE(bufoff, gbase, voff) do { _Pragma("unroll") for (int _i = 0; _i < 2; ++_i) \
        __builtin_amdgcn_global_load_lds((const unsigned*)((const char*)(gbase) + (voff)[_i]), (LAS unsigned*)(lds + (bufoff) + ldsw + _i * 8192), 16, 0, 0); } while (0)
#define PG8_LDA(dst, b, h) do { _Pragma("unroll") for (int m = 0; m < 4; ++m) _Pragma("unroll") for (int k = 0; k < 2; ++k) dst[m][k] = *(const LAS bf16x8*)(lds + PG8_SA(b, h) + aoff + m * 2048 + k * fkst); } while (0)
#define PG8_LDB(dst, b, h) do { _Pragma("unroll") for (int n = 0; n < 2; ++n) _Pragma("unroll") for (int k = 0; k < 2; ++k) dst[n][k] = *(const LAS bf16x8*)(lds + PG8_SB(b, h) + boff + n * 2048 + k * fkst); } while (0)
#define PG8_MMA(ai, bj, At, Bt) do { __builtin_amdgcn_s_setprio(1); \
        if constexpr (ESZ == 2) { _Pragma("unroll") for (int m = 0; m < 4; ++m) _Pragma("unroll") for (int n = 0; n < 2; ++n) _Pragma("unroll") for (int k = 0; k < 2; ++k) \
            acc[ai][bj][m][n] = __builtin_amdgcn_mfma_f32_16x16x32_bf16(Bt[n][k], At[m][k], acc[ai][bj][m][n], 0, 0, 0); } \
        else { _Pragma("unroll") for (int m = 0; m < 4; ++m) _Pragma("unroll") for (int n = 0; n < 2; ++n) { \
            const v8i32 a8_ = __builtin_shufflevector(__builtin_bit_cast(v4i32, At[m][0]), __builtin_bit_cast(v4i32, At[m][1]), 0, 1, 2, 3, 4, 5, 6, 7); \
            const v8i32 b8_ = __builtin_shufflevector(__builtin_bit_cast(v4i32, Bt[n][0]), __builtin_bit_cast(v4i32, Bt[n][1]), 0, 1, 2, 3, 4, 5, 6, 7); \
            acc[ai][bj][m][n] = __builtin_amdgcn_mfma_scale_f32_16x16x128_f8f6f4(b8_, a8_, acc[ai][bj][m][n], 0, 0, 0, 0x7f7f7f7f, 0, 0x7f7f7f7f); } } \
        __builtin_amdgcn_s_setprio(0); } while (0)
#define PG8_WAIT_V(n) asm volatile("s_waitcnt vmcnt(" #n ")" ::: "memory")
#define PG8_WAIT_L(n) asm volatile("s_waitcnt lgkmcnt(" #n ")" ::: "memory")
#define PG8_WAIT_VK() do { if constexpr (P::HALFONLY) asm volatile("s_waitcnt vmcnt(6)" ::: "memory"); else asm volatile("s_waitcnt vmcnt(8)" ::: "memory"); } while (0)
#define PG8_BAR __builtin_amdgcn_s_barrier()
#define PG8_SCHED __builtin_amdgcn_sched_barrier(0)
    Unit cur, nxt; int ui = 0;
    if (!prm.next(0, cur)) return;
    f32x4 acc[2][2][4][2];
#pragma unroll
    for (int a = 0; a < 2; ++a)
#pragma unroll
        for (int b = 0; b < 2; ++b)
#pragma unroll
            for (int m = 0; m < 4; ++m)
#pragma unroll
                for (int n = 0; n < 2; ++n) acc[a][b][m][n] = (f32x4){0.f, 0.f, 0.f, 0.f};
    bf16x8 At[4][2], B0[2][2], B1[2][2];
    const char* Ab = (const char*)prm.A;
    unsigned offA0[2], offA1[2];
#pragma unroll
    for (int i = 0; i < 2; ++i) { offA0[i] = prm.row_id(cur, Rl[i]) * lda2 + (unsigned)Cl[i] * 2u + prm.a_koff(cur); offA1[i] = prm.row_id(cur, Rl[i] + HALF) * lda2 + (unsigned)Cl[i] * 2u + prm.a_koff(cur); }
    const char* cB = prm.b_base(cur);
    PG8_STAGE(PG8_SB(0, 0), cB, voffB); PG8_STAGE(PG8_SB(0, 1), cB + hstepB, voffB); PG8_STAGE(PG8_SA(0, 0), Ab, offA0); if constexpr (!P::HALFONLY) PG8_STAGE(PG8_SA(0, 1), Ab, offA1);
    if (wr == 1) PG8_BAR;
    if constexpr (P::HALFONLY) PG8_WAIT_V(0); else PG8_WAIT_V(2);
    PG8_BAR;
    PG8_STAGE(PG8_SB(1, 0), cB + kstep, voffB); PG8_STAGE(PG8_SA(1, 0), Ab + kstep, offA0); PG8_STAGE(PG8_SB(1, 1), cB + hstepB + kstep, voffB);
    PG8_WAIT_V(6); PG8_BAR;
    for (;;) {
        const bool has_next = prm.next(ui + 1, nxt);
        const char* nB = has_next ? prm.b_base(nxt) : cB;
        prm.unit_begin(cur, ui);
        unsigned idn[4] = {0u, 0u, 0u, 0u};
#pragma unroll 1
        for (int t = 0; t < nt; t += 2) {
            const bool last = (t == nt - 2);
            if (t == nt - 4 && has_next) {
                if constexpr (P::IDLDS) prm.ids_prefetch(nxt, wid, lane);
                else {
#pragma unroll
                    for (int i = 0; i < 2; ++i) { idn[i] = prm.row_id(nxt, Rl[i]); idn[2 + i] = prm.row_id(nxt, Rl[i] + HALF); }
                }
            }
            const char* a1 = Ab + (size_t)(t + 1) * kstep;
            const char* a2 = last ? Ab : Ab + (size_t)(t + 2) * kstep; const char* b2 = last ? nB : cB + (size_t)(t + 2) * kstep;
            const char* a3 = a2 + kstep; const char* b3 = b2 + kstep;
            if constexpr (P::MIDK) { if (t == nt / 2) prm.midk(acc, cur, ui, wr, fr); }
            PG8_LDB(B0, 0, 0); PG8_LDB(B1, 0, 1); PG8_SCHED; PG8_LDA(At, 0, 0); if constexpr (!P::HALFONLY) PG8_STAGE(PG8_SA(1, 1), a1, offA1);
            if (last && has_next) {
                if constexpr (P::IDLDS) {
#pragma unroll
                    for (int i = 0; i < 2; ++i) { idn[i] = prm.ids_read(nxt, Rl[i]); idn[2 + i] = prm.ids_read(nxt, Rl[i] + HALF); }
                }
#pragma unroll
                for (int i = 0; i < 2; ++i) { offA0[i] = idn[i] * lda2 + (unsigned)Cl[i] * 2u + prm.a_koff(nxt); offA1[i] = idn[2 + i] * lda2 + (unsigned)Cl[i] * 2u + prm.a_koff(nxt); }
            }
            PG8_WAIT_VK(); PG8_WAIT_L(0); PG8_BAR; PG8_MMA(0, 0, At, B0); PG8_MMA(0, 1, At, B1); PG8_BAR; PG8_SCHED;
            if constexpr (!P::HALFONLY) PG8_LDA(At, 0, 1); PG8_STAGE(PG8_SB(0, 0), b2, voffB); PG8_STAGE(PG8_SB(0, 1), b2 + hstepB, voffB); PG8_STAGE(PG8_SA(0, 0), a2, offA0);
            PG8_WAIT_VK(); PG8_WAIT_L(0); PG8_BAR; if constexpr (!P::HALFONLY) { PG8_MMA(1, 0, At, B0); PG8_MMA(1, 1, At, B1); } PG8_BAR; PG8_SCHED;
            PG8_LDB(B0, 1, 0); PG8_LDB(B1, 1, 1); PG8_SCHED; PG8_LDA(At, 1, 0); if constexpr (!P::HALFONLY) PG8_STAGE(PG8_SA(0, 1), a2, offA1);
            PG8_WAIT_VK(); PG8_WAIT_L(0); PG8_BAR; PG8_MMA(0, 0, At, B0); PG8_MMA(0, 1, At, B1); PG8_BAR; PG8_SCHED;
            if constexpr (!P::HALFONLY) PG8_LDA(At, 1, 1); PG8_STAGE(PG8_SB(1, 0), b3, voffB); PG8_STAGE(PG8_SB(1, 1), b3 + hstepB, voffB); PG8_STAGE(PG8_SA(1, 0), a3, offA0);
            PG8_WAIT_VK(); PG8_WAIT_L(0); PG8_BAR; if constexpr (!P::HALFONLY) { PG8_MMA(1, 0, At, B0); PG8_MMA(1, 1, At, B1); } PG8_BAR; PG8_SCHED;
        }
        if (wr == 0) PG8_BAR;
        prm.epi(acc, cur, ui, wr, wc, fr, fq);
        if (DUP(16)) { asm volatile("" ::: "memory"); prm.epi(acc, cur, ui, wr, wc, fr, fq); }
        if (!has_next) break;
#pragma unroll
        for (int a = 0; a < 2; ++a)
#pragma unroll
            for (int b = 0; b < 2; ++b)
#pragma unroll
                for (int m = 0; m < 4; ++m)
#pragma unroll
                    for (int n = 0; n < 2; ++n) acc[a][b][m][n] = (f32x4){0.f, 0.f, 0.f, 0.f};
        cur = nxt; cB = nB; ++ui;
        if (wr == 1) PG8_BAR;
    }
    PG8_WAIT_V(0);
    PG8_BAR;
#undef PG8_SA
#undef PG8_SB
#undef PG8_STAGE
#undef PG8_LDA
#undef PG8_LDB
#undef PG8_MMA
#undef PG8_WAIT_V
#undef PG8_WAIT_L
#undef PG8_WAIT_VK
#undef PG8_BAR
#undef PG8_SCHED
}
}
using pg8::Unit;
typedef f32x4 Acc[2][2][4][2];

struct Frame {
    LAS unsigned char* lds;
    unsigned char* ws;
    const float* const* in;
    float* out;
    int tid, lane, wave, G, vcu;
};
#define WSP(T_, off) ((T_*)(F.ws + (off)))

struct ConvItem { const float* src; int ldn; int k0; int n0; bf16_t* dst; int Kd; int drow0; int mode; int nvalid; int fp8; const float* rs0; const float* rs1; };
constexpr int CV_WIN = 16 * 38, CV_WOUT = 256, CV_CMP = 64, CV_GU = 65 * 128, CV_DN = 65 * 64;
constexpr int CV_TOTAL = CV_WIN + CV_WOUT + CV_CMP + CV_GU + CV_DN;
__device__ __forceinline__ void conv_decode(const Frame& F, int it, ConvItem& c) {
    c.mode = 0; c.nvalid = 128; c.fp8 = 0; c.rs0 = nullptr; c.rs1 = nullptr;
    if (it < CV_WIN) {
        const int kb = it / 38, nb = it % 38; c.src = F.in[I_WIN]; c.ldn = IN_COLS; c.k0 = kb * 128; c.dst = WSP(bf16_t, WS_WIN_T); c.Kd = 2048;
        if (nb < 20) { c.n0 = nb * 128; c.drow0 = (nb >> 1) * 256; c.mode = 1 + (nb & 1); }
        else if (nb < 28) { c.n0 = 2608 + (nb - 20) * 128; c.drow0 = 2560 + (nb - 20) * 128; }
        else if (nb < 36) { c.n0 = 3632 + (nb - 28) * 128; c.drow0 = 3584 + (nb - 28) * 128; }
        else if (nb == 36) { c.n0 = 2560; c.drow0 = 4608; c.nvalid = 48; }
        else { c.n0 = 2560; c.drow0 = 4736; c.nvalid = 0; }
        return;
    }
    it -= CV_WIN;
    if (it < CV_WOUT) { const int kb = it / 16, nb = it % 16; c.src = F.in[I_WOUT]; c.ldn = 2048; c.k0 = kb * 128; c.n0 = nb * 128; c.dst = WSP(bf16_t, WS_WOUT_T); c.Kd = 2048; c.drow0 = nb * 128;
        c.rs0 = F.in[I_GON]; c.rs1 = F.in[I_GOG]; return; }
    it -= CV_WOUT;
    if (it < CV_CMP) { const int kv = it / 32, r = it % 32, kb = r / 2, nb = r % 2; c.src = F.in[kv ? I_CW1V : I_CW1K]; c.ldn = 256; c.k0 = kb * 128; c.n0 = nb * 128;
        c.dst = WSP(bf16_t, WS_WCMP_T) + (size_t)kv * 256 * 2048; c.Kd = 2048; c.drow0 = nb * 128; return; }
    it -= CV_CMP;
    if (it < CV_GU) { const int e = it / 128, r = it % 128, up = r / 64, kb = (r % 64) / 4, nb = r % 4;
        c.src = (e < 64) ? F.in[up ? I_WU : I_WG] + (size_t)e * 2048 * 512 : F.in[up ? I_SU : I_SG];
        c.ldn = 512; c.k0 = kb * 128; c.n0 = nb * 128; c.dst = (bf16_t*)(WSP(unsigned char, WS_WGU_T) + (size_t)e * 1024 * 2048); c.Kd = 2048; c.drow0 = nb * 256 + up * 128; c.fp8 = 1; return; }
    it -= CV_GU;
    { const int e = it / 64, r = it % 64, kb = r / 16, nb = r % 16;
      c.src = (e < 64) ? F.in[I_WD] + (size_t)e * 512 * 2048 : F.in[I_SD];
      c.ldn = 2048; c.k0 = kb * 128; c.n0 = nb * 128; c.dst = (bf16_t*)(WSP(unsigned char, WS_WD_T) + (size_t)e * 2048 * 512); c.Kd = 512; c.drow0 = nb * 128; c.fp8 = 1; c.mode = 3; }
}
__device__ __forceinline__ void conv_load(const ConvItem& c, int sub, int lane, f32x4 (&v)[16]) {
    const int n4 = lane & 15, kq = lane >> 4, nl = 64 * (sub & 1) + 4 * n4;
    const bool ok = nl < c.nvalid;
    if (c.fp8) {
        const float* s = c.src + (size_t)(c.k0 + 64 * (sub >> 1) + 4 * kq) * c.ldn + c.n0 + nl;
#pragma unroll
        for (int i = 0; i < 4; ++i)
#pragma unroll
            for (int j = 0; j < 4; ++j) v[4 * i + j] = __builtin_nontemporal_load((const f32x4*)(s + (size_t)(16 * i + j) * c.ldn));
        return;
    }
    const float* s = c.src + (size_t)(c.k0 + 64 * (sub >> 1) + 2 * kq) * c.ldn + c.n0 + nl;
#pragma unroll
    for (int i = 0; i < 8; ++i) {
        v[2 * i] = ok ? __builtin_nontemporal_load((const f32x4*)(s + (size_t)(8 * i) * c.ldn)) : (f32x4){0.f, 0.f, 0.f, 0.f};
        v[2 * i + 1] = ok ? __builtin_nontemporal_load((const f32x4*)(s + (size_t)(8 * i + 1) * c.ldn)) : (f32x4){0.f, 0.f, 0.f, 0.f};
    }
}
__device__ __forceinline__ void conv_process(const ConvItem& c, int sub, int lane, const f32x4 (&v)[16], LAS unsigned* tile) {
    const int n4 = lane & 15, kq = lane >> 4, kb = c.k0 + 64 * (sub >> 1);
    if (c.fp8) {
#pragma unroll
        for (int i = 0; i < 4; ++i)
#pragma unroll
            for (int cc = 0; cc < 4; ++cc) tile[(4 * n4 + cc) * 129 + 4 * i + kq] = pk4_fp8(v[4 * i][cc] * W8SCALE, v[4 * i + 1][cc] * W8SCALE, v[4 * i + 2][cc] * W8SCALE, v[4 * i + 3][cc] * W8SCALE);
        return;
    }
#pragma unroll
    for (int i = 0; i < 8; ++i) {
        float s0 = 1.f, s1 = 1.f;
        if (c.rs0) { const int k = kb + 8 * i + 2 * kq; s0 = (k < 1024) ? c.rs0[k] : c.rs1[k - 1024]; s1 = (k + 1 < 1024) ? c.rs0[k + 1] : c.rs1[k + 1 - 1024]; }
#pragma unroll
        for (int cc = 0; cc < 4; ++cc) tile[(4 * n4 + cc) * 33 + 4 * i + kq] = cvt_pk_bf16(v[2 * i][cc] * s0, v[2 * i + 1][cc] * s1);
    }
#pragma unroll
    for (int j = 0; j < 8; ++j) {
        const int row = (lane >> 3) + 8 * j, c8 = lane & 7;
        const LAS unsigned* sp = tile + row * 33 + 4 * c8;
        u32x4 o; o.x = sp[0]; o.y = sp[1]; o.z = sp[2]; o.w = sp[3];
        const int n = 64 * (sub & 1) + row;
        int drow = c.drow0 + n;
        if (c.mode) { const int l = (c.mode - 1) * 128 + n, wc = l >> 6, bj = (l >> 5) & 1, jj = l & 31; drow = c.drow0 + 128 * bj + 32 * wc + jj; }
        __builtin_nontemporal_store(o, (u32x4*)(c.dst + (size_t)drow * c.Kd + kb + 8 * c8));
    }
}
template <int R>
__device__ __forceinline__ void gemv_item(const Frame& F, const LAS float* a_lds, LAS float* red, const float* W, int ldn, int n0, const float* bias, float* out, int ldo) {
    const int ks = F.tid >> 4, c4 = F.tid & 15;
    float acc[R][4];
#pragma unroll
    for (int r = 0; r < R; ++r) { acc[r][0] = 0.f; acc[r][1] = 0.f; acc[r][2] = 0.f; acc[r][3] = 0.f; }
    const float* wp = W + (size_t)(ks * 64) * ldn + n0 + 4 * c4;
#pragma unroll 16
    for (int kk = 0; kk < 64; ++kk) {
        const f32x4 w = *(const f32x4*)(wp + (size_t)kk * ldn);
#pragma unroll
        for (int r = 0; r < R; ++r) { const float a = a_lds[r * 2048 + ks * 64 + kk]; acc[r][0] += a * w.x; acc[r][1] += a * w.y; acc[r][2] += a * w.z; acc[r][3] += a * w.w; }
    }
#pragma unroll
    for (int r = 0; r < R; ++r) *(LAS f32x4*)(red + (ks * R + r) * 64 + 4 * c4) = (f32x4){acc[r][0], acc[r][1], acc[r][2], acc[r][3]};
    __syncthreads();
    if (F.tid < R * 64) {
        const int r = F.tid >> 6, n = F.tid & 63; float s = bias ? bias[n0 + n] : 0.f;
        for (int k = 0; k < 32; ++k) s += red[(k * R + r) * 64 + n];
        out[(size_t)r * ldo + n0 + n] = s;
    }
    __syncthreads();
}
constexpr int CV_NT4 = CV_TOTAL * 4;
constexpr int CV_DEFER = 0;
constexpr int CV_EARLY = 76 * 32;
constexpr int CV_EARLY_ALL = 76 * 32 + 32 * 32 + 2 * 4 * 32;
constexpr int NG_INPROJ = 132;
constexpr int CV_DEFER2 = 0;
__device__ __forceinline__ void tile_decode(int T, int& item, int& sub) {
    constexpr int T_WIN = 76 * 32, T_WOUT = 32 * 32, T_CMP = 2 * 4 * 32, T_GU = 65 * 2 * 8 * 32;
    int kb, nb;
    if (T < T_WIN) { kb = T & 31; nb = T >> 5; item = (kb >> 1) * 38 + (nb >> 1); }
    else if ((T -= T_WIN) < T_WOUT) { kb = T & 31; nb = T >> 5; item = CV_WIN + (kb >> 1) * 16 + (nb >> 1); }
    else if ((T -= T_WOUT) < T_CMP) { kb = T & 31; nb = (T >> 5) & 3; const int kv = T >> 7; item = CV_WIN + CV_WOUT + kv * 32 + (kb >> 1) * 2 + (nb >> 1); }
    else if ((T -= T_CMP) < T_GU) { kb = T & 31; nb = (T >> 5) & 7; const int eu = T >> 8; item = CV_WIN + CV_WOUT + CV_CMP + eu * 64 + (kb >> 1) * 4 + (nb >> 1); }
    else { T -= T_GU; kb = T & 7; nb = (T >> 3) & 31; const int e = T >> 8; item = CV_WIN + CV_WOUT + CV_CMP + CV_GU + e * 64 + (kb >> 1) * 16 + (nb >> 1); }
    sub = ((kb & 1) << 1) | (nb & 1);
}
__device__ __forceinline__ void conv_coop_store(const ConvItem& c0, int s0, int tid, const LAS unsigned* img) {
    unsigned char* d8 = (unsigned char*)c0.dst; const int kbase = c0.k0 + 64 * (s0 >> 1);
#pragma unroll
    for (int q = 0; q < 4; ++q) {
        const int ch = tid + 512 * q, row = ch >> 5, c16 = ch & 31;
        const LAS unsigned* sp = img + row * 129 + 4 * c16;
        u32x4 o; o.x = sp[0]; o.y = sp[1]; o.z = sp[2]; o.w = sp[3];
        int drow = c0.drow0 + 64 * (s0 & 1) + row;
        if (c0.mode == 3) { const int L = drow & 255; drow = (drow & ~255) + 128 * ((L >> 3) & 1) + 32 * (L >> 6) + 8 * ((L >> 4) & 3) + (L & 7); }
        __builtin_nontemporal_store(o, (u32x4*)(d8 + (size_t)drow * c0.Kd + kbase + 16 * c16));
    }
}
__device__ __forceinline__ void conv_range(const Frame& F, int t0, int t1, int wid, int nw) {
    LAS unsigned* tile = (LAS unsigned*)F.lds + F.wave * (64 * 33);
    LAS unsigned* img0 = (LAS unsigned*)(F.lds + 67584);
    int ta = t0 + wid; const int te = t1; int par = 0;
    ConvItem ca, cb, c0; f32x4 va[16], vb[16]; int ia, sa, ib, sb, i0, s0;
    if (ta < te) { tile_decode(ta, ia, sa); conv_decode(F, ia, ca); conv_load(ca, sa, F.lane, va); }
    while (ta < te) {
        const int tb = ta + nw;
        if (tb < te) { tile_decode(tb, ib, sb); conv_decode(F, ib, cb); conv_load(cb, sb, F.lane, vb); }
        if (ca.fp8) {
            LAS unsigned* img = img0 + par * (64 * 129);
            conv_process(ca, sa, F.lane, va, img + 16 * F.wave);
            __syncthreads();
            tile_decode(ta - F.wave, i0, s0); conv_decode(F, i0, c0); conv_coop_store(c0, s0, F.tid, img); par ^= 1;
        } else conv_process(ca, sa, F.lane, va, tile);
        if (tb >= te) break;
        ta = tb + nw;
        if (ta < te) { tile_decode(ta, ia, sa); conv_decode(F, ia, ca); conv_load(ca, sa, F.lane, va); }
        if (cb.fp8) {
            LAS unsigned* img = img0 + par * (64 * 129);
            conv_process(cb, sb, F.lane, vb, img + 16 * F.wave);
            __syncthreads();
            tile_decode(tb - F.wave, i0, s0); conv_decode(F, i0, c0); conv_coop_store(c0, s0, F.tid, img); par ^= 1;
        } else conv_process(cb, sb, F.lane, vb, tile);
    }
}
__device__ __forceinline__ void conv_process8_wave(const ConvItem& c, int sub, int lane, const f32x4 (&v)[16], LAS unsigned* tile) {
    const int n4 = lane & 15, kq = lane >> 4, kb = c.k0 + 64 * (sub >> 1);
#pragma unroll
    for (int i = 0; i < 4; ++i)
#pragma unroll
        for (int cc = 0; cc < 4; ++cc) tile[(4 * n4 + cc) * 17 + 4 * i + kq] = pk4_fp8(v[4 * i][cc] * W8SCALE, v[4 * i + 1][cc] * W8SCALE, v[4 * i + 2][cc] * W8SCALE, v[4 * i + 3][cc] * W8SCALE);
    unsigned char* d8 = (unsigned char*)c.dst;
#pragma unroll
    for (int j = 0; j < 4; ++j) {
        const int row = (lane >> 2) + 16 * j, c4 = lane & 3;
        const LAS unsigned* sp = tile + row * 17 + 4 * c4;
        u32x4 o; o.x = sp[0]; o.y = sp[1]; o.z = sp[2]; o.w = sp[3];
        int drow = c.drow0 + 64 * (sub & 1) + row;
        if (c.mode == 3) { const int L = drow & 255; drow = (drow & ~255) + 128 * ((L >> 3) & 1) + 32 * (L >> 6) + 8 * ((L >> 4) & 3) + (L & 7); }
        __builtin_nontemporal_store(o, (u32x4*)(d8 + (size_t)drow * c.Kd + kb + 16 * c4));
    }
}
__device__ __forceinline__ void conv_step(const Frame& F, const ConvItem& c, int sid, const f32x4 (&v)[16], int tcur, LAS unsigned* tile, LAS unsigned* img0, int& par) {
    if (c.fp8) { conv_process8_wave(c, sid, F.lane, v, tile);
    } else conv_process(c, sid, F.lane, v, tile);
}
__device__ __forceinline__ void conv_range3(const Frame& F, int t0, int t1, int wid, int nw) {
    LAS unsigned* tile = (LAS unsigned*)F.lds + F.wave * (64 * 33);
    LAS unsigned* img0 = (LAS unsigned*)(F.lds + 67584);
    int par = 0; const int te = t1;
    ConvItem ca, cb, cc; f32x4 va[16], vb[16], vc[16]; int ia, sa, ib, sb, ic, sc;
    int ta = t0 + wid, tb = ta + nw, tc = tb + nw;
    if (ta < te) { tile_decode(ta, ia, sa); conv_decode(F, ia, ca); conv_load(ca, sa, F.lane, va); }
    if (tb < te) { tile_decode(tb, ib, sb); conv_decode(F, ib, cb); conv_load(cb, sb, F.lane, vb); }
    while (ta < te) {
        if (tc < te) { tile_decode(tc, ic, sc); conv_decode(F, ic, cc); conv_load(cc, sc, F.lane, vc); }
        conv_step(F, ca, sa, va, ta, tile, img0, par);
        ta = tc + nw;
        if (tb >= te) break;
        if (ta < te) { tile_decode(ta, ia, sa); conv_decode(F, ia, ca); conv_load(ca, sa, F.lane, va); }
        conv_step(F, cb, sb, vb, tb, tile, img0, par);
        tb = ta + nw;
        if (tc >= te) break;
        if (tb < te) { tile_decode(tb, ib, sb); conv_decode(F, ib, cb); conv_load(cb, sb, F.lane, vb); }
        conv_step(F, cc, sc, vc, tc, tile, img0, par);
        tc = tb + nw;
    }
}
__device__ __forceinline__ void phase0a(const Frame& F) {
    LAS float* a_lds = (LAS float*)F.lds;
    LAS float* red = (LAS float*)(F.lds + 32768);
    for (int it = F.vcu; it < 200; it += F.G) {
        if (it < 192) {
            for (int i = F.tid; i < 4 * 2048; i += 512) a_lds[i] = siluf_(F.in[I_C][i]);
            __syncthreads();
            gemv_item<4>(F, a_lds, red, F.in[I_WADA], 6 * D, it * 64, F.in[I_BADA], WSP(float, WS_MOD), 6 * D);
        } else {
            const int kv = (it - 192) >> 2, nb = (it - 192) & 3;
            for (int i = F.tid; i < 2048; i += 512) a_lds[i] = F.in[kv ? I_CPV : I_CPK][i];
            __syncthreads();
            gemv_item<1>(F, a_lds, red, F.in[kv ? I_CW1V : I_CW1K], 256, nb * 64, nullptr, WSP(float, WS_BIAS1) + kv * 256, 256);
        }
    }
    for (int it = F.vcu; it < 128; it += F.G) {
        const int idx = it * 512 + F.tid, pos = idx >> 5, i = idx & 31; float c, s; rope_cs((float)pos, i, c, s);
        WSP(float, WS_ROPE)[idx] = c; WSP(float, WS_ROPE)[65536 + idx] = s;
    }
    __syncthreads();
    if (F.G == 256) {
        constexpr int HEAD = 56 * 8 * 3;
        if (F.vcu >= 200) conv_range(F, 0, HEAD, (F.vcu - 200) * 8 + F.wave, 56 * 8);
        conv_range(F, HEAD, CV_EARLY, F.vcu * 8 + F.wave, F.G * 8);
    }
    else conv_range(F, 0, CV_NT4 - CV_DEFER2, F.vcu * 8 + F.wave, F.G * 8);
}

__device__ __forceinline__ void phase0b(const Frame& F) {
    const int gw = F.vcu * 8 + F.wave, NGW = F.G * 8;
    const float* mod = WSP(float, WS_MOD);
    for (int r0 = gw * 4; r0 < NTOK; r0 += NGW * 4) {
        const int b = r0 >> 11;
        f32x4 ga[8], sh[8];
#pragma unroll
        for (int j = 0; j < 8; ++j) { const int k = 4 * F.lane + 256 * j;
            ga[j] = *(const f32x4*)(F.in[I_GN1] + k) * (*(const f32x4*)(mod + b * 6 * D + D + k) + 1.0f); sh[j] = *(const f32x4*)(mod + b * 6 * D + k); }
#pragma unroll 1
        for (int hf = 0; hf < 2; ++hf) {
            f32x4 v[2][8];
#pragma unroll
            for (int q = 0; q < 2; ++q) { const f32x4* xr = (const f32x4*)(F.in[I_X] + (size_t)(r0 + 2 * hf + q) * D) + F.lane;
#pragma unroll
                for (int j = 0; j < 8; ++j) v[q][j] = xr[64 * j]; }
#pragma unroll
            for (int q = 0; q < 2; ++q) {
                float s = 0.f;
#pragma unroll
                for (int j = 0; j < 8; ++j) s += (v[q][j].x * v[q][j].x + v[q][j].y * v[q][j].y) + (v[q][j].z * v[q][j].z + v[q][j].w * v[q][j].w);
                const float rstd = rsqrtf(wave_sum(s) * (1.f / D) + EPS);
                u32x2* o = (u32x2*)(WSP(bf16_t, WS_H) + (size_t)(r0 + 2 * hf + q) * D) + F.lane;
#pragma unroll
                for (int j = 0; j < 8; ++j) { const f32x4 h = v[q][j] * rstd * ga[j] + sh[j]; u32x2 w; w.x = cvt_pk_bf16(h.x, h.y); w.y = cvt_pk_bf16(h.z, h.w); o[64 * j] = w; }
            }
        }
    }
}

struct InProjP {
    static constexpr int K = 2048, ESZ = 2, LDB = 2048; static constexpr bool IDLDS = false; static constexpr bool HALFONLY = false; static constexpr bool MIDK = false;
    const bf16_t* A; const bf16_t* Bt; int lda; int G, c;
    unsigned char* ws; const float* gq; const float* gk;
    __device__ __forceinline__ bool next(int i, Unit& u) const { return pg8::dense_next(i, G, c, 32, 19, u); }
    __device__ __forceinline__ unsigned row_id(const Unit& u, int r) const { return (unsigned)(u.pm * 256 + r); }
    __device__ __forceinline__ const char* b_base(const Unit& u) const { return (const char*)(Bt + (size_t)u.pn * 256 * K); }
    __device__ __forceinline__ void unit_begin(const Unit&, int) const {}
    __device__ __forceinline__ unsigned a_koff(const Unit&) const { return 0u; }
    __device__ __forceinline__ void midk(Acc&, const Unit&, int, int, int) const {}
    __device__ __forceinline__ void epi(const Acc& acc, const Unit& u, int ui, int wr, int wc, int fr, int fq) const {
        const int pn = u.pn;
        if (pn < 10) {
            const bool donorm = (pn < 4) || pn == 6 || pn == 8;
            const float* g = (pn < 4) ? gq : gk;
            float glo[8], ghi[8];
#pragma unroll
            for (int j = 0; j < 8; ++j) { glo[j] = g[8 * fq + j]; ghi[j] = g[32 + 8 * fq + j]; }
            const float qs = (pn < 4) ? QSCALE : 1.0f;
            const float* cosT = (const float*)(ws + WS_ROPE); const float* sinT = cosT + 65536;
#pragma unroll
            for (int ai = 0; ai < 2; ++ai)
#pragma unroll
                for (int m = 0; m < 4; ++m) {
                    const int row = u.pm * 256 + ai * 128 + wr * 64 + m * 16 + fr, b = row >> 11, t = row & 2047;
                    float lo[8], hi[8];
#pragma unroll
                    for (int n = 0; n < 2; ++n)
#pragma unroll
                        for (int v = 0; v < 4; ++v) { lo[4 * n + v] = acc[ai][0][m][n][v]; hi[4 * n + v] = acc[ai][1][m][n][v]; }
                    if (donorm) {
                        float ss = 0.f;
#pragma unroll
                        for (int j = 0; j < 8; ++j) ss += lo[j] * lo[j] + hi[j] * hi[j];
                        ss += __shfl_xor(ss, 16); ss += __shfl_xor(ss, 32);
                        const float rstd = rsqrtf(ss * (1.f / 64.f) + EPS) * qs;
                        const f32x4 c0 = *(const f32x4*)(cosT + t * 32 + 8 * fq), c1 = *(const f32x4*)(cosT + t * 32 + 8 * fq + 4);
                        const f32x4 s0 = *(const f32x4*)(sinT + t * 32 + 8 * fq), s1 = *(const f32x4*)(sinT + t * 32 + 8 * fq + 4);
#pragma unroll
                        for (int j = 0; j < 8; ++j) {
                            const float cc = j < 4 ? c0[j & 3] : c1[j & 3], sn = j < 4 ? s0[j & 3] : s1[j & 3];
                            const float yl = lo[j] * rstd * glo[j], yh = hi[j] * rstd * ghi[j];
                            lo[j] = yl * cc - yh * sn; hi[j] = yh * cc + yl * sn;
                        }
                    }
                    bf16_t* dst = (pn < 4) ? (bf16_t*)(ws + WS_Q) + ((size_t)((b * 16 + 4 * pn + wc) * 2048 + t)) * 64
                                           : (bf16_t*)(ws + WS_KV + (size_t)(pn - 4) * KV_STRIDE) + ((size_t)((b * 4 + wc) * 2048 + t)) * 64;
                    u32x4 w0, w1;
                    w0.x = cvt_pk_bf16(lo[0], lo[1]); w0.y = cvt_pk_bf16(lo[2], lo[3]); w0.z = cvt_pk_bf16(lo[4], lo[5]); w0.w = cvt_pk_bf16(lo[6], lo[7]);
                    w1.x = cvt_pk_bf16(hi[0], hi[1]); w1.y = cvt_pk_bf16(hi[2], hi[3]); w1.z = cvt_pk_bf16(hi[4], hi[5]); w1.w = cvt_pk_bf16(hi[6], hi[7]);
                    *(u32x4*)(dst + 8 * fq) = w0; *(u32x4*)(dst + 32 + 8 * fq) = w1;
                }
        } else if (pn < 18) {
            const bool isv = pn >= 14; const int tb = isv ? pn - 14 : pn - 10;
            bf16_t* O = (bf16_t*)(ws + (isv ? WS_V : WS_U)); float* vss = (float*)(ws + WS_VSS);
#pragma unroll
            for (int ai = 0; ai < 2; ++ai)
#pragma unroll
                for (int m = 0; m < 4; ++m) {
                    const int row = u.pm * 256 + ai * 128 + wr * 64 + m * 16 + fr;
#pragma unroll
                    for (int bj = 0; bj < 2; ++bj) {
                        float y[8]; float ss = 0.f;
#pragma unroll
                        for (int n = 0; n < 2; ++n)
#pragma unroll
                            for (int v = 0; v < 4; ++v) { const float gl = gelu_tanh(acc[ai][bj][m][n][v]); y[4 * n + v] = gl; ss += gl * gl; }
                        u32x4 w; w.x = cvt_pk_bf16(y[0], y[1]); w.y = cvt_pk_bf16(y[2], y[3]); w.z = cvt_pk_bf16(y[4], y[5]); w.w = cvt_pk_bf16(y[6], y[7]);
                        *(u32x4*)(O + (size_t)row * 1024 + tb * 256 + bj * 128 + wc * 32 + 8 * fq) = w;
                        if (isv) { ss += __shfl_xor(ss, 16); ss += __shfl_xor(ss, 32); if (fq == 0) vss[(size_t)row * 32 + (2 * tb + bj) * 4 + wc] = ss; }
                    }
                }
        } else {
            float* gate = (float*)(ws + WS_GATE);
            const int col = wc * 32 + 8 * fq;
            if (col < 48) {
#pragma unroll
                for (int ai = 0; ai < 2; ++ai)
#pragma unroll
                    for (int m = 0; m < 4; ++m) {
                        const int row = u.pm * 256 + ai * 128 + wr * 64 + m * 16 + fr;
#pragma unroll
                        for (int n = 0; n < 2; ++n) { f32x4 a = acc[ai][0][m][n]; f32x4 o; o.x = sigmoidf_(a.x); o.y = sigmoidf_(a.y); o.z = sigmoidf_(a.z); o.w = sigmoidf_(a.w);
                            *(f32x4*)(gate + (size_t)row * 48 + col + 4 * n) = o; }
                    }
            }
        }
    }
};

struct CmpP {
    static constexpr int K = 512, ESZ = 2, LDB = 2048; static constexpr bool IDLDS = false; static constexpr bool HALFONLY = false; static constexpr bool MIDK = false;
    const bf16_t* A; const bf16_t* Bt; int lda; int G, c;
    unsigned char* ws;
    __device__ __forceinline__ bool next(int i, Unit& u) const { const int L = i * G + c; if (L >= 64) return false; u.e = L >> 5; u.pm = (L >> 2) & 7; u.aux = L & 3; u.pn = 0; return true; }
    __device__ __forceinline__ unsigned row_id(const Unit& u, int r) const { return (unsigned)(u.e * 2048 + u.pm * 256 + r); }
    __device__ __forceinline__ unsigned a_koff(const Unit& u) const { return (unsigned)u.aux * 1024u; }
    __device__ __forceinline__ const char* b_base(const Unit& u) const { return (const char*)(Bt + (size_t)u.e * 256 * 2048 + u.aux * 512); }
    __device__ __forceinline__ void unit_begin(const Unit&, int) const {}
    __device__ __forceinline__ void midk(Acc&, const Unit&, int, int, int) const {}
    __device__ __forceinline__ void epi(const Acc& acc, const Unit& u, int ui, int wr, int wc, int fr, int fq) const {
        float* O = (float*)(ws + WS_PO) + ((size_t)(u.aux * 2 + u.e) * 2048) * 256;
#pragma unroll
        for (int bj = 0; bj < 2; ++bj) {
            const int col = bj * 128 + wc * 32 + 8 * fq;
#pragma unroll
            for (int ai = 0; ai < 2; ++ai)
#pragma unroll
                for (int m = 0; m < 4; ++m) {
                    const int row = u.pm * 256 + ai * 128 + wr * 64 + m * 16 + fr;
                    *(f32x4*)(O + (size_t)row * 256 + col) = acc[ai][bj][m][0]; *(f32x4*)(O + (size_t)row * 256 + col + 4) = acc[ai][bj][m][1];
                }
        }
    }
};

struct OutProjP {
    static constexpr int K = 2048, ESZ = 2, LDB = 2048; static constexpr bool IDLDS = false; static constexpr bool HALFONLY = false; static constexpr bool MIDK = true;
    const bf16_t* A; const bf16_t* Bt; int lda; int G, c;
    unsigned char* ws; const float* x; float* out; LAS f32x2* tab;
    __device__ __forceinline__ bool next(int i, Unit& u) const { return pg8::dense_next(i, G, c, 32, 8, u); }
    __device__ __forceinline__ unsigned row_id(const Unit& u, int r) const { return (unsigned)(u.pm * 256 + r); }
    __device__ __forceinline__ const char* b_base(const Unit& u) const { return (const char*)(Bt + (size_t)u.pn * 256 * K); }
    __device__ __forceinline__ unsigned a_koff(const Unit&) const { return 0u; }
    __device__ __forceinline__ void unit_begin(const Unit& u, int ui) const {
        if (threadIdx.x < 256) {
            const int row = u.pm * 256 + threadIdx.x;
            const f32x4 a = *(const f32x4*)((const float*)(ws + WS_OSSN) + (size_t)row * 4);
            const f32x4* gp = (const f32x4*)((const float*)(ws + WS_OSSG) + (size_t)row * 16);
            const f32x4 g0 = gp[0], g1 = gp[1], g2 = gp[2], g3 = gp[3];
            const float sn = (a.x + a.y) + (a.z + a.w);
            const float sg = ((g0.x + g0.y) + (g0.z + g0.w)) + ((g1.x + g1.y) + (g1.z + g1.w)) + ((g2.x + g2.y) + (g2.z + g2.w)) + ((g3.x + g3.y) + (g3.z + g3.w));
            const float rn = rsqrtf(sn * (1.f / 1024.f) + EPS), rg = rsqrtf(sg * (1.f / 1024.f) + EPS);
            tab[(ui & 1) * 256 + threadIdx.x] = (f32x2){rn / rg, rg};
        }
    }
    __device__ __forceinline__ void midk(Acc& acc, const Unit& u, int ui, int wr, int fr) const {
#pragma unroll
        for (int ai = 0; ai < 2; ++ai)
#pragma unroll
            for (int m = 0; m < 4; ++m) { const float s = tab[(ui & 1) * 256 + ai * 128 + wr * 64 + m * 16 + fr].x;
#pragma unroll
                for (int bj = 0; bj < 2; ++bj)
#pragma unroll
                    for (int n = 0; n < 2; ++n) acc[ai][bj][m][n] *= s; }
    }
    __device__ __forceinline__ void epi(const Acc& acc, const Unit& u, int ui, int wr, int wc, int fr, int fq) const {
        const float* mod = (const float*)(ws + WS_MOD);
#pragma unroll
        for (int ai = 0; ai < 2; ++ai)
#pragma unroll
            for (int m = 0; m < 4; ++m) {
                const int r = ai * 128 + wr * 64 + m * 16 + fr, row = u.pm * 256 + r, b = row >> 11; const float s = tab[(ui & 1) * 256 + r].y;
#pragma unroll
                for (int bj = 0; bj < 2; ++bj) {
                    const int col = u.pn * 256 + bj * 128 + wc * 32 + 8 * fq;
#pragma unroll
                    for (int n = 0; n < 2; ++n) {
                        const f32x4 gt = *(const f32x4*)(mod + b * 6 * D + 2 * D + col + 4 * n), xv = *(const f32x4*)(x + (size_t)row * D + col + 4 * n);
                        *(f32x4*)(out + (size_t)row * D + col + 4 * n) = xv + gt * (acc[ai][bj][m][n] * s);
                    }
                }
            }
    }
};

__device__ __forceinline__ void moe_table(const Frame& F, LAS int* tb) {
    if (F.tid < 64) {
        const unsigned* cnt = (const unsigned*)(F.ws + WS_CTL) + CW_CNT;
        const int c = (int)__hip_atomic_load(cnt + F.tid, __ATOMIC_RELAXED, __HIP_MEMORY_SCOPE_AGENT);
        const int tl = (c + 255) >> 8; int inc = tl;
#pragma unroll
        for (int o = 1; o < 64; o <<= 1) { const int v = __shfl_up(inc, o); if (F.lane >= o) inc += v; }
        tb[F.tid] = inc - tl; tb[128 + F.tid] = c;
        if (F.tid == 63) { tb[64] = inc; tb[65] = inc + (NTOK >> 8); tb[128 + 64] = NTOK; }
    }
    __syncthreads();
    if (F.tid < 384) {
        int lo = 0, hi = 64; while (lo < hi) { const int mid = (lo + hi + 1) >> 1; if (tb[mid] <= F.tid) lo = mid; else hi = mid - 1; }
        tb[256 + F.tid] = lo;
        const int nv = tb[128 + lo] - (F.tid - tb[lo]) * 256;
        tb[640 + F.tid] = (F.tid < tb[65] && lo < 64 && nv <= 128) ? 1 : 0;
    }
    __syncthreads();
    {
        const int TT = tb[65];
        const unsigned long long bm = __ballot(F.tid < 384 && tb[640 + (F.tid < 384 ? F.tid : 0)] != 0);
        if (F.tid < 384 && F.lane == 0) { tb[1500 + 2 * F.wave] = (int)(unsigned)bm; tb[1501 + 2 * F.wave] = (int)(unsigned)(bm >> 32); }
        __syncthreads();
        if (F.tid < 384) {
            int nhb = 0, nh = 0;
#pragma unroll
            for (int w = 0; w < 6; ++w) { const int c = __popc((unsigned)tb[1500 + 2 * w]) + __popc((unsigned)tb[1501 + 2 * w]); nh += c; if (w < F.wave) nhb += c; }
            nhb += __popcll(bm & ((1ull << F.lane) - 1ull));
            const int nf = TT - nh;
            if (F.tid < TT) tb[1024 + (tb[640 + F.tid] ? nf + nhb : F.tid - nhb)] = F.tid;
            if (F.tid == 0) tb[66] = nf;
        }
    }
    __syncthreads();
}

template <bool HALF> struct MoeUpP {
    LAS unsigned* idtab;
    static constexpr int K = 2048, ESZ = 1, LDB = 2048; static constexpr bool IDLDS = true; static constexpr bool HALFONLY = HALF; static constexpr bool MIDK = false;
    const unsigned char* A; const unsigned char* Bt; int lda; int G, c;
    unsigned char* ws; const LAS int* tb; int c0;
    __device__ __forceinline__ bool next(int i, Unit& u) const {
        const int nf = tb[66]; int k;
        if (!HALF) { const int L = i * G + c; if (L >= nf * 4) return false; k = L >> 2; u.pn = L & 3; }
        else { if (c < c0) return false; const int L = i * (G - c0) + (c - c0); if (L >= (tb[65] - nf) * 4) return false; k = nf + (L >> 2); u.pn = L & 3; }
        const int mt = tb[1024 + k]; u.e = tb[256 + mt]; u.pm = mt; u.aux = mt - tb[u.e]; return true; }
    __device__ __forceinline__ unsigned row_id(const Unit& u, int r) const {
        const int base = u.aux * 256; const int nv = tb[128 + u.e] - base; const int rr = r < nv ? r : 0;
        if (u.e == 64) return (unsigned)(base + rr);
        return (unsigned)((const int*)(ws + WS_LIST))[u.e * 8192 + base + rr];
    }
    __device__ __forceinline__ const char* b_base(const Unit& u) const { return (const char*)(Bt + ((size_t)u.e * 1024 + u.pn * 256) * K); }
    __device__ __forceinline__ void ids_prefetch(const Unit& u, int wid, int lane) const {
        if (u.e == 64) return;
        const int r = 64 * (wid & 3) + lane, base = u.aux * 256, nv = tb[128 + u.e] - base, rr = r < nv ? r : 0;
        __builtin_amdgcn_global_load_lds((const unsigned*)((const int*)(ws + WS_LIST) + u.e * 8192 + base + rr), (LAS unsigned*)(idtab + (wid >> 2) * 256 + 64 * (wid & 3)), 4, 0, 0);
    }
    __device__ __forceinline__ unsigned ids_read(const Unit& u, int r) const {
        if (u.e == 64) { const int base = u.aux * 256, nv = tb[128 + u.e] - base; return (unsigned)(base + (r < nv ? r : 0)); }
        return idtab[r];
    }
    __device__ __forceinline__ void unit_begin(const Unit&, int) const {}
    __device__ __forceinline__ unsigned a_koff(const Unit&) const { return 0u; }
    __device__ __forceinline__ void midk(Acc&, const Unit&, int, int, int) const {}
    __device__ __forceinline__ void epi(const Acc& acc, const Unit& u, int ui, int wr, int wc, int fr, int fq) const {
        unsigned char* O = ws + WS_HID; const float ws_ = 1.0f / W8SCALE;
#pragma unroll
        for (int ai = 0; ai < (HALF ? 1 : 2); ++ai)
#pragma unroll
            for (int m = 0; m < 4; ++m) {
                const size_t row = (size_t)u.pm * 256 + ai * 128 + wr * 64 + m * 16 + fr; float y[8];
#pragma unroll
                for (int n = 0; n < 2; ++n)
#pragma unroll
                    for (int v = 0; v < 4; ++v) y[4 * n + v] = siluf_(acc[ai][0][m][n][v] * ws_) * (acc[ai][1][m][n][v] * (ws_ * H8SCALE));
                u32x2 w; w.x = pk4_fp8(y[0], y[1], y[2], y[3]); w.y = pk4_fp8(y[4], y[5], y[6], y[7]);
                *(u32x2*)(O + row * 512 + u.pn * 128 + wc * 32 + 8 * fq) = w;
            }
    }
};
template <bool HALF> struct MoeDownP {
    static constexpr int K = 512, ESZ = 1, LDB = 512; static constexpr bool IDLDS = false; static constexpr bool HALFONLY = HALF; static constexpr bool MIDK = false;
    const unsigned char* A; const unsigned char* Bt; int lda; int G, c;
    unsigned char* ws; const LAS int* tb; int c0;
    __device__ __forceinline__ bool next(int i, Unit& u) const {
        const int nf = tb[66]; int k;
        if (!HALF) { const int L = i * G + c; if (L >= nf * 8) return false; k = L >> 3; u.pn = L & 7; }
        else { if (c < c0) return false; const int L = i * (G - c0) + (c - c0); if (L >= (tb[65] - nf) * 8) return false; k = nf + (L >> 3); u.pn = L & 7; }
        const int mt = tb[1024 + k]; u.e = tb[256 + mt]; u.pm = mt; u.aux = 0; return true; }
    __device__ __forceinline__ unsigned row_id(const Unit& u, int r) const { return (unsigned)(u.pm * 256 + r); }
    __device__ __forceinline__ const char* b_base(const Unit& u) const { return (const char*)(Bt + ((size_t)u.e * 2048 + u.pn * 256) * K); }
    __device__ __forceinline__ void unit_begin(const Unit&, int) const {}
    __device__ __forceinline__ unsigned a_koff(const Unit&) const { return 0u; }
    __device__ __forceinline__ void midk(Acc&, const Unit&, int, int, int) const {}
    __device__ __forceinline__ void epi(const Acc& acc, const Unit& u, int ui, int wr, int wc, int fr, int fq) const {
        unsigned char* O = ws + WS_PO; const float sc_ = PO8SCALE / (W8SCALE * H8SCALE);
#pragma unroll
        for (int ai = 0; ai < (HALF ? 1 : 2); ++ai)
#pragma unroll
            for (int m = 0; m < 4; ++m) {
                const size_t row = (size_t)u.pm * 256 + ai * 128 + wr * 64 + m * 16 + fr;
                const f32x4 a0 = acc[ai][0][m][0] * sc_, a1 = acc[ai][0][m][1] * sc_, b0 = acc[ai][1][m][0] * sc_, b1 = acc[ai][1][m][1] * sc_;
                u32x4 w; w.x = pk4_fp8(a0.x, a0.y, a0.z, a0.w); w.y = pk4_fp8(a1.x, a1.y, a1.z, a1.w); w.z = pk4_fp8(b0.x, b0.y, b0.z, b0.w); w.w = pk4_fp8(b1.x, b1.y, b1.z, b1.w);
                *(u32x4*)(O + row * 2048 + u.pn * 256 + wc * 64 + 16 * fq) = w;
            }
    }
};

__device__ __forceinline__ void gmlp_unit(const Frame& F, int n) {
    const int b = n >> 7, c = (n >> 3) & 15, g = n & 7;
    constexpr int WP = 136, VP = 160;
    LAS bf16_t* Ws = (LAS bf16_t*)F.lds;
    LAS bf16_t* Vs = (LAS bf16_t*)(F.lds + 34816);
    LAS float* rs = (LAS float*)(F.lds + 75776);
    LAS float* stg = (LAS float*)F.lds + F.wave * 2048;
    const int row0 = b * T + c * 128;
    const int tb = F.wave & 3, dh = F.wave >> 2, r32 = F.lane & 31, hi = F.lane >> 5;
    f32x4 vssv = (f32x4){0.f, 0.f, 0.f, 0.f};
    if (F.tid < 128) vssv = *(const f32x4*)(WSP(float, WS_VSS) + (size_t)(row0 + F.tid) * 32 + g * 4);
    const float* wsp = F.in[I_WSP] + (size_t)g * 128 * 128;
    f32x4 wv[8];
#pragma unroll
    for (int q = 0; q < 8; ++q) { const int idx = F.tid + 512 * q; wv[q] = *(const f32x4*)(wsp + (idx >> 5) * 128 + (idx & 31) * 4); }
    const bf16_t* Vg = WSP(bf16_t, WS_V);
    u32x4 vv[4];
#pragma unroll
    for (int q = 0; q < 4; ++q) { const int ch = F.tid + 512 * q; vv[q] = *(const u32x4*)(Vg + (size_t)(row0 + (ch >> 4)) * 1024 + g * 128 + (ch & 15) * 8); }
    const bf16_t* U = WSP(bf16_t, WS_U);
    u32x4 uv[4];
#pragma unroll
    for (int q = 0; q < 4; ++q) uv[q] = *(const u32x4*)(U + (size_t)(row0 + 32 * tb + q * 8 + (F.lane >> 3)) * 1024 + g * 128 + 64 * dh + (F.lane & 7) * 8);
    f32x4 gv0, gv1; { const float* gvp = F.in[I_GGV] + g * 128 + (F.tid & 15) * 8; gv0 = *(const f32x4*)gvp; gv1 = *(const f32x4*)(gvp + 4); }
    __syncthreads();
    if (F.tid < 128) rs[F.tid] = rsqrtf(((vssv.x + vssv.y) + (vssv.z + vssv.w)) * (1.f / 128.f) + EPS);
#pragma unroll
    for (int q = 0; q < 8; ++q) {
        const int idx = F.tid + 512 * q, t = idx >> 5, s4 = (idx & 31) * 4;
        f32x4 w = wv[q];
        if (s4 + 0 > t) w.x = 0.f; if (s4 + 1 > t) w.y = 0.f; if (s4 + 2 > t) w.z = 0.f; if (s4 + 3 > t) w.w = 0.f;
        u32x2 o; o.x = cvt_pk_bf16(w.x, w.y); o.y = cvt_pk_bf16(w.z, w.w);
        *(LAS u32x2*)(Ws + t * WP + s4) = o;
    }
    __syncthreads();
#pragma unroll
    for (int q = 0; q < 4; ++q) {
        const int ch = F.tid + 512 * q, sidx = ch >> 4, dc = ch & 15;
        const float r = rs[sidx];
        u32x4 o;
        o.x = cvt_pk_bf16(bflo(vv[q].x) * r * gv0.x, bfhi(vv[q].x) * r * gv0.y); o.y = cvt_pk_bf16(bflo(vv[q].y) * r * gv0.z, bfhi(vv[q].y) * r * gv0.w);
        o.z = cvt_pk_bf16(bflo(vv[q].z) * r * gv1.x, bfhi(vv[q].z) * r * gv1.y); o.w = cvt_pk_bf16(bflo(vv[q].w) * r * gv1.z, bfhi(vv[q].w) * r * gv1.w);
        *(LAS u32x4*)(Vs + sidx * VP + dc * 8) = o;
    }
    __syncthreads();
    f32x16 acc[2]; acc[0] = (f32x16)(0.f); acc[1] = (f32x16)(0.f);
    {
        const LAS unsigned char* vbase = (const LAS unsigned char*)Vs + (8 * hi + ((F.lane & 15) >> 2)) * (VP * 2) + (64 * dh + 16 * ((F.lane >> 4) & 1) + 4 * (F.lane & 3)) * 2;
        for (int kc = 0; kc < 2 * tb + 2; ++kc) {
            const bf16x8 a = *(const LAS bf16x8*)(Ws + (32 * tb + r32) * WP + 16 * kc + 8 * hi);
#pragma unroll
            for (int db = 0; db < 2; ++db) {
                const v4i16_t lo4 = __builtin_amdgcn_ds_read_tr16_b64_v4i16((LAS v4i16_t*)(vbase + (16 * kc) * (VP * 2) + 64 * db));
                const v4i16_t hi4 = __builtin_amdgcn_ds_read_tr16_b64_v4i16((LAS v4i16_t*)(vbase + (16 * kc + 4) * (VP * 2) + 64 * db));
                const bf16x8 bq = (bf16x8){lo4[0], lo4[1], lo4[2], lo4[3], hi4[0], hi4[1], hi4[2], hi4[3]};
                acc[db] = __builtin_amdgcn_mfma_f32_32x32x16_bf16(a, bq, acc[db], 0, 0, 0);
            }
        }
    }
    __syncthreads();
    {
        const float* bsp = F.in[I_BSP] + g * 128 + 32 * tb + 4 * hi;
        LAS float* sl = stg + (4 * hi) * 64 + r32;
#pragma unroll
        for (int r = 0; r < 16; ++r) { const int rc = (r & 3) + 8 * (r >> 2); const float bias = bsp[rc]; sl[rc * 64] = acc[0][r] + bias; sl[rc * 64 + 32] = acc[1][r] + bias; }
    }
    bf16_t* O = WSP(bf16_t, WS_OCAT); float* ossg = WSP(float, WS_OSSG);
#pragma unroll
    for (int q = 0; q < 4; ++q) {
        const int rl = q * 8 + (F.lane >> 3), ch = F.lane & 7, row = row0 + 32 * tb + rl;
        const f32x4 m0 = *(const LAS f32x4*)(stg + rl * 64 + ch * 8), m1 = *(const LAS f32x4*)(stg + rl * 64 + ch * 8 + 4);
        const float o0 = bflo(uv[q].x) * m0.x, o1 = bfhi(uv[q].x) * m0.y, o2 = bflo(uv[q].y) * m0.z, o3 = bfhi(uv[q].y) * m0.w;
        const float o4 = bflo(uv[q].z) * m1.x, o5 = bfhi(uv[q].z) * m1.y, o6 = bflo(uv[q].w) * m1.z, o7 = bfhi(uv[q].w) * m1.w;
        u32x4 w; w.x = cvt_pk_bf16(o0, o1); w.y = cvt_pk_bf16(o2, o3); w.z = cvt_pk_bf16(o4, o5); w.w = cvt_pk_bf16(o6, o7);
        *(u32x4*)(O + (size_t)row * 2048 + 1024 + g * 128 + 64 * dh + ch * 8) = w;
        float ss = ((o0 * o0 + o1 * o1) + (o2 * o2 + o3 * o3)) + ((o4 * o4 + o5 * o5) + (o6 * o6 + o7 * o7));
        ss += __shfl_xor(ss, 1); ss += __shfl_xor(ss, 2); ss += __shfl_xor(ss, 4);
        if (ch == 0) ossg[(size_t)row * 16 + 2 * g + dh] = ss;
    }
}

__device__ __forceinline__ void phase2b(const Frame& F) {
    const int gw = F.vcu * 8 + F.wave, NGW = F.G * 8;
    LAS float* hs = (LAS float*)F.lds + F.wave * 256;
    for (int it = gw; it < 4096; it += NGW) {
        const int kv = it >> 11, m = it & 2047, n = m & 127;
        bf16_t* dst = WSP(bf16_t, kv ? WS_VCMP : WS_KCMP) + (size_t)m * 64;
        if (n == 127) { dst[F.lane] = 0; continue; }
        {
            f32x4 a = *(const f32x4*)(WSP(float, WS_BIAS1) + kv * 256 + 4 * F.lane);
#pragma unroll
            for (int ks = 0; ks < 4; ++ks) a += *(const f32x4*)(WSP(float, WS_PO) + ((size_t)(ks * 2 + kv) * 2048 + m) * 256 + 4 * F.lane);
            hs[4 * F.lane + 0] = gelu_tanh(a.x); hs[4 * F.lane + 1] = gelu_tanh(a.y); hs[4 * F.lane + 2] = gelu_tanh(a.z); hs[4 * F.lane + 3] = gelu_tanh(a.w);
        }
        const float* w2 = F.in[kv ? I_CW2V : I_CW2K];
        float y0 = 0.f, y1 = 0.f, y2 = 0.f, y3 = 0.f;
#pragma unroll 8
        for (int k = 0; k < 256; k += 4) {
            const f32x4 h4 = *(const LAS f32x4*)(hs + k);
            y0 += h4.x * w2[k * 64 + F.lane]; y1 += h4.y * w2[(k + 1) * 64 + F.lane]; y2 += h4.z * w2[(k + 2) * 64 + F.lane]; y3 += h4.w * w2[(k + 3) * 64 + F.lane];
        }
        float y = (y0 + y1) + (y2 + y3);
        if (kv == 0) {
            const float rstd = rsqrtf(wave_sum(y * y) * (1.f / 64.f) + EPS);
            const float yn = y * rstd * F.in[I_GK][F.lane];
            const float pr = __shfl_xor(yn, 32);
            float c, s; rope_cs(16.0f * (float)n + 15.5f, F.lane & 31, c, s);
            y = (F.lane < 32) ? yn * c - pr * s : yn * c + pr * s;
        }
        dst[F.lane] = (bf16_t)(cvt_pk_bf16(y, 0.f) & 0xffffu);
    }
}

constexpr int AT_KS = 0, AT_VT = 18432, AT_WSF = 43008, AT_MSK = 45056, AT_FS = 45312, AT_SSQ = 47360, AT_IMP = 48384, AT_G = 56832, AT_L = 90624;
constexpr int KSP = 72, VTP = 96, VTB = 64 * VTP * 2;
constexpr float AT_THR = 20.0f;
struct AttnCtx {
    LAS unsigned char* lds; int tid, lane, wave, r32, hi, g, th, tokl;
    bf16x8 qf[4];
};
__device__ __forceinline__ void at_load(const bf16_t* Kb, const bf16_t* Vb, int tile, int tid, u32x4& kr, u32x4& vr) {
    const size_t off = (size_t)(tile * 64 + (tid >> 3)) * 64 + (tid & 7) * 8;
    kr = *(const u32x4*)(Kb + off); vr = *(const u32x4*)(Vb + off);
}
__device__ __forceinline__ void at_store(LAS unsigned char* lds, int buf, int tid, const u32x4& kr, const u32x4& vr) {
    const int key = tid >> 3, ch = tid & 7;
    *(LAS u32x4*)(lds + AT_KS + buf * 9216 + (key * KSP + ch * 8) * 2) = kr;
    *(LAS u32x4*)(lds + AT_VT + buf * VTB + (key * VTP + ch * 8) * 2) = vr;
}
__device__ __forceinline__ void attn_pass(const int MODE, AttnCtx& C, const bf16_t* Kb, const bf16_t* Vb, int i, int j0, int ntiles, unsigned rowmask, bool want_imp, float gatev, f32x16 (&of)[2],
                                          u32x4& kr, u32x4& vr, const bf16_t* Kn, const bf16_t* Vn, int jn) {
    LAS unsigned char* lds = C.lds;
    LAS float* wsf = (LAS float*)(lds + AT_WSF) + C.wave * 64;
    float mref = 0.f, l = 0.f, m0 = 0.f;
    f32x16 o[2]; o[0] = (f32x16)(0.f); o[1] = (f32x16)(0.f);
    const int vlane = (4 * C.hi + ((C.lane & 15) >> 2)) * (VTP * 2) + (16 * ((C.lane >> 4) & 1) + 4 * (C.lane & 3)) * 2;
    at_store(lds, 0, C.tid, kr, vr);
    __syncthreads();
    for (int tt = 0; tt < ntiles; ++tt) {
        const int buf = tt & 1, j = j0 + tt;
        if (tt + 1 < ntiles) at_load(Kb, Vb, j + 1, C.tid, kr, vr); else if (Kn) at_load(Kn, Vn, jn, C.tid, kr, vr);
        bool active = true;
        if (MODE == 1) active = __any((rowmask >> j) & 1u);
        if (active) {
            f32x16 p0, p1;
            const LAS unsigned char* ks = lds + AT_KS + buf * 9216;
            int wlo = 0, whi = 63;
            if (MODE == 0) { const int t = 64 * i + C.tokl; whi = ((t >= 31) ? ((t - 31) >> 4) : -1) - 64 * tt; }
            else {
                if (MODE == 1 && !((rowmask >> j) & 1u)) wlo = 64;
                if (j == i) whi = C.tokl;
                if (MODE == 2 && j == i - 8) wlo = C.tokl + 1;
            }
            bf16x8 kf[8];
#pragma unroll
            for (int d0 = 0; d0 < 4; ++d0) {
                kf[2 * d0] = *(const LAS bf16x8*)(ks + (C.r32 * KSP + 16 * d0 + 8 * C.hi) * 2);
                kf[2 * d0 + 1] = *(const LAS bf16x8*)(ks + ((32 + C.r32) * KSP + 16 * d0 + 8 * C.hi) * 2);
            }
            __builtin_amdgcn_sched_barrier(0);
            const bf16x8 ka0 = kf[0], ka1 = kf[1];
            if (__any(wlo > 0 || whi < 63)) {
                f32x16 c0, c1;
#pragma unroll
                for (int r = 0; r < 16; ++r) { const int kl = (r & 3) + 8 * (r >> 2) + 4 * C.hi; c0[r] = (kl < wlo || kl > whi) ? NEGF : 0.f; c1[r] = (kl + 32 < wlo || kl + 32 > whi) ? NEGF : 0.f; }
                p0 = __builtin_amdgcn_mfma_f32_32x32x16_bf16(ka0, C.qf[0], c0, 0, 0, 0); p1 = __builtin_amdgcn_mfma_f32_32x32x16_bf16(ka1, C.qf[0], c1, 0, 0, 0);
            } else {
                const f32x16 z16 = (f32x16)(0.f);
                p0 = __builtin_amdgcn_mfma_f32_32x32x16_bf16(ka0, C.qf[0], z16, 0, 0, 0); p1 = __builtin_amdgcn_mfma_f32_32x32x16_bf16(ka1, C.qf[0], z16, 0, 0, 0);
            }
#pragma unroll
            for (int d0 = 1; d0 < 4; ++d0) {
                p0 = __builtin_amdgcn_mfma_f32_32x32x16_bf16(kf[2 * d0], C.qf[d0], p0, 0, 0, 0); p1 = __builtin_amdgcn_mfma_f32_32x32x16_bf16(kf[2 * d0 + 1], C.qf[d0], p1, 0, 0, 0);
            }
            const LAS unsigned char* vb = lds + AT_VT + buf * VTB + vlane;
            bf16x8 vf[8];
            __builtin_amdgcn_sched_barrier(0);
#pragma unroll
            for (int c = 0; c < 2; ++c) {
                const int koff = (32 * (c >> 1) + 16 * (c & 1)) * (VTP * 2);
#pragma unroll
                for (int db = 0; db < 2; ++db) {
                    const v4i16_t lo = __builtin_amdgcn_ds_read_tr16_b64_v4i16((LAS v4i16_t*)(vb + koff + 64 * db));
                    const v4i16_t hi4 = __builtin_amdgcn_ds_read_tr16_b64_v4i16((LAS v4i16_t*)(vb + koff + 8 * (VTP * 2) + 64 * db));
                    vf[2 * c + db] = (bf16x8){lo[0], lo[1], lo[2], lo[3], hi4[0], hi4[1], hi4[2], hi4[3]};
                }
            }
            __builtin_amdgcn_sched_barrier(0);
            if (__any(mref != 0.f)) {
#pragma unroll
                for (int r = 0; r < 16; ++r) { p0[r] -= mref; p1[r] -= mref; }
            }
            float mx = fmaxf(p0[0], p1[0]);
#pragma unroll
            for (int r = 1; r < 16; ++r) mx = fmaxf(fmaxf(mx, p0[r]), p1[r]);
            if (__any(mx > AT_THR)) {
                mx = fmaxf(mx, __shfl_xor(mx, 32));
                const float dl = fmaxf(mx, 0.f); mref += dl;
#pragma unroll
                for (int r = 0; r < 16; ++r) { p0[r] -= dl; p1[r] -= dl; }
                const float f = fexp2(-dl); l *= f;
                if (C.hi == 0) wsf[C.r32] = f;
#pragma unroll
                for (int r = 0; r < 16; ++r) { const float ff = wsf[(r & 3) + 8 * (r >> 2) + 4 * C.hi]; o[0][r] *= ff; o[1][r] *= ff; }
            }
            float rsum = 0.f;
#pragma unroll
            for (int r = 0; r < 16; ++r) { p0[r] = fexp2(p0[r]); p1[r] = fexp2(p1[r]); rsum += p0[r] + p1[r]; }
            l += rsum;
            if (MODE == 0) {
                if (tt == 0) m0 = mref;
                if (want_imp) {
                    LAS float* Gs = (LAS float*)(lds + AT_G) + (C.g * 64 + C.tokl) * 33; LAS float* Ls = (LAS float*)(lds + AT_L) + (C.g * 64 + C.tokl) * 33;
#pragma unroll
                    for (int rg = 0; rg < 4; ++rg) {
                        const int ml = 16 * tt + 2 * rg + C.hi;
                        Gs[ml] = (p0[4 * rg] + p0[4 * rg + 1]) + (p0[4 * rg + 2] + p0[4 * rg + 3]); Ls[ml] = p0[4 * rg + 3];
                        Gs[ml + 8] = (p1[4 * rg] + p1[4 * rg + 1]) + (p1[4 * rg + 2] + p1[4 * rg + 3]); Ls[ml + 8] = p1[4 * rg + 3];
                    }
                }
            }
            bf16x8 pa[4];
#pragma unroll
            for (int c = 0; c < 4; ++c) {
                u32x4 w;
                if (c < 2) { w.x = cvt_pk_bf16(p0[8 * c], p0[8 * c + 1]); w.y = cvt_pk_bf16(p0[8 * c + 2], p0[8 * c + 3]); w.z = cvt_pk_bf16(p0[8 * c + 4], p0[8 * c + 5]); w.w = cvt_pk_bf16(p0[8 * c + 6], p0[8 * c + 7]); }
                else { const int cc = c - 2; w.x = cvt_pk_bf16(p1[8 * cc], p1[8 * cc + 1]); w.y = cvt_pk_bf16(p1[8 * cc + 2], p1[8 * cc + 3]); w.z = cvt_pk_bf16(p1[8 * cc + 4], p1[8 * cc + 5]); w.w = cvt_pk_bf16(p1[8 * cc + 6], p1[8 * cc + 7]); }
                pa[c] = __builtin_bit_cast(bf16x8, w);
            }
            __builtin_amdgcn_sched_barrier(0);
#pragma unroll
            for (int c = 2; c < 4; ++c) {
                const int koff = (32 * (c >> 1) + 16 * (c & 1)) * (VTP * 2);
#pragma unroll
                for (int db = 0; db < 2; ++db) {
                    const v4i16_t lo = __builtin_amdgcn_ds_read_tr16_b64_v4i16((LAS v4i16_t*)(vb + koff + 64 * db));
                    const v4i16_t hi4 = __builtin_amdgcn_ds_read_tr16_b64_v4i16((LAS v4i16_t*)(vb + koff + 8 * (VTP * 2) + 64 * db));
                    vf[2 * c + db] = (bf16x8){lo[0], lo[1], lo[2], lo[3], hi4[0], hi4[1], hi4[2], hi4[3]};
                }
            }
            __builtin_amdgcn_sched_barrier(0);
#pragma unroll
            for (int c = 0; c < 4; ++c) {
#pragma unroll
                for (int db = 0; db < 2; ++db) o[db] = __builtin_amdgcn_mfma_f32_32x32x16_bf16(pa[c], vf[2 * c + db], o[db], 0, 0, 0);
            }
        }
        if (tt + 1 < ntiles) at_store(lds, buf ^ 1, C.tid, kr, vr);
        __syncthreads();
    }
    const float lt = l + __shfl_xor(l, 32);
    const float inv = lt > 0.f ? frcp(lt) : 0.f;
    if (MODE == 0 && want_imp && C.hi == 0) {
        LAS float* fs = (LAS float*)(lds + AT_FS) + (C.g * 64 + C.tokl) * 2;
        fs[0] = (ntiles > 1) ? fexp2(m0 - mref) * inv : inv; fs[1] = inv;
    }
    if (C.hi == 0) wsf[C.r32] = inv * gatev;
#pragma unroll
    for (int r = 0; r < 16; ++r) { const float f = wsf[(r & 3) + 8 * (r >> 2) + 4 * C.hi]; of[0][r] += o[0][r] * f; of[1][r] += o[1][r] * f; }
}
__device__ __forceinline__ void attn_unit(const Frame& F, int b, int kvh, int i) {
    AttnCtx C; C.lds = F.lds; C.tid = F.tid; C.lane = F.lane; C.wave = F.wave; C.r32 = F.lane & 31; C.hi = F.lane >> 5; C.g = F.wave >> 1; C.th = F.wave & 1; C.tokl = 32 * C.th + C.r32;
    const int h = 4 * kvh + C.g, t = 64 * i + C.tokl, row = b * T + t;
    const bf16_t* Qp = WSP(bf16_t, WS_Q) + ((size_t)(b * 16 + h) * 2048 + t) * 64;
#pragma unroll
    for (int d0 = 0; d0 < 4; ++d0) C.qf[d0] = *(const bf16x8*)(Qp + 16 * d0 + 8 * C.hi);
    const float* gp = WSP(float, WS_GATE) + (size_t)row * 48 + h * 3;
    const float g0 = gp[0], g1 = gp[1], g2 = gp[2];
    const size_t kvoff = (size_t)(b * 4 + kvh) * 2048 * 64;
    f32x16 of[2]; of[0] = (f32x16)(0.f); of[1] = (f32x16)(0.f);
    const bool want_imp = i >= 16;
    u32x4 kr, vr;
    at_load(WSP(bf16_t, WS_KCMP) + (size_t)(b * 4 + kvh) * 128 * 64, WSP(bf16_t, WS_VCMP) + (size_t)(b * 4 + kvh) * 128 * 64, 0, C.tid, kr, vr);
    __syncthreads();
    LAS unsigned* msk = (LAS unsigned*)(F.lds + AT_MSK);
    unsigned rowmask = 0u;
#pragma unroll 1
    for (int ps = 0; ps < 3; ++ps) {
        const bf16_t* Kb; const bf16_t* Vb; int j0, ntl; float gv;
        if (ps == 0) { Kb = WSP(bf16_t, WS_KCMP) + (size_t)(b * 4 + kvh) * 128 * 64; Vb = WSP(bf16_t, WS_VCMP) + (size_t)(b * 4 + kvh) * 128 * 64; j0 = 0; ntl = want_imp ? 2 : 1; gv = g0; }
        else if (ps == 1) { Kb = WSP(bf16_t, WS_KV + 2 * KV_STRIDE) + kvoff; Vb = WSP(bf16_t, WS_KV + 3 * KV_STRIDE) + kvoff; j0 = 0; ntl = i + 1; gv = g1; }
        else { Kb = WSP(bf16_t, WS_KV + 4 * KV_STRIDE) + kvoff; Vb = WSP(bf16_t, WS_KV + 5 * KV_STRIDE) + kvoff; j0 = i >= 8 ? i - 8 : 0; ntl = i - j0 + 1; gv = g2; }
        const bf16_t* Kn = nullptr; const bf16_t* Vn = nullptr; int jn = 0;
        if (ps == 0) { Kn = WSP(bf16_t, WS_KV + 2 * KV_STRIDE) + kvoff; Vn = WSP(bf16_t, WS_KV + 3 * KV_STRIDE) + kvoff; jn = 0; }
        else if (ps == 1) { Kn = WSP(bf16_t, WS_KV + 4 * KV_STRIDE) + kvoff; Vn = WSP(bf16_t, WS_KV + 5 * KV_STRIDE) + kvoff; jn = i >= 8 ? i - 8 : 0; }
        attn_pass(ps, C, Kb, Vb, i, j0, ntl, rowmask, want_imp, gv, of, kr, vr, Kn, Vn, jn);
        if (ps == 0) {
            if (want_imp) {
                __syncthreads();
                LAS float* Gs = (LAS float*)(F.lds + AT_G); LAS float* Ls = (LAS float*)(F.lds + AT_L); LAS float* fs = (LAS float*)(F.lds + AT_FS); LAS float* imp = (LAS float*)(F.lds + AT_IMP);
#pragma unroll 1
                for (int q = 0; q < 4; ++q) {
                    const int idx = F.tid + 512 * q, tok = idx >> 5, j = idx & 31; float v = 0.f;
#pragma unroll
                    for (int g = 0; g < 4; ++g) {
                        const int base = (g * 64 + tok);
                        v += fs[base * 2 + (j >> 4)] * Gs[base * 33 + j];
                        if (j > 0) v += fs[base * 2 + ((j - 1) >> 4)] * Ls[base * 33 + j - 1];
                    }
                    imp[tok * 33 + j] = v;
                }
                __syncthreads();
                {
                    const int tok = F.tid >> 3, sub = F.tid & 7;
                    const LAS float* im = imp + tok * 33;
                    float cv[4]; int cj[4];
#pragma unroll
                    for (int q = 0; q < 4; ++q) { cj[q] = 1 + sub + 8 * q; cv[q] = (cj[q] <= i - 2) ? im[cj[q]] : -2.f; }
                    unsigned mk = 1u | (1u << i) | (1u << (i - 1));
                    for (int rnd = 0; rnd < 13; ++rnd) {
                        float best = -1.f; int bj = 99;
#pragma unroll
                        for (int q = 0; q < 4; ++q) if (cv[q] > best) { best = cv[q]; bj = cj[q]; }
#pragma unroll
                        for (int o = 1; o < 8; o <<= 1) { const float ov = __shfl_xor(best, o); const int oj = __shfl_xor(bj, o); if (ov > best || (ov == best && oj < bj)) { best = ov; bj = oj; } }
                        mk |= 1u << bj;
#pragma unroll
                        for (int q = 0; q < 4; ++q) if (cj[q] == bj) cv[q] = -2.f;
                    }
                    if (sub == 0) msk[tok] = mk;
                }
            } else {
                if (F.tid < 64) msk[F.tid] = (2u << i) - 1u;
            }
            __syncthreads();
            rowmask = msk[C.tokl];
        }
    }
    bf16_t* O = WSP(bf16_t, WS_OCAT); LAS float* ssq = (LAS float*)(F.lds + AT_SSQ);
    LAS bf16_t* stg = (LAS bf16_t*)(F.lds + AT_G) + C.wave * 2048;
#pragma unroll
    for (int r = 0; r < 16; ++r) {
        const int rl = (r & 3) + 8 * (r >> 2) + 4 * C.hi;
        stg[rl * 64 + C.r32] = (bf16_t)(cvt_pk_bf16(of[0][r], 0.f) & 0xffffu); stg[rl * 64 + 32 + C.r32] = (bf16_t)(cvt_pk_bf16(of[1][r], 0.f) & 0xffffu);
        float ss = of[0][r] * of[0][r] + of[1][r] * of[1][r];
        ss += __shfl_xor(ss, 1); ss += __shfl_xor(ss, 2); ss += __shfl_xor(ss, 4); ss += __shfl_xor(ss, 8); ss += __shfl_xor(ss, 16);
        if (C.r32 == 0) ssq[C.g * 64 + 32 * C.th + rl] = ss;
    }
    {
        bf16_t* ob = O + (size_t)(b * T + 64 * i + 32 * C.th + (C.lane >> 3)) * 2048 + h * 64 + (C.lane & 7) * 8;
#pragma unroll
        for (int q = 0; q < 4; ++q) { const u32x4 v = *(const LAS u32x4*)(stg + (q * 8 + (C.lane >> 3)) * 64 + (C.lane & 7) * 8); *(u32x4*)(ob + (size_t)q * 8 * 2048) = v; }
    }
    __syncthreads();
    if (F.tid < 64) WSP(float, WS_OSSN)[(size_t)(b * T + 64 * i + F.tid) * 4 + kvh] = (ssq[F.tid] + ssq[64 + F.tid]) + (ssq[128 + F.tid] + ssq[192 + F.tid]);
}

__device__ __forceinline__ void split_bf16(const float (&v)[8], bf16x8& hi, bf16x8& lo) {
    u32x4 h, l;
    unsigned* hp = (unsigned*)&h; unsigned* lp = (unsigned*)&l;
#pragma unroll
    for (int e = 0; e < 4; ++e) {
        const unsigned pk = cvt_pk_bf16(v[2 * e], v[2 * e + 1]); hp[e] = pk;
        lp[e] = cvt_pk_bf16(v[2 * e] - bflo(pk), v[2 * e + 1] - bfhi(pk));
    }
    hi = __builtin_bit_cast(bf16x8, h); lo = __builtin_bit_cast(bf16x8, l);
}
__device__ __forceinline__ void router_unit(const Frame& F, int un) {
    LAS float* rstd_s = (LAS float*)F.lds;
    LAS float* part = (LAS float*)(F.lds + 1024);
    LAS float* sc_s = (LAS float*)(F.lds + 1024 + 65536);
    LAS float* sb_s = sc_s + 32 * 65;
    LAS int* lcnt = (LAS int*)(sb_s + 32 * 65);
    LAS int* lbase = lcnt + 64;
    const int row0 = un * 32, b = row0 >> 11;
    const float* x1 = F.out; const float* mod = WSP(float, WS_MOD) + b * 6 * D;
    __syncthreads();
    if (F.tid < 64) lcnt[F.tid] = 0;
    {
        f32x4 xv[4][8];
#pragma unroll
        for (int q = 0; q < 4; ++q) { const f32x4* xr = (const f32x4*)(x1 + (size_t)(row0 + F.wave * 4 + q) * D) + F.lane;
#pragma unroll
            for (int j = 0; j < 8; ++j) xv[q][j] = xr[64 * j]; }
#pragma unroll
        for (int q = 0; q < 4; ++q) { float s = 0.f;
#pragma unroll
            for (int j = 0; j < 8; ++j) { const f32x4 v = xv[q][j]; s += (v.x * v.x + v.y * v.y) + (v.z * v.z + v.w * v.w); }
            s = wave_sum(s); if (F.lane == 0) rstd_s[F.wave * 4 + q] = rsqrtf(s * (1.f / D) + EPS); }
    }
    __syncthreads();
    const int r32 = F.lane & 31, hi = F.lane >> 5;
    const float rs = rstd_s[r32];
    f32x16 acc[2]; acc[0] = (f32x16)(0.f); acc[1] = (f32x16)(0.f);
    const float* wr_ = F.in[I_WR];
#pragma unroll 4
    for (int kc = 0; kc < 16; ++kc) {
        const int kk = F.wave * 256 + kc * 16 + 8 * hi;
        float hv[8];
        {
            const f32x4 xa = *(const f32x4*)(x1 + (size_t)(row0 + r32) * D + kk), xb = *(const f32x4*)(x1 + (size_t)(row0 + r32) * D + kk + 4);
            const f32x4 ga = *(const f32x4*)(F.in[I_GN2] + kk), gb = *(const f32x4*)(F.in[I_GN2] + kk + 4);
            const f32x4 sa = *(const f32x4*)(mod + 4 * D + kk), sb2 = *(const f32x4*)(mod + 4 * D + kk + 4);
            const f32x4 ha = *(const f32x4*)(mod + 3 * D + kk), hb = *(const f32x4*)(mod + 3 * D + kk + 4);
            const f32x4 ra = xa * rs * ga * (sa + 1.0f) + ha, rb = xb * rs * gb * (sb2 + 1.0f) + hb;
            hv[0] = ra.x; hv[1] = ra.y; hv[2] = ra.z; hv[3] = ra.w; hv[4] = rb.x; hv[5] = rb.y; hv[6] = rb.z; hv[7] = rb.w;
        }
        bf16x8 ah, al; split_bf16(hv, ah, al);
        { u32x2 h8; h8.x = pk4_fp8(hv[0], hv[1], hv[2], hv[3]); h8.y = pk4_fp8(hv[4], hv[5], hv[6], hv[7]); *(u32x2*)(WSP(unsigned char, WS_H) + (size_t)(row0 + r32) * D + kk) = h8; }
#pragma unroll
        for (int nb = 0; nb < 2; ++nb) {
            float wv[8];
#pragma unroll
            for (int j = 0; j < 8; ++j) wv[j] = wr_[(size_t)(kk + j) * 64 + 32 * nb + r32];
            bf16x8 bh, bl; split_bf16(wv, bh, bl);
            acc[nb] = __builtin_amdgcn_mfma_f32_32x32x16_bf16(ah, bh, acc[nb], 0, 0, 0);
            acc[nb] = __builtin_amdgcn_mfma_f32_32x32x16_bf16(ah, bl, acc[nb], 0, 0, 0);
            acc[nb] = __builtin_amdgcn_mfma_f32_32x32x16_bf16(al, bh, acc[nb], 0, 0, 0);
        }
    }
#pragma unroll
    for (int nb = 0; nb < 2; ++nb)
#pragma unroll
        for (int r = 0; r < 16; ++r) part[(F.wave * 32 + (r & 3) + 8 * (r >> 2) + 4 * hi) * 64 + 32 * nb + r32] = acc[nb][r];
    __syncthreads();
    int eid[8]; int lp[8]; float wk[8];
    const int tok = F.tid >> 4, sub = F.tid & 15;
    {
        const int e4 = sub * 4; f32x4 sacc = (f32x4){0.f, 0.f, 0.f, 0.f};
#pragma unroll
        for (int w = 0; w < 8; ++w) sacc += *(const LAS f32x4*)(part + (w * 32 + tok) * 64 + e4);
        const f32x4 rb = *(const f32x4*)(F.in[I_RB] + e4);
        float s4[4], sb4[4];
#pragma unroll
        for (int v = 0; v < 4; ++v) { s4[v] = 1.0f / (1.0f + expf(-sacc[v])); sb4[v] = s4[v] + rb[v]; }
        float a1 = -3.0e38f, a2 = -3.0e38f;
#pragma unroll
        for (int v = 0; v < 4; ++v) { if (sb4[v] > a1) { a2 = a1; a1 = sb4[v]; } else if (sb4[v] > a2) a2 = sb4[v]; }
        const float b1 = __shfl_xor(a1, 1), b2 = __shfl_xor(a2, 1);
        const float gs = fmaxf(a1, b1) + fmaxf(fminf(a1, b1), fmaxf(a2, b2));
        int rank = 0; const int g = sub >> 1;
#pragma unroll
        for (int gg = 0; gg < 8; ++gg) { const float v = __shfl(gs, (F.lane & ~15) | (2 * gg)); rank += (v > gs || (v == gs && gg < g)) ? 1 : 0; }
        const bool gsel = rank < 4;
        float cv[4];
#pragma unroll
        for (int v = 0; v < 4; ++v) cv[v] = gsel ? sb4[v] : -3.0e38f;
        float wsum = 0.f;
#pragma unroll 1
        for (int k = 0; k < 8; ++k) {
            float best = -3.9e38f; int be = 99; float bs = 0.f;
#pragma unroll
            for (int v = 0; v < 4; ++v) if (cv[v] > best) { best = cv[v]; be = e4 + v; bs = s4[v]; }
#pragma unroll
            for (int o = 1; o < 16; o <<= 1) { const float ov = __shfl_xor(best, o); const int oe = __shfl_xor(be, o); const float os = __shfl_xor(bs, o);
                if (ov > best || (ov == best && oe < be)) { best = ov; be = oe; bs = os; } }
#pragma unroll
            for (int v = 0; v < 4; ++v) if (e4 + v == be) cv[v] = -3.9e38f;
#pragma unroll
            for (int kk = 0; kk < 8; ++kk) if (kk == k) { eid[kk] = be; wk[kk] = bs; }
            wsum += bs;
        }
        const float sc = 2.5f / wsum;
        if (sub == 0) {
#pragma unroll
            for (int k = 0; k < 8; ++k) { wk[k] *= sc; lp[k] = atomicAdd((int*)(lcnt + eid[k]), 1); }
        }
    }
    __syncthreads();
    if (F.tid < 64) { const int c = lcnt[F.tid]; lbase[F.tid] = c ? (int)atomicAdd((unsigned*)(F.ws + WS_CTL) + CW_CNT + F.tid, (unsigned)c) : 0; }
    __syncthreads();
    if (sub == 0) {
        const int row = row0 + tok;
#pragma unroll
        for (int k = 0; k < 8; ++k) { const int pos = lbase[eid[k]] + lp[k];
            WSP(int, WS_EIDX)[row * 8 + k] = eid[k]; WSP(int, WS_POS)[row * 8 + k] = pos; WSP(float, WS_WTS)[row * 8 + k] = wk[k];
            WSP(int, WS_LIST)[eid[k] * 8192 + pos] = row; }
    }
}

__device__ __forceinline__ void phase8(const Frame& F, const LAS int* tb) {
    const int gw = F.vcu * 8 + F.wave, NGW = F.G * 8;
    const unsigned char* PO = WSP(unsigned char, WS_PO);
    for (int row = gw; row < NTOK; row += NGW) {
        const int b = row >> 11;
        size_t pr[9]; float w[9];
#pragma unroll
        for (int k = 0; k < 8; ++k) { const int e = WSP(int, WS_EIDX)[row * 8 + k], pos = WSP(int, WS_POS)[row * 8 + k]; w[k] = WSP(float, WS_WTS)[row * 8 + k] * (1.0f / PO8SCALE); pr[k] = ((size_t)tb[e] * 256 + pos) * 2048; }
        pr[8] = ((size_t)tb[64] * 256 + row) * 2048; w[8] = 1.0f / PO8SCALE;
        const float* gt2 = WSP(float, WS_MOD) + b * 6 * D + 5 * D;
#pragma unroll
        for (int j = 0; j < 2; ++j) {
            const int col = 16 * F.lane + 1024 * j; float a[16];
#pragma unroll
            for (int e = 0; e < 16; ++e) a[e] = 0.f;
#pragma unroll
            for (int k = 0; k < 9; ++k) {
                const u32x4 v = *(const u32x4*)(PO + pr[k] + col);
                const unsigned vv[4] = {v.x, v.y, v.z, v.w};
#pragma unroll
                for (int q = 0; q < 4; ++q) {
                    const f32x2 lo = __builtin_amdgcn_cvt_pk_f32_fp8((int)vv[q], false), hi = __builtin_amdgcn_cvt_pk_f32_fp8((int)vv[q], true);
                    a[4 * q] += w[k] * lo.x; a[4 * q + 1] += w[k] * lo.y; a[4 * q + 2] += w[k] * hi.x; a[4 * q + 3] += w[k] * hi.y;
                }
            }
            float* op = F.out + (size_t)row * D + col;
#pragma unroll
            for (int q = 0; q < 4; ++q) {
                const f32x4 x0 = *(const f32x4*)(op + 4 * q), g0 = *(const f32x4*)(gt2 + col + 4 * q);
                *(f32x4*)(op + 4 * q) = x0 + g0 * (f32x4){a[4 * q], a[4 * q + 1], a[4 * q + 2], a[4 * q + 3]};
            }
        }
    }
}

constexpr int N_PHASES = 11;
__global__ void __launch_bounds__(512, 2) mk_fwd(Params p) {
    extern __shared__ __attribute__((aligned(16))) unsigned char lds_raw[];
    Frame F;
    F.lds = (LAS unsigned char*)lds_raw; F.ws = p.ws; F.in = p.in; F.out = p.out;
    F.tid = threadIdx.x; F.lane = F.tid & 63; F.wave = __builtin_amdgcn_readfirstlane(F.tid >> 6);
    F.G = gridDim.x; { const int bx = blockIdx.x; F.vcu = (F.G % 8 == 0) ? (bx % 8) * (F.G / 8) + bx / 8 : bx; }
    volatile LAS unsigned* MISC = (volatile LAS unsigned*)(F.lds + MISC_OFF);
    if (F.tid < 64) MISC[F.tid] = 0u;
    __syncthreads();
    const int lo = p.ph_lo, hi = p.ph_hi;
    const bool multi = (hi - lo) > 1;
    XcdBarrier bar; bar.bar = (unsigned*)(p.ws + WS_CTL) + CW_BAR; bar.x = 0; bar.st = nullptr;
    if (multi) bar = xcd_barrier_post((unsigned*)(p.ws + WS_CTL) + CW_BAR, MISC + 8);
#ifndef PH_MASK
#define PH_MASK 0xffff
#endif
#define IN(k) (((PH_MASK >> (k)) & 1) && lo <= (k) && (k) < hi)
#define SEAM(k) do { if (IN(k) && IN((k) + 1)) xcd_barrier(bar); } while (0)
#define REP(k) for (int rep_ = 0; rep_ < ((((PROBE_MASK) >> (k)) & 1) ? 2 : 1); ++rep_)
    LAS int* mtab = (LAS int*)(F.lds + LDSX_OFF + 4096);

    if (IN(0)) REP(0) { phase0a(F); SEAM(0); }
    if (IN(1)) REP(1) { phase0b(F); SEAM(1); }
    if (IN(2)) REP(2) {
        const bool split = (F.G == 256);
        if (!split || (int)blockIdx.x < NG_INPROJ) {
            InProjP P; P.A = WSP(bf16_t, WS_H); P.Bt = WSP(bf16_t, WS_WIN_T); P.lda = D; P.G = split ? NG_INPROJ : F.G; P.c = blockIdx.x; P.ws = p.ws; P.gq = p.in[I_GQ]; P.gk = p.in[I_GK];
            pg8::gemm_phase(F.lds, P);
        } else conv_range3(F, CV_EARLY, CV_NT4 - CV_DEFER2, ((int)blockIdx.x - NG_INPROJ) * 8 + F.wave, (256 - NG_INPROJ) * 8);
        SEAM(2);
    }
    if (IN(3) && DUP(3)) {
        {
            CmpP P; P.A = WSP(bf16_t, WS_KV); P.Bt = WSP(bf16_t, WS_WCMP_T); P.lda = 1024; P.G = F.G; P.c = F.vcu; P.ws = p.ws;
            pg8::gemm_phase(F.lds, P);
        }
        if (F.G >= 128) {
            if (F.vcu < 64) gmlp_unit(F, F.vcu);
            else { for (int n = 64 + (F.vcu - 64); n < 512; n += F.G - 64) gmlp_unit(F, n);
                   __syncthreads(); conv_range(F, CV_NT4 - CV_DEFER - CV_DEFER2, CV_NT4 - CV_DEFER, (F.vcu - 64) * 8 + F.wave, (F.G - 64) * 8); }
        } else { for (int n = F.vcu; n < 512; n += F.G) gmlp_unit(F, n); __syncthreads(); conv_range(F, CV_NT4 - CV_DEFER - CV_DEFER2, CV_NT4 - CV_DEFER, F.vcu * 8 + F.wave, F.G * 8); }
        SEAM(3);
    }
    if (IN(3)) {
        {
            CmpP P; P.A = WSP(bf16_t, WS_KV); P.Bt = WSP(bf16_t, WS_WCMP_T); P.lda = 1024; P.G = F.G; P.c = F.vcu; P.ws = p.ws;
            pg8::gemm_phase(F.lds, P);
        }
        if (F.G >= 128) {
            if (F.vcu < 64) gmlp_unit(F, F.vcu);
            else { for (int n = 64 + (F.vcu - 64); n < 512; n += F.G - 64) gmlp_unit(F, n);
                   __syncthreads(); conv_range(F, CV_NT4 - CV_DEFER - CV_DEFER2, CV_NT4 - CV_DEFER, (F.vcu - 64) * 8 + F.wave, (F.G - 64) * 8); }
        } else { for (int n = F.vcu; n < 512; n += F.G) gmlp_unit(F, n); __syncthreads(); conv_range(F, CV_NT4 - CV_DEFER - CV_DEFER2, CV_NT4 - CV_DEFER, F.vcu * 8 + F.wave, F.G * 8); }
        SEAM(3);
    }
    if (IN(4)) REP(4) { phase2b(F); SEAM(4); }
    if (IN(5)) REP(5) {
        for (int n = F.vcu; n < 512; n += F.G) {
            int combo, i; if (n < 256) { combo = n >> 4; i = 31 - (n & 15); } else { combo = (n - 256) >> 4; i = n & 15; }
            attn_unit(F, combo >> 2, combo & 3, i);
        }
        SEAM(5);
    }
    if (IN(6) && DUP(6)) {
        OutProjP P; P.A = WSP(bf16_t, WS_OCAT); P.Bt = WSP(bf16_t, WS_WOUT_T); P.lda = D; P.G = F.G; P.c = blockIdx.x; P.ws = p.ws; P.x = p.in[I_X]; P.out = p.out; P.tab = (LAS f32x2*)(F.lds + LDSX_OFF);
        pg8::gemm_phase(F.lds, P); SEAM(6);
    }
    if (IN(6)) {
        OutProjP P; P.A = WSP(bf16_t, WS_OCAT); P.Bt = WSP(bf16_t, WS_WOUT_T); P.lda = D; P.G = F.G; P.c = blockIdx.x; P.ws = p.ws; P.x = p.in[I_X]; P.out = p.out; P.tab = (LAS f32x2*)(F.lds + LDSX_OFF);
        pg8::gemm_phase(F.lds, P); SEAM(6);
    }
    if (IN(7)) { for (int un = F.vcu; un < 256; un += F.G) router_unit(F, un); SEAM(7); }
    if (IN(8)) REP(8) {
        moe_table(F, mtab);
        { MoeUpP<false> P; P.A = WSP(unsigned char, WS_H); P.Bt = WSP(unsigned char, WS_WGU_T); P.lda = D; P.G = F.G; P.c = F.vcu; P.ws = p.ws; P.tb = mtab; P.c0 = 0; P.idtab = (LAS unsigned*)(F.lds + LDSX_OFF + 10240);
          pg8::gemm_phase(F.lds, P); }
        { MoeUpP<true> P; P.A = WSP(unsigned char, WS_H); P.Bt = WSP(unsigned char, WS_WGU_T); P.lda = D; P.G = F.G; P.c = F.vcu; P.ws = p.ws; P.tb = mtab; P.c0 = (mtab[66] * 4) % F.G; P.idtab = (LAS unsigned*)(F.lds + LDSX_OFF + 10240);
          pg8::gemm_phase(F.lds, P); }
        SEAM(8);
    }
    if (IN(9) && DUP(9)) {
        moe_table(F, mtab);
        { MoeDownP<false> P; P.A = WSP(unsigned char, WS_HID); P.Bt = WSP(unsigned char, WS_WD_T); P.lda = EDIM; P.G = F.G; P.c = F.vcu; P.ws = p.ws; P.tb = mtab; P.c0 = 0;
          pg8::gemm_phase(F.lds, P); }
        { MoeDownP<true> P; P.A = WSP(unsigned char, WS_HID); P.Bt = WSP(unsigned char, WS_WD_T); P.lda = EDIM; P.G = F.G; P.c = F.vcu; P.ws = p.ws; P.tb = mtab; P.c0 = (mtab[66] * 8) % F.G;
          pg8::gemm_phase(F.lds, P); } SEAM(9);
    }
    if (IN(9)) {
        moe_table(F, mtab);
        { MoeDownP<false> P; P.A = WSP(unsigned char, WS_HID); P.Bt = WSP(unsigned char, WS_WD_T); P.lda = EDIM; P.G = F.G; P.c = F.vcu; P.ws = p.ws; P.tb = mtab; P.c0 = 0;
          pg8::gemm_phase(F.lds, P); }
        { MoeDownP<true> P; P.A = WSP(unsigned char, WS_HID); P.Bt = WSP(unsigned char, WS_WD_T); P.lda = EDIM; P.G = F.G; P.c = F.vcu; P.ws = p.ws; P.tb = mtab; P.c0 = (mtab[66] * 8) % F.G;
          pg8::gemm_phase(F.lds, P); } SEAM(9);
    }
    if (IN(10)) { moe_table(F, mtab); phase8(F, mtab); }
#undef IN
#undef SEAM
}

extern "C" void kernel_launch(void* const* d_in, const int* in_sizes, int n_in, void* d_out, int out_size, void* d_ws, size_t ws_size, hipStream_t stream) {
    static int grid = 0;
    if (grid == 0) {
        if (n_in != 29 || out_size != NTOK * D || ws_size < WS_END) { fprintf(stderr, "kernel_launch: unexpected shapes (n_in %d out %d ws %zu)\n", n_in, out_size, ws_size); grid = -1; return; }
        int dev = 0, cus = 0, per_cu = 0;
        hipGetDevice(&dev); hipDeviceGetAttribute(&cus, hipDeviceAttributeMultiprocessorCount, dev);
        if (hipFuncSetAttribute((const void*)mk_fwd, hipFuncAttributeMaxDynamicSharedMemorySize, LDS_BYTES) != hipSuccess) { fprintf(stderr, "kernel_launch: hipFuncSetAttribute failed\n"); grid = -1; return; }
        if (hipOccupancyMaxActiveBlocksPerMultiprocessor(&per_cu, (const void*)mk_fwd, 512, LDS_BYTES) != hipSuccess || per_cu < 1) { fprintf(stderr, "kernel_launch: occupancy query says %d\n", per_cu); per_cu = 1; }
        (void)hipGetLastError();
        grid = cus;
    }
    if (grid < 0) return;
    hipMemsetAsync((char*)d_ws + WS_CTL, 0, CTL_BYTES, stream);
    Params p{};
    for (int i = 0; i < 29; ++i) p.in[i] = (const float*)d_in[i];
    p.out = (float*)d_out; p.ws = (unsigned char*)d_ws;
#if MK_N_LAUNCHES == 1
    p.ph_lo = 0; p.ph_hi = N_PHASES;
    void* args[] = {&p};
    hipError_t e = hipLaunchCooperativeKernel((const void*)mk_fwd, dim3(grid), dim3(512), args, LDS_BYTES, stream);
    if (e != hipSuccess) fprintf(stderr, "kernel_launch: cooperative launch failed: %s (grid %d)\n", hipGetErrorString(e), grid);
#else
    for (int ph = 0; ph < N_PHASES; ++ph) { p.ph_lo = ph; p.ph_hi = ph + 1; hipLaunchKernelGGL(mk_fwd, dim3(grid), dim3(512), LDS_BYTES, stream, p); }
#endif
}
```

```cpp
#include <hip/hip_runtime.h>
#include <hip/hip_cooperative_groups.h>
#include <cstdio>
#include <cstdint>
namespace cg = cooperative_groups;

#ifndef MK_N_LAUNCHES
#define MK_N_LAUNCHES 1
#endif

#ifndef PROBE_MASK
#define PROBE_MASK 0
#endif
#define DUP(k) ((((PROBE_MASK) >> (k)) & 1) != 0)
#define LAS __attribute__((address_space(3)))
#define GAS __attribute__((address_space(1)))
typedef unsigned short bf16_t;
typedef short bf16x8 __attribute__((ext_vector_type(8)));
typedef short s16x4 __attribute__((ext_vector_type(4)));
typedef float f32x4 __attribute__((ext_vector_type(4)));
typedef float f32x2 __attribute__((ext_vector_type(2)));
typedef float f32x16 __attribute__((ext_vector_type(16)));
typedef unsigned u32x4 __attribute__((ext_vector_type(4)));
typedef unsigned u32x2 __attribute__((ext_vector_type(2)));
typedef short v4i16_t __attribute__((ext_vector_type(4)));
typedef int v4i32 __attribute__((ext_vector_type(4)));
typedef int v8i32 __attribute__((ext_vector_type(8)));

constexpr int NB = 4, T = 2048, D = 2048, NTOK = NB * T;
constexpr int NH = 16, KVH = 4, HD = 64;
constexpr int NCMP = 127;
constexpr int NEXP = 64, TOPK = 8, EDIM = 512;
constexpr int IN_COLS = 4656, NIN_T = 19 * 256;
constexpr float EPS = 1e-6f;
constexpr float QSCALE = 0.125f * 1.4426950408889634f;
constexpr float NEGF = -1e30f;
constexpr float W8SCALE = 32.0f, H8SCALE = 4.0f, PO8SCALE = 16.0f;

constexpr size_t MiB = 1u << 20, KiB = 1024;
constexpr size_t WS_CTL = 0, CTL_BYTES = 1 * MiB;
constexpr size_t WS_MOD = 1 * MiB;
constexpr size_t WS_ROPE = 1 * MiB + 256 * KiB;
constexpr size_t WS_BIAS1 = 1 * MiB + 768 * KiB;
constexpr size_t WS_KCMP = 2 * MiB;
constexpr size_t WS_VCMP = 2 * MiB + 256 * KiB;
constexpr size_t WS_OSSN = 2 * MiB + 512 * KiB;
constexpr size_t WS_OSSG = 2 * MiB + 768 * KiB;
constexpr size_t WS_VSS = 3 * MiB + 512 * KiB;
constexpr size_t WS_EIDX = 5 * MiB;
constexpr size_t WS_POS = 5 * MiB + 256 * KiB;
constexpr size_t WS_WTS = 5 * MiB + 512 * KiB;
constexpr size_t WS_LIST = 6 * MiB;
constexpr size_t WS_GATE = 8 * MiB;
constexpr size_t WS_HIDC = 10 * MiB;
constexpr size_t WS_KV = 12 * MiB;
constexpr size_t KV_STRIDE = 4 * MiB;
constexpr size_t WS_Q = 36 * MiB;
constexpr size_t WS_U = 52 * MiB;
constexpr size_t WS_V = 68 * MiB;
constexpr size_t WS_H = 84 * MiB;
constexpr size_t WS_OCAT = 116 * MiB;
constexpr size_t WS_WIN_T = 148 * MiB;
constexpr size_t WS_WOUT_T = 168 * MiB;
constexpr size_t WS_WCMP_T = 176 * MiB;
constexpr size_t WS_WGU_T = 178 * MiB;
constexpr size_t WS_WD_T = 438 * MiB;
constexpr size_t WS_HID = 568 * MiB;
constexpr size_t WS_PO = 656 * MiB;
constexpr size_t WS_END = 1008 * MiB;
constexpr int CW_CNT = 256;
constexpr int CW_BAR = 4096;

constexpr int RING_BYTES = 131072;
constexpr int LDSX_OFF = RING_BYTES;
constexpr int MISC_OFF = RING_BYTES + 12288;
constexpr int LDS_BYTES = 147456;

__device__ __forceinline__ unsigned cvt_pk_bf16(float lo, float hi) { unsigned r; asm volatile("v_cvt_pk_bf16_f32 %0, %1, %2" : "=v"(r) : "v"(lo), "v"(hi)); return r; }
__device__ __forceinline__ unsigned pk4_fp8(float a, float b, float c, float d) { int w = 0; w = __builtin_amdgcn_cvt_pk_fp8_f32(a, b, w, false); w = __builtin_amdgcn_cvt_pk_fp8_f32(c, d, w, true); return (unsigned)w; }
__device__ __forceinline__ float bf2f(unsigned short h) { return __uint_as_float(((unsigned)h) << 16); }
__device__ __forceinline__ float bflo(unsigned w) { return __uint_as_float(w << 16); }
__device__ __forceinline__ float bfhi(unsigned w) { return __uint_as_float(w & 0xffff0000u); }
__device__ __forceinline__ float fexp2(float x) { return __builtin_amdgcn_exp2f(x); }
__device__ __forceinline__ float frcp(float x) { return __builtin_amdgcn_rcpf(x); }
__device__ __forceinline__ float sigmoidf_(float x) { return frcp(1.0f + fexp2(-1.4426950408889634f * x)); }
__device__ __forceinline__ float siluf_(float x) { return x * sigmoidf_(x); }
__device__ __forceinline__ float gelu_tanh(float x) {
    const float u = x * (1.0f + 0.044715f * x * x);
    return x * frcp(1.0f + fexp2(u * (-2.0f * 0.7978845608028654f * 1.4426950408889634f)));
}
__device__ __forceinline__ float wave_sum(float v) {
#pragma unroll
    for (int o = 1; o < 64; o <<= 1) v += __shfl_xor(v, o);
    return v;
}
__device__ __forceinline__ void rope_cs(float pos, int i, float& c, float& s) {
    const float fr = exp2f(-(float)i * (13.287712379549449f / 32.0f));
    const float ang = pos * fr;
    const double rev = (double)ang * 0.15915494309189535;
    const double fr_ = rev - rint(rev);
    const float r = (float)(fr_ * 6.283185307179586);
    c = cosf(r); s = sinf(r);
}

#define XB_TMO      128
#define XB_XCNT(j)  (256  + 64 * (j))
#define XB_XSUB(j)  (1280 + 64 * (j))
#define XB_XGEN(j)  (2304 + 64 * (j))
#define XB_TOP      3328
#define XB_TOPGEN   3392
#define XCD_BAR_WORDS 3456
#define XB_SPIN_CAP (1u << 22)
__device__ __forceinline__ unsigned xb_ld(unsigned* p)              { return __hip_atomic_load(p, __ATOMIC_RELAXED, __HIP_MEMORY_SCOPE_AGENT); }
__device__ __forceinline__ unsigned xb_add(unsigned* p, unsigned v) { return __hip_atomic_fetch_add(p, v, __ATOMIC_RELAXED, __HIP_MEMORY_SCOPE_AGENT); }
__device__ __forceinline__ unsigned xb_xcc_id() { return (unsigned)__builtin_amdgcn_s_getreg((3 << 11) | 20) & 0xFu; }
#define XB_SPIN(cond, bar) do { unsigned _sp = 0; while (cond) { __builtin_amdgcn_s_sleep(1); \
    if ((++_sp & 255u) == 0u) { if (xb_ld(&(bar)[XB_TMO])) break; if (_sp > XB_SPIN_CAP) { atomicAdd(&(bar)[XB_TMO], 1u); break; } } } } while (0)
struct XcdBarrier { unsigned* bar; unsigned x; volatile LAS unsigned* st; };
__device__ __forceinline__ XcdBarrier xcd_barrier_post(unsigned* bar, volatile LAS unsigned* st) {
    XcdBarrier b; b.bar = bar; b.x = xb_xcc_id(); b.st = st;
    if (threadIdx.x == 0) (void)xb_add(&bar[XB_XCNT(b.x)], 1u);
    return b;
}
__device__ __forceinline__ void xcd_barrier_complete(unsigned* bar, unsigned x, unsigned& nloc, unsigned& nx) {
    const unsigned G = gridDim.x * gridDim.y * gridDim.z;
    unsigned sum, cnt, mine, sp = 0u;
    for (;;) {
        sum = 0u; cnt = 0u; mine = 0u;
#pragma unroll
        for (unsigned j = 0; j < 16; ++j) { const unsigned c = xb_ld(&bar[XB_XCNT(j)]); sum += c; cnt += (c > 0u) ? 1u : 0u; mine = (j == x) ? c : mine; }
        if (sum == G) break;
        __builtin_amdgcn_s_sleep(1);
        if ((++sp & 255u) == 0u) { if (xb_ld(&bar[XB_TMO])) break; if (sp > XB_SPIN_CAP) { atomicAdd(&bar[XB_TMO], 1u); break; } }
    }
    nloc = mine > 0u ? mine : 1u; nx = cnt > 0u ? cnt : 1u;
}
__device__ __forceinline__ void xcd_barrier(const XcdBarrier& b) {
    asm volatile("s_waitcnt vmcnt(0)" ::: "memory");
    __syncthreads();
    if (threadIdx.x == 0) {
        unsigned* bar = b.bar;
        __builtin_amdgcn_s_waitcnt(0);
        unsigned nloc = b.st[0], nx = b.st[1];
        if (nloc == 0u) { xcd_barrier_complete(bar, b.x, nloc, nx); b.st[0] = nloc; b.st[1] = nx; }
        const unsigned old = xb_add(&bar[XB_XSUB(b.x)], 1u);
        const unsigned gen = old / nloc;
        if (old + 1u == (gen + 1u) * nloc) {
            __builtin_amdgcn_fence(__ATOMIC_RELEASE, "agent");
            asm volatile("s_waitcnt vmcnt(0)" ::: "memory");
            const unsigned og = xb_add(&bar[XB_TOP], 1u);
            const unsigned tg = og / nx;
            if (og + 1u == (tg + 1u) * nx) xb_add(&bar[XB_TOPGEN], 1u);
            else XB_SPIN(xb_ld(&bar[XB_TOPGEN]) == tg, bar);
            __builtin_amdgcn_fence(__ATOMIC_ACQUIRE, "agent");
            xb_add(&bar[XB_XGEN(b.x)], 1u);
            asm volatile("s_waitcnt vmcnt(0)" ::: "memory");
        } else {
            XB_SPIN(xb_ld(&bar[XB_XGEN(b.x)]) == gen, bar);
            __builtin_amdgcn_fence(__ATOMIC_ACQUIRE, "agent");
            asm volatile("s_waitcnt vmcnt(0)" ::: "memory");
        }
    }
    __syncthreads();
}

struct Params { const float* in[29]; float* out; unsigned char* ws; int ph_lo, ph_hi; };
enum { I_X = 0, I_C, I_WADA, I_BADA, I_GN1, I_WIN, I_GQ, I_GK, I_CPK, I_CPV, I_CW1K, I_CW2K, I_CW1V, I_CW2V, I_GGV, I_WSP, I_BSP, I_GON, I_GOG, I_WOUT, I_GN2,
       I_WR, I_RB, I_WG, I_WU, I_WD, I_SG, I_SU, I_SD };

namespace pg8 {
constexpr int BM = 256, BK = 64, HALF = 128, HTB = HALF * BK * 2, NXCD = 8, WGM = 8;
__device__ __forceinline__ int lds_byte(int r, int c) { const int st = (r >> 4) * 2 + (c >> 5), rr = r & 15, cc = c & 31, ob = rr * 64 + cc * 2; return st * 1024 + (ob ^ (((ob >> 9) & 1) << 5)); }
__device__ __forceinline__ void stage_rc(int b, int& R, int& C) { const int st = b / 1024, sb = b % 1024, swz = sb ^ (((sb >> 9) & 1) << 5); R = (st >> 1) * 16 + swz / 64; C = (st & 1) * 32 + (swz % 64) / 2; }
__device__ __forceinline__ int perm32(int rho) { const int n = rho >> 4, i = rho & 15; return 8 * (i >> 2) + 4 * n + (i & 3); }
struct Unit { int pm, pn, e, aux; };

__device__ __forceinline__ bool dense_next(int i, int G, int c, int nM, int nN, Unit& u) {
    const int nwg = nM * nN; const long L = (long)i * G + c; if (L >= nwg) return false;
    int wgid = (int)L; { const int q = nwg / NXCD, r = nwg % NXCD, xcd = wgid % NXCD, off = wgid / NXCD; wgid = (xcd < r ? xcd * (q + 1) : r * (q + 1) + (xcd - r) * q) + off; }
    const int nig = WGM * nN, gid = wgid / nig, fm = gid * WGM, gsz = (nM - fm) < WGM ? (nM - fm) : WGM;
    u.pm = fm + ((wgid % nig) % gsz); u.pn = (wgid % nig) / gsz; u.e = 0; u.aux = 0; return true;
}

template <class P>
__device__ __forceinline__ void gemm_phase(LAS unsigned char* lds, const P& prm) {
    const int tid = threadIdx.x, wid = __builtin_amdgcn_readfirstlane(tid >> 6), lane = tid & 63, wr = wid >> 2, wc = wid & 3, fr = lane & 15, fq = lane >> 4;
    constexpr int K = P::K, ESZ = P::ESZ, nt = (K * ESZ) / 128;
    const unsigned lda2 = (unsigned)prm.lda * (unsigned)ESZ;
    int Rl[2], Cl[2]; unsigned voffB[2];
#pragma unroll
    for (int i = 0; i < 2; ++i) { int R, C; stage_rc(tid * 16 + i * 8192, R, C); Rl[i] = R; Cl[i] = C; const int Rb = (R & ~31) + perm32(R & 31); voffB[i] = (unsigned)(Rb * P::LDB * ESZ + C * 2); }
    const size_t kstep = (size_t)(BK * 2);
    const size_t hstepB = (size_t)HALF * P::LDB * ESZ;
    const unsigned ldsw = (unsigned)wid * 1024u;
    const int fcol = fq * 8;
    const int aoff = lds_byte(wr * 64 + fr, fcol), boff = lds_byte(wc * 32 + fr, fcol);
    constexpr int fkst = 1024;
#define PG8_SA(b, h) (((b) * 2 + (h)) * HTB)
#define PG8_SB(b, h) ((4 + (b) * 2 + (h)) * HTB)
#define PG8_STAGE(bufoff, gbase, voff) do { _Pragma("unroll") for (int _i = 0; _i < 2; ++_i) \
        __builtin_amdgcn_global_load_lds((const unsigned*)((const char*)(gbase) + (voff)[_i]), (LAS unsigned*)(lds + (bufoff) + ldsw + _i * 8192), 16, 0, 0); } while (0)
#define PG8_LDA(dst, b, h) do { _Pragma("unroll") for (int m = 0; m < 4; ++m) _Pragma("unroll") for (int k = 0; k < 2; ++k) dst[m][k] = *(const LAS bf16x8*)(lds + PG8_SA(b, h) + aoff + m * 2048 + k * fkst); } while (0)
#define PG8_LDB(dst, b, h) do { _Pragma("unroll") for (int n = 0; n < 2; ++n) _Pragma("unroll") for (int k = 0; k < 2; ++k) dst[n][k] = *(const LAS bf16x8*)(lds + PG8_SB(b, h) + boff + n * 2048 + k * fkst); } while (0)
#define PG8_MMA(ai, bj, At, Bt) do { __builtin_amdgcn_s_setprio(1); \
        if constexpr (ESZ == 2) { _Pragma("unroll") for (int m = 0; m < 4; ++m) _Pragma("unroll") for (int n = 0; n < 2; ++n) _Pragma("unroll") for (int k = 0; k < 2; ++k) \
            acc[ai][bj][m][n] = __builtin_amdgcn_mfma_f32_16x16x32_bf16(Bt[n][k], At[m][k], acc[ai][bj][m][n], 0, 0, 0); } \
        else { _Pragma("unroll") for (int m = 0; m < 4; ++m) _Pragma("unroll") for (int n = 0; n < 2; ++n) { \
            const v8i32 a8_ = __builtin_shufflevector(__builtin_bit_cast(v4i32, At[m][0]), __builtin_bit_cast(v4i32, At[m][1]), 0, 1, 2, 3, 4, 5, 6, 7); \
            const v8i32 b8_ = __builtin_shufflevector(__builtin_bit_cast(v4i32, Bt[n][0]), __builtin_bit_cast(v4i32, Bt[n][1]), 0, 1, 2, 3, 4, 5, 6, 7); \
            acc[ai][bj][m][n] = __builtin_amdgcn_mfma_scale_f32_16x16x128_f8f6f4(b8_, a8_, acc[ai][bj][m][n], 0, 0, 0, 0x7f7f7f7f, 0, 0x7f7f7f7f); } } \
        __builtin_amdgcn_s_setprio(0); } while (0)
#define PG8_WAIT_V(n) asm volatile("s_waitcnt vmcnt(" #n ")" ::: "memory")
#define PG8_WAIT_L(n) asm volatile("s_waitcnt lgkmcnt(" #n ")" ::: "memory")
#define PG8_WAIT_VK() do { if constexpr (P::HALFONLY) asm volatile("s_waitcnt vmcnt(6)" ::: "memory"); else asm volatile("s_waitcnt vmcnt(8)" ::: "memory"); } while (0)
#define PG8_BAR __builtin_amdgcn_s_barrier()
#define PG8_SCHED __builtin_amdgcn_sched_barrier(0)
    Unit cur, nxt; int ui = 0;
    if (!prm.next(0, cur)) return;
    f32x4 acc[2][2][4][2];
#pragma unroll
    for (int a = 0; a < 2; ++a)
#pragma unroll
        for (int b = 0; b < 2; ++b)
#pragma unroll
            for (int m = 0; m < 4; ++m)
#pragma unroll
                for (int n = 0; n < 2; ++n) acc[a][b][m][n] = (f32x4){0.f, 0.f, 0.f, 0.f};
    bf16x8 At[4][2], B0[2][2], B1[2][2];
    const char* Ab = (const char*)prm.A;
    unsigned offA0[2], offA1[2];
#pragma unroll
    for (int i = 0; i < 2; ++i) { offA0[i] = prm.row_id(cur, Rl[i]) * lda2 + (unsigned)Cl[i] * 2u + prm.a_koff(cur); offA1[i] = prm.row_id(cur, Rl[i] + HALF) * lda2 + (unsigned)Cl[i] * 2u + prm.a_koff(cur); }
    const char* cB = prm.b_base(cur);
    PG8_STAGE(PG8_SB(0, 0), cB, voffB); PG8_STAGE(PG8_SB(0, 1), cB + hstepB, voffB); PG8_STAGE(PG8_SA(0, 0), Ab, offA0); if constexpr (!P::HALFONLY) PG8_STAGE(PG8_SA(0, 1), Ab, offA1);
    if (wr == 1) PG8_BAR;
    if constexpr (P::HALFONLY) PG8_WAIT_V(0); else PG8_WAIT_V(2);
    PG8_BAR;
    PG8_STAGE(PG8_SB(1, 0), cB + kstep, voffB); PG8_STAGE(PG8_SA(1, 0), Ab + kstep, offA0); PG8_STAGE(PG8_SB(1, 1), cB + hstepB + kstep, voffB);
    PG8_WAIT_V(6); PG8_BAR;
    for (;;) {
        const bool has_next = prm.next(ui + 1, nxt);
        const char* nB = has_next ? prm.b_base(nxt) : cB;
        prm.unit_begin(cur, ui);
        unsigned idn[4] = {0u, 0u, 0u, 0u};
#pragma unroll 1
        for (int t = 0; t < nt; t += 2) {
            const bool last = (t == nt - 2);
            if (t == nt - 4 && has_next) {
                if constexpr (P::IDLDS) prm.ids_prefetch(nxt, wid, lane);
                else {
#pragma unroll
                    for (int i = 0; i < 2; ++i) { idn[i] = prm.row_id(nxt, Rl[i]); idn[2 + i] = prm.row_id(nxt, Rl[i] + HALF); }
                }
            }
            const char* a1 = Ab + (size_t)(t + 1) * kstep;
            const char* a2 = last ? Ab : Ab + (size_t)(t + 2) * kstep; const char* b2 = last ? nB : cB + (size_t)(t + 2) * kstep;
            const char* a3 = a2 + kstep; const char* b3 = b2 + kstep;
            if constexpr (P::MIDK) { if (t == nt / 2) prm.midk(acc, cur, ui, wr, fr); }
            PG8_LDB(B0, 0, 0); PG8_LDB(B1, 0, 1); PG8_SCHED; PG8_LDA(At, 0, 0); if constexpr (!P::HALFONLY) PG8_STAGE(PG8_SA(1, 1), a1, offA1);
            if (last && has_next) {
                if constexpr (P::IDLDS) {
#pragma unroll
                    for (int i = 0; i < 2; ++i) { idn[i] = prm.ids_read(nxt, Rl[i]); idn[2 + i] = prm.ids_read(nxt, Rl[i] + HALF); }
                }
#pragma unroll
                for (int i = 0; i < 2; ++i) { offA0[i] = idn[i] * lda2 + (unsigned)Cl[i] * 2u + prm.a_koff(nxt); offA1[i] = idn[2 + i] * lda2 + (unsigned)Cl[i] * 2u + prm.a_koff(nxt); }
            }
            PG8_WAIT_VK(); PG8_WAIT_L(0); PG8_BAR; PG8_MMA(0, 0, At, B0); PG8_MMA(0, 1, At, B1); PG8_BAR; PG8_SCHED;
            if constexpr (!P::HALFONLY) PG8_LDA(At, 0, 1); PG8_STAGE(PG8_SB(0, 0), b2, voffB); PG8_STAGE(PG8_SB(0, 1), b2 + hstepB, voffB); PG8_STAGE(PG8_SA(0, 0), a2, offA0);
            PG8_WAIT_VK(); PG8_WAIT_L(0); PG8_BAR; if constexpr (!P::HALFONLY) { PG8_MMA(1, 0, At, B0); PG8_MMA(1, 1, At, B1); } PG8_BAR; PG8_SCHED;
            PG8_LDB(B0, 1, 0); PG8_LDB(B1, 1, 1); PG8_SCHED; PG8_LDA(At, 1, 0); if constexpr (!P::HALFONLY) PG8_STAGE(PG8_SA(0, 1), a2, offA1);
            PG8_WAIT_VK(); PG8_WAIT_L(0); PG8_BAR; PG8_MMA(0, 0, At, B0); PG8_MMA(0, 1, At, B1); PG8_BAR; PG8_SCHED;
            if constexpr (!P::HALFONLY) PG8_LDA(At, 1, 1); PG8_STAGE(PG8_SB(1, 0), b3, voffB); PG8_STAGE(PG8_SB(1, 1), b3 + hstepB, voffB); PG8_STAGE(PG8_SA(1, 0), a3, offA0);
            PG8_WAIT_VK(); PG8_WAIT_L(0); PG8_BAR; if constexpr (!P::HALFONLY) { PG8_MMA(1, 0, At, B0); PG8_MMA(1, 1, At, B1); } PG8_BAR; PG8_SCHED;
        }
        if (wr == 0) PG8_BAR;
        prm.epi(acc, cur, ui, wr, wc, fr, fq);
        if (DUP(16)) { asm volatile("" ::: "memory"); prm.epi(acc, cur, ui, wr, wc, fr, fq); }
        if (!has_next) break;
#pragma unroll
        for (int a = 0; a < 2; ++a)
#pragma unroll
            for (int b = 0; b < 2; ++b)
#pragma unroll
                for (int m = 0; m < 4; ++m)
#pragma unroll
                    for (int n = 0; n < 2; ++n) acc[a][b][m][n] = (f32x4){0.f, 0.f, 0.f, 0.f};
        cur = nxt; cB = nB; ++ui;
        if (wr == 1) PG8_BAR;
    }
    PG8_WAIT_V(0);
    PG8_BAR;
#undef PG8_SA
#undef PG8_SB
#undef PG8_STAGE
#undef PG8_LDA
#undef PG8_LDB
#undef PG8_MMA
#undef PG8_WAIT_V
#undef PG8_WAIT_L
#undef PG8_WAIT_VK
#undef PG8_BAR
#undef PG8_SCHED
}
}
using pg8::Unit;
typedef f32x4 Acc[2][2][4][2];

struct Frame {
    LAS unsigned char* lds;
    unsigned char* ws;
    const float* const* in;
    float* out;
    int tid, lane, wave, G, vcu;
};
#define WSP(T_, off) ((T_*)(F.ws + (off)))

struct ConvItem { const float* src; int ldn; int k0; int n0; bf16_t* dst; int Kd; int drow0; int mode; int nvalid; int fp8; const float* rs0; const float* rs1; };
constexpr int CV_WIN = 16 * 38, CV_WOUT = 256, CV_CMP = 64, CV_GU = 65 * 128, CV_DN = 65 * 64;
constexpr int CV_TOTAL = CV_WIN + CV_WOUT + CV_CMP + CV_GU + CV_DN;
__device__ __forceinline__ void conv_decode(const Frame& F, int it, ConvItem& c) {
    c.mode = 0; c.nvalid = 128; c.fp8 = 0; c.rs0 = nullptr; c.rs1 = nullptr;
    if (it < CV_WIN) {
        const int kb = it / 38, nb = it % 38; c.src = F.in[I_WIN]; c.ldn = IN_COLS; c.k0 = kb * 128; c.dst = WSP(bf16_t, WS_WIN_T); c.Kd = 2048;
        if (nb < 20) { c.n0 = nb * 128; c.drow0 = (nb >> 1) * 256; c.mode = 1 + (nb & 1); }
        else if (nb < 28) { c.n0 = 2608 + (nb - 20) * 128; c.drow0 = 2560 + (nb - 20) * 128; }
        else if (nb < 36) { c.n0 = 3632 + (nb - 28) * 128; c.drow0 = 3584 + (nb - 28) * 128; }
        else if (nb == 36) { c.n0 = 2560; c.drow0 = 4608; c.nvalid = 48; }
        else { c.n0 = 2560; c.drow0 = 4736; c.nvalid = 0; }
        return;
    }
    it -= CV_WIN;
    if (it < CV_WOUT) { const int kb = it / 16, nb = it % 16; c.src = F.in[I_WOUT]; c.ldn = 2048; c.k0 = kb * 128; c.n0 = nb * 128; c.dst = WSP(bf16_t, WS_WOUT_T); c.Kd = 2048; c.drow0 = nb * 128;
        c.rs0 = F.in[I_GON]; c.rs1 = F.in[I_GOG]; return; }
    it -= CV_WOUT;
    if (it < CV_CMP) { const int kv = it / 32, r = it % 32, kb = r / 2, nb = r % 2; c.src = F.in[kv ? I_CW1V : I_CW1K]; c.ldn = 256; c.k0 = kb * 128; c.n0 = nb * 128;
        c.dst = WSP(bf16_t, WS_WCMP_T) + (size_t)kv * 256 * 2048; c.Kd = 2048; c.drow0 = nb * 128; return; }
    it -= CV_CMP;
    if (it < CV_GU) { const int e = it / 128, r = it % 128, up = r / 64, kb = (r % 64) / 4, nb = r % 4;
        c.src = (e < 64) ? F.in[up ? I_WU : I_WG] + (size_t)e * 2048 * 512 : F.in[up ? I_SU : I_SG];
        c.ldn = 512; c.k0 = kb * 128; c.n0 = nb * 128; c.dst = (bf16_t*)(WSP(unsigned char, WS_WGU_T) + (size_t)e * 1024 * 2048); c.Kd = 2048; c.drow0 = nb * 256 + up * 128; c.fp8 = 1; return; }
    it -= CV_GU;
    { const int e = it / 64, r = it % 64, kb = r / 16, nb = r % 16;
      c.src = (e < 64) ? F.in[I_WD] + (size_t)e * 512 * 2048 : F.in[I_SD];
      c.ldn = 2048; c.k0 = kb * 128; c.n0 = nb * 128; c.dst = (bf16_t*)(WSP(unsigned char, WS_WD_T) + (size_t)e * 2048 * 512); c.Kd = 512; c.drow0 = nb * 128; c.fp8 = 1; c.mode = 3; }
}
__device__ __forceinline__ void conv_load(const ConvItem& c, int sub, int lane, f32x4 (&v)[16]) {
    const int n4 = lane & 15, kq = lane >> 4, nl = 64 * (sub & 1) + 4 * n4;
    const bool ok = nl < c.nvalid;
    if (c.fp8) {
        const float* s = c.src + (size_t)(c.k0 + 64 * (sub >> 1) + 4 * kq) * c.ldn + c.n0 + nl;
#pragma unroll
        for (int i = 0; i < 4; ++i)
#pragma unroll
            for (int j = 0; j < 4; ++j) v[4 * i + j] = __builtin_nontemporal_load((const f32x4*)(s + (size_t)(16 * i + j) * c.ldn));
        return;
    }
    const float* s = c.src + (size_t)(c.k0 + 64 * (sub >> 1) + 2 * kq) * c.ldn + c.n0 + nl;
#pragma unroll
    for (int i = 0; i < 8; ++i) {
        v[2 * i] = ok ? __builtin_nontemporal_load((const f32x4*)(s + (size_t)(8 * i) * c.ldn)) : (f32x4){0.f, 0.f, 0.f, 0.f};
        v[2 * i + 1] = ok ? __builtin_nontemporal_load((const f32x4*)(s + (size_t)(8 * i + 1) * c.ldn)) : (f32x4){0.f, 0.f, 0.f, 0.f};
    }
}
__device__ __forceinline__ void conv_process(const ConvItem& c, int sub, int lane, const f32x4 (&v)[16], LAS unsigned* tile) {
    const int n4 = lane & 15, kq = lane >> 4, kb = c.k0 + 64 * (sub >> 1);
    if (c.fp8) {
#pragma unroll
        for (int i = 0; i < 4; ++i)
#pragma unroll
            for (int cc = 0; cc < 4; ++cc) tile[(4 * n4 + cc) * 129 + 4 * i + kq] = pk4_fp8(v[4 * i][cc] * W8SCALE, v[4 * i + 1][cc] * W8SCALE, v[4 * i + 2][cc] * W8SCALE, v[4 * i + 3][cc] * W8SCALE);
        return;
    }
#pragma unroll
    for (int i = 0; i < 8; ++i) {
        float s0 = 1.f, s1 = 1.f;
        if (c.rs0) { const int k = kb + 8 * i + 2 * kq; s0 = (k < 1024) ? c.rs0[k] : c.rs1[k - 1024]; s1 = (k + 1 < 1024) ? c.rs0[k + 1] : c.rs1[k + 1 - 1024]; }
#pragma unroll
        for (int cc = 0; cc < 4; ++cc) tile[(4 * n4 + cc) * 33 + 4 * i + kq] = cvt_pk_bf16(v[2 * i][cc] * s0, v[2 * i + 1][cc] * s1);
    }
#pragma unroll
    for (int j = 0; j < 8; ++j) {
        const int row = (lane >> 3) + 8 * j, c8 = lane & 7;
        const LAS unsigned* sp = tile + row * 33 + 4 * c8;
        u32x4 o; o.x = sp[0]; o.y = sp[1]; o.z = sp[2]; o.w = sp[3];
        const int n = 64 * (sub & 1) + row;
        int drow = c.drow0 + n;
        if (c.mode) { const int l = (c.mode - 1) * 128 + n, wc = l >> 6, bj = (l >> 5) & 1, jj = l & 31; drow = c.drow0 + 128 * bj + 32 * wc + jj; }
        __builtin_nontemporal_store(o, (u32x4*)(c.dst + (size_t)drow * c.Kd + kb + 8 * c8));
    }
}
template <int R>
__device__ __forceinline__ void gemv_item(const Frame& F, const LAS float* a_lds, LAS float* red, const float* W, int ldn, int n0, const float* bias, float* out, int ldo) {
    const int ks = F.tid >> 4, c4 = F.tid & 15;
    float acc[R][4];
#pragma unroll
    for (int r = 0; r < R; ++r) { acc[r][0] = 0.f; acc[r][1] = 0.f; acc[r][2] = 0.f; acc[r][3] = 0.f; }
    const float* wp = W + (size_t)(ks * 64) * ldn + n0 + 4 * c4;
#pragma unroll 16
    for (int kk = 0; kk < 64; ++kk) {
        const f32x4 w = *(const f32x4*)(wp + (size_t)kk * ldn);
#pragma unroll
        for (int r = 0; r < R; ++r) { const float a = a_lds[r * 2048 + ks * 64 + kk]; acc[r][0] += a * w.x; acc[r][1] += a * w.y; acc[r][2] += a * w.z; acc[r][3] += a * w.w; }
    }
#pragma unroll
    for (int r = 0; r < R; ++r) *(LAS f32x4*)(red + (ks * R + r) * 64 + 4 * c4) = (f32x4){acc[r][0], acc[r][1], acc[r][2], acc[r][3]};
    __syncthreads();
    if (F.tid < R * 64) {
        const int r = F.tid >> 6, n = F.tid & 63; float s = bias ? bias[n0 + n] : 0.f;
        for (int k = 0; k < 32; ++k) s += red[(k * R + r) * 64 + n];
        out[(size_t)r * ldo + n0 + n] = s;
    }
    __syncthreads();
}
constexpr int CV_NT4 = CV_TOTAL * 4;
constexpr int CV_DEFER = 0;
constexpr int CV_EARLY = 76 * 32;
constexpr int CV_EARLY_ALL = 76 * 32 + 32 * 32 + 2 * 4 * 32;
constexpr int NG_INPROJ = 132;
constexpr int CV_DEFER2 = 0;
__device__ __forceinline__ void tile_decode(int T, int& item, int& sub) {
    constexpr int T_WIN = 76 * 32, T_WOUT = 32 * 32, T_CMP = 2 * 4 * 32, T_GU = 65 * 2 * 8 * 32;
    int kb, nb;
    if (T < T_WIN) { kb = T & 31; nb = T >> 5; item = (kb >> 1) * 38 + (nb >> 1); }
    else if ((T -= T_WIN) < T_WOUT) { kb = T & 31; nb = T >> 5; item = CV_WIN + (kb >> 1) * 16 + (nb >> 1); }
    else if ((T -= T_WOUT) < T_CMP) { kb = T & 31; nb = (T >> 5) & 3; const int kv = T >> 7; item = CV_WIN + CV_WOUT + kv * 32 + (kb >> 1) * 2 + (nb >> 1); }
    else if ((T -= T_CMP) < T_GU) { kb = T & 31; nb = (T >> 5) & 7; const int eu = T >> 8; item = CV_WIN + CV_WOUT + CV_CMP + eu * 64 + (kb >> 1) * 4 + (nb >> 1); }
    else { T -= T_GU; kb = T & 7; nb = (T >> 3) & 31; const int e = T >> 8; item = CV_WIN + CV_WOUT + CV_CMP + CV_GU + e * 64 + (kb >> 1) * 16 + (nb >> 1); }
    sub = ((kb & 1) << 1) | (nb & 1);
}
__device__ __forceinline__ void conv_coop_store(const ConvItem& c0, int s0, int tid, const LAS unsigned* img) {
    unsigned char* d8 = (unsigned char*)c0.dst; const int kbase = c0.k0 + 64 * (s0 >> 1);
#pragma unroll
    for (int q = 0; q < 4; ++q) {
        const int ch = tid + 512 * q, row = ch >> 5, c16 = ch & 31;
        const LAS unsigned* sp = img + row * 129 + 4 * c16;
        u32x4 o; o.x = sp[0]; o.y = sp[1]; o.z = sp[2]; o.w = sp[3];
        int drow = c0.drow0 + 64 * (s0 & 1) + row;
        if (c0.mode == 3) { const int L = drow & 255; drow = (drow & ~255) + 128 * ((L >> 3) & 1) + 32 * (L >> 6) + 8 * ((L >> 4) & 3) + (L & 7); }
        __builtin_nontemporal_store(o, (u32x4*)(d8 + (size_t)drow * c0.Kd + kbase + 16 * c16));
    }
}
__device__ __forceinline__ void conv_range(const Frame& F, int t0, int t1, int wid, int nw) {
    LAS unsigned* tile = (LAS unsigned*)F.lds + F.wave * (64 * 33);
    LAS unsigned* img0 = (LAS unsigned*)(F.lds + 67584);
    int ta = t0 + wid; const int te = t1; int par = 0;
    ConvItem ca, cb, c0; f32x4 va[16], vb[16]; int ia, sa, ib, sb, i0, s0;
    if (ta < te) { tile_decode(ta, ia, sa); conv_decode(F, ia, ca); conv_load(ca, sa, F.lane, va); }
    while (ta < te) {
        const int tb = ta + nw;
        if (tb < te) { tile_decode(tb, ib, sb); conv_decode(F, ib, cb); conv_load(cb, sb, F.lane, vb); }
        if (ca.fp8) {
            LAS unsigned* img = img0 + par * (64 * 129);
            conv_process(ca, sa, F.lane, va, img + 16 * F.wave);
            __syncthreads();
            tile_decode(ta - F.wave, i0, s0); conv_decode(F, i0, c0); conv_coop_store(c0, s0, F.tid, img); par ^= 1;
        } else conv_process(ca, sa, F.lane, va, tile);
        if (tb >= te) break;
        ta = tb + nw;
        if (ta < te) { tile_decode(ta, ia, sa); conv_decode(F, ia, ca); conv_load(ca, sa, F.lane, va); }
        if (cb.fp8) {
            LAS unsigned* img = img0 + par * (64 * 129);
            conv_process(cb, sb, F.lane, vb, img + 16 * F.wave);
            __syncthreads();
            tile_decode(tb - F.wave, i0, s0); conv_decode(F, i0, c0); conv_coop_store(c0, s0, F.tid, img); par ^= 1;
        } else conv_process(cb, sb, F.lane, vb, tile);
    }
}
__device__ __forceinline__ void conv_process8_wave(const ConvItem& c, int sub, int lane, const f32x4 (&v)[16], LAS unsigned* tile) {
    const int n4 = lane & 15, kq = lane >> 4, kb = c.k0 + 64 * (sub >> 1);
#pragma unroll
    for (int i = 0; i < 4; ++i)
#pragma unroll
        for (int cc = 0; cc < 4; ++cc) tile[(4 * n4 + cc) * 17 + 4 * i + kq] = pk4_fp8(v[4 * i][cc] * W8SCALE, v[4 * i + 1][cc] * W8SCALE, v[4 * i + 2][cc] * W8SCALE, v[4 * i + 3][cc] * W8SCALE);
    unsigned char* d8 = (unsigned char*)c.dst;
#pragma unroll
    for (int j = 0; j < 4; ++j) {
        const int row = (lane >> 2) + 16 * j, c4 = lane & 3;
        const LAS unsigned* sp = tile + row * 17 + 4 * c4;
        u32x4 o; o.x = sp[0]; o.y = sp[1]; o.z = sp[2]; o.w = sp[3];
        int drow = c.drow0 + 64 * (sub & 1) + row;
        if (c.mode == 3) { const int L = drow & 255; drow = (drow & ~255) + 128 * ((L >> 3) & 1) + 32 * (L >> 6) + 8 * ((L >> 4) & 3) + (L & 7); }
        __builtin_nontemporal_store(o, (u32x4*)(d8 + (size_t)drow * c.Kd + kb + 16 * c4));
    }
}
__device__ __forceinline__ void conv_step(const Frame& F, const ConvItem& c, int sid, const f32x4 (&v)[16], int tcur, LAS unsigned* tile, LAS unsigned* img0, int& par) {
    if (c.fp8) { conv_process8_wave(c, sid, F.lane, v, tile);
    } else conv_process(c, sid, F.lane, v, tile);
}
__device__ __forceinline__ void conv_range3(const Frame& F, int t0, int t1, int wid, int nw) {
    LAS unsigned* tile = (LAS unsigned*)F.lds + F.wave * (64 * 33);
    LAS unsigned* img0 = (LAS unsigned*)(F.lds + 67584);
    int par = 0; const int te = t1;
    ConvItem ca, cb, cc; f32x4 va[16], vb[16], vc[16]; int ia, sa, ib, sb, ic, sc;
    int ta = t0 + wid, tb = ta + nw, tc = tb + nw;
    if (ta < te) { tile_decode(ta, ia, sa); conv_decode(F, ia, ca); conv_load(ca, sa, F.lane, va); }
    if (tb < te) { tile_decode(tb, ib, sb); conv_decode(F, ib, cb); conv_load(cb, sb, F.lane, vb); }
    while (ta < te) {
        if (tc < te) { tile_decode(tc, ic, sc); conv_decode(F, ic, cc); conv_load(cc, sc, F.lane, vc); }
        conv_step(F, ca, sa, va, ta, tile, img0, par);
        ta = tc + nw;
        if (tb >= te) break;
        if (ta < te) { tile_decode(ta, ia, sa); conv_decode(F, ia, ca); conv_load(ca, sa, F.lane, va); }
        conv_step(F, cb, sb, vb, tb, tile, img0, par);
        tb = ta + nw;
        if (tc >= te) break;
        if (tb < te) { tile_decode(tb, ib, sb); conv_decode(F, ib, cb); conv_load(cb, sb, F.lane, vb); }
        conv_step(F, cc, sc, vc, tc, tile, img0, par);
        tc = tb + nw;
    }
}
__device__ __forceinline__ void phase0a(const Frame& F) {
    LAS float* a_lds = (LAS float*)F.lds;
    LAS float* red = (LAS float*)(F.lds + 32768);
    for (int it = F.vcu; it < 200; it += F.G) {
        if (it < 192) {
            for (int i = F.tid; i < 4 * 2048; i += 512) a_lds[i] = siluf_(F.in[I_C][i]);
            __syncthreads();
            gemv_item<4>(F, a_lds, red, F.in[I_WADA], 6 * D, it * 64, F.in[I_BADA], WSP(float, WS_MOD), 6 * D);
        } else {
            const int kv = (it - 192) >> 2, nb = (it - 192) & 3;
            for (int i = F.tid; i < 2048; i += 512) a_lds[i] = F.in[kv ? I_CPV : I_CPK][i];
            __syncthreads();
            gemv_item<1>(F, a_lds, red, F.in[kv ? I_CW1V : I_CW1K], 256, nb * 64, nullptr, WSP(float, WS_BIAS1) + kv * 256, 256);
        }
    }
    for (int it = F.vcu; it < 128; it += F.G) {
        const int idx = it * 512 + F.tid, pos = idx >> 5, i = idx & 31; float c, s; rope_cs((float)pos, i, c, s);
        WSP(float, WS_ROPE)[idx] = c; WSP(float, WS_ROPE)[65536 + idx] = s;
    }
    __syncthreads();
    if (F.G == 256) {
        constexpr int HEAD = 56 * 8 * 3;
        if (F.vcu >= 200) conv_range(F, 0, HEAD, (F.vcu - 200) * 8 + F.wave, 56 * 8);
        conv_range(F, HEAD, CV_EARLY, F.vcu * 8 + F.wave, F.G * 8);
    }
    else conv_range(F, 0, CV_NT4 - CV_DEFER2, F.vcu * 8 + F.wave, F.G * 8);
}

__device__ __forceinline__ void phase0b(const Frame& F) {
    const int gw = F.vcu * 8 + F.wave, NGW = F.G * 8;
    const float* mod = WSP(float, WS_MOD);
    for (int r0 = gw * 4; r0 < NTOK; r0 += NGW * 4) {
        const int b = r0 >> 11;
        f32x4 ga[8], sh[8];
#pragma unroll
        for (int j = 0; j < 8; ++j) { const int k = 4 * F.lane + 256 * j;
            ga[j] = *(const f32x4*)(F.in[I_GN1] + k) * (*(const f32x4*)(mod + b * 6 * D + D + k) + 1.0f); sh[j] = *(const f32x4*)(mod + b * 6 * D + k); }
#pragma unroll 1
        for (int hf = 0; hf < 2; ++hf) {
            f32x4 v[2][8];
#pragma unroll
            for (int q = 0; q < 2; ++q) { const f32x4* xr = (const f32x4*)(F.in[I_X] + (size_t)(r0 + 2 * hf + q) * D) + F.lane;
#pragma unroll
                for (int j = 0; j < 8; ++j) v[q][j] = xr[64 * j]; }
#pragma unroll
            for (int q = 0; q < 2; ++q) {
                float s = 0.f;
#pragma unroll
                for (int j = 0; j < 8; ++j) s += (v[q][j].x * v[q][j].x + v[q][j].y * v[q][j].y) + (v[q][j].z * v[q][j].z + v[q][j].w * v[q][j].w);
                const float rstd = rsqrtf(wave_sum(s) * (1.f / D) + EPS);
                u32x2* o = (u32x2*)(WSP(bf16_t, WS_H) + (size_t)(r0 + 2 * hf + q) * D) + F.lane;
#pragma unroll
                for (int j = 0; j < 8; ++j) { const f32x4 h = v[q][j] * rstd * ga[j] + sh[j]; u32x2 w; w.x = cvt_pk_bf16(h.x, h.y); w.y = cvt_pk_bf16(h.z, h.w); o[64 * j] = w; }
            }
        }
    }
}

struct InProjP {
    static constexpr int K = 2048, ESZ = 2, LDB = 2048; static constexpr bool IDLDS = false; static constexpr bool HALFONLY = false; static constexpr bool MIDK = false;
    const bf16_t* A; const bf16_t* Bt; int lda; int G, c;
    unsigned char* ws; const float* gq; const float* gk;
    __device__ __forceinline__ bool next(int i, Unit& u) const { return pg8::dense_next(i, G, c, 32, 19, u); }
    __device__ __forceinline__ unsigned row_id(const Unit& u, int r) const { return (unsigned)(u.pm * 256 + r); }
    __device__ __forceinline__ const char* b_base(const Unit& u) const { return (const char*)(Bt + (size_t)u.pn * 256 * K); }
    __device__ __forceinline__ void unit_begin(const Unit&, int) const {}
    __device__ __forceinline__ unsigned a_koff(const Unit&) const { return 0u; }
    __device__ __forceinline__ void midk(Acc&, const Unit&, int, int, int) const {}
    __device__ __forceinline__ void epi(const Acc& acc, const Unit& u, int ui, int wr, int wc, int fr, int fq) const {
        const int pn = u.pn;
        if (pn < 10) {
            const bool donorm = (pn < 4) || pn == 6 || pn == 8;
            const float* g = (pn < 4) ? gq : gk;
            float glo[8], ghi[8];
#pragma unroll
            for (int j = 0; j < 8; ++j) { glo[j] = g[8 * fq + j]; ghi[j] = g[32 + 8 * fq + j]; }
            const float qs = (pn < 4) ? QSCALE : 1.0f;
            const float* cosT = (const float*)(ws + WS_ROPE); const float* sinT = cosT + 65536;
#pragma unroll
            for (int ai = 0; ai < 2; ++ai)
#pragma unroll
                for (int m = 0; m < 4; ++m) {
                    const int row = u.pm * 256 + ai * 128 + wr * 64 + m * 16 + fr, b = row >> 11, t = row & 2047;
                    float lo[8], hi[8];
#pragma unroll
                    for (int n = 0; n < 2; ++n)
#pragma unroll
                        for (int v = 0; v < 4; ++v) { lo[4 * n + v] = acc[ai][0][m][n][v]; hi[4 * n + v] = acc[ai][1][m][n][v]; }
                    if (donorm) {
                        float ss = 0.f;
#pragma unroll
                        for (int j = 0; j < 8; ++j) ss += lo[j] * lo[j] + hi[j] * hi[j];
                        ss += __shfl_xor(ss, 16); ss += __shfl_xor(ss, 32);
                        const float rstd = rsqrtf(ss * (1.f / 64.f) + EPS) * qs;
                        const f32x4 c0 = *(const f32x4*)(cosT + t * 32 + 8 * fq), c1 = *(const f32x4*)(cosT + t * 32 + 8 * fq + 4);
                        const f32x4 s0 = *(const f32x4*)(sinT + t * 32 + 8 * fq), s1 = *(const f32x4*)(sinT + t * 32 + 8 * fq + 4);
#pragma unroll
                        for (int j = 0; j < 8; ++j) {
                            const float cc = j < 4 ? c0[j & 3] : c1[j & 3], sn = j < 4 ? s0[j & 3] : s1[j & 3];
                            const float yl = lo[j] * rstd * glo[j], yh = hi[j] * rstd * ghi[j];
                            lo[j] = yl * cc - yh * sn; hi[j] = yh * cc + yl * sn;
                        }
                    }
                    bf16_t* dst = (pn < 4) ? (bf16_t*)(ws + WS_Q) + ((size_t)((b * 16 + 4 * pn + wc) * 2048 + t)) * 64
                                           : (bf16_t*)(ws + WS_KV + (size_t)(pn - 4) * KV_STRIDE) + ((size_t)((b * 4 + wc) * 2048 + t)) * 64;
                    u32x4 w0, w1;
                    w0.x = cvt_pk_bf16(lo[0], lo[1]); w0.y = cvt_pk_bf16(lo[2], lo[3]); w0.z = cvt_pk_bf16(lo[4], lo[5]); w0.w = cvt_pk_bf16(lo[6], lo[7]);
                    w1.x = cvt_pk_bf16(hi[0], hi[1]); w1.y = cvt_pk_bf16(hi[2], hi[3]); w1.z = cvt_pk_bf16(hi[4], hi[5]); w1.w = cvt_pk_bf16(hi[6], hi[7]);
                    *(u32x4*)(dst + 8 * fq) = w0; *(u32x4*)(dst + 32 + 8 * fq) = w1;
                }
        } else if (pn < 18) {
            const bool isv = pn >= 14; const int tb = isv ? pn - 14 : pn - 10;
            bf16_t* O = (bf16_t*)(ws + (isv ? WS_V : WS_U)); float* vss = (float*)(ws + WS_VSS);
#pragma unroll
            for (int ai = 0; ai < 2; ++ai)
#pragma unroll
                for (int m = 0; m < 4; ++m) {
                    const int row = u.pm * 256 + ai * 128 + wr * 64 + m * 16 + fr;
#pragma unroll
                    for (int bj = 0; bj < 2; ++bj) {
                        float y[8]; float ss = 0.f;
#pragma unroll
                        for (int n = 0; n < 2; ++n)
#pragma unroll
                            for (int v = 0; v < 4; ++v) { const float gl = gelu_tanh(acc[ai][bj][m][n][v]); y[4 * n + v] = gl; ss += gl * gl; }
                        u32x4 w; w.x = cvt_pk_bf16(y[0], y[1]); w.y = cvt_pk_bf16(y[2], y[3]); w.z = cvt_pk_bf16(y[4], y[5]); w.w = cvt_pk_bf16(y[6], y[7]);
                        *(u32x4*)(O + (size_t)row * 1024 + tb * 256 + bj * 128 + wc * 32 + 8 * fq) = w;
                        if (isv) { ss += __shfl_xor(ss, 16); ss += __shfl_xor(ss, 32); if (fq == 0) vss[(size_t)row * 32 + (2 * tb + bj) * 4 + wc] = ss; }
                    }
                }
        } else {
            float* gate = (float*)(ws + WS_GATE);
            const int col = wc * 32 + 8 * fq;
            if (col < 48) {
#pragma unroll
                for (int ai = 0; ai < 2; ++ai)
#pragma unroll
                    for (int m = 0; m < 4; ++m) {
                        const int row = u.pm * 256 + ai * 128 + wr * 64 + m * 16 + fr;
#pragma unroll
                        for (int n = 0; n < 2; ++n) { f32x4 a = acc[ai][0][m][n]; f32x4 o; o.x = sigmoidf_(a.x); o.y = sigmoidf_(a.y); o.z = sigmoidf_(a.z); o.w = sigmoidf_(a.w);
                            *(f32x4*)(gate + (size_t)row * 48 + col + 4 * n) = o; }
                    }
            }
        }
    }
};

struct CmpP {
    static constexpr int K = 512, ESZ = 2, LDB = 2048; static constexpr bool IDLDS = false; static constexpr bool HALFONLY = false; static constexpr bool MIDK = false;
    const bf16_t* A; const bf16_t* Bt; int lda; int G, c;
    unsigned char* ws;
    __device__ __forceinline__ bool next(int i, Unit& u) const { const int L = i * G + c; if (L >= 64) return false; u.e = L >> 5; u.pm = (L >> 2) & 7; u.aux = L & 3; u.pn = 0; return true; }
    __device__ __forceinline__ unsigned row_id(const Unit& u, int r) const { return (unsigned)(u.e * 2048 + u.pm * 256 + r); }
    __device__ __forceinline__ unsigned a_koff(const Unit& u) const { return (unsigned)u.aux * 1024u; }
    __device__ __forceinline__ const char* b_base(const Unit& u) const { return (const char*)(Bt + (size_t)u.e * 256 * 2048 + u.aux * 512); }
    __device__ __forceinline__ void unit_begin(const Unit&, int) const {}
    __device__ __forceinline__ void midk(Acc&, const Unit&, int, int, int) const {}
    __device__ __forceinline__ void epi(const Acc& acc, const Unit& u, int ui, int wr, int wc, int fr, int fq) const {
        float* O = (float*)(ws + WS_PO) + ((size_t)(u.aux * 2 + u.e) * 2048) * 256;
#pragma unroll
        for (int bj = 0; bj < 2; ++bj) {
            const int col = bj * 128 + wc * 32 + 8 * fq;
#pragma unroll
            for (int ai = 0; ai < 2; ++ai)
#pragma unroll
                for (int m = 0; m < 4; ++m) {
                    const int row = u.pm * 256 + ai * 128 + wr * 64 + m * 16 + fr;
                    *(f32x4*)(O + (size_t)row * 256 + col) = acc[ai][bj][m][0]; *(f32x4*)(O + (size_t)row * 256 + col + 4) = acc[ai][bj][m][1];
                }
        }
    }
};

struct OutProjP {
    static constexpr int K = 2048, ESZ = 2, LDB = 2048; static constexpr bool IDLDS = false; static constexpr bool HALFONLY = false; static constexpr bool MIDK = true;
    const bf16_t* A; const bf16_t* Bt; int lda; int G, c;
    unsigned char* ws; const float* x; float* out; LAS f32x2* tab;
    __device__ __forceinline__ bool next(int i, Unit& u) const { return pg8::dense_next(i, G, c, 32, 8, u); }
    __device__ __forceinline__ unsigned row_id(const Unit& u, int r) const { return (unsigned)(u.pm * 256 + r); }
    __device__ __forceinline__ const char* b_base(const Unit& u) const { return (const char*)(Bt + (size_t)u.pn * 256 * K); }
    __device__ __forceinline__ unsigned a_koff(const Unit&) const { return 0u; }
    __device__ __forceinline__ void unit_begin(const Unit& u, int ui) const {
        if (threadIdx.x < 256) {
            const int row = u.pm * 256 + threadIdx.x;
            const f32x4 a = *(const f32x4*)((const float*)(ws + WS_OSSN) + (size_t)row * 4);
            const f32x4* gp = (const f32x4*)((const float*)(ws + WS_OSSG) + (size_t)row * 16);
            const f32x4 g0 = gp[0], g1 = gp[1], g2 = gp[2], g3 = gp[3];
            const float sn = (a.x + a.y) + (a.z + a.w);
            const float sg = ((g0.x + g0.y) + (g0.z + g0.w)) + ((g1.x + g1.y) + (g1.z + g1.w)) + ((g2.x + g2.y) + (g2.z + g2.w)) + ((g3.x + g3.y) + (g3.z + g3.w));
            const float rn = rsqrtf(sn * (1.f / 1024.f) + EPS), rg = rsqrtf(sg * (1.f / 1024.f) + EPS);
            tab[(ui & 1) * 256 + threadIdx.x] = (f32x2){rn / rg, rg};
        }
    }
    __device__ __forceinline__ void midk(Acc& acc, const Unit& u, int ui, int wr, int fr) const {
#pragma unroll
        for (int ai = 0; ai < 2; ++ai)
#pragma unroll
            for (int m = 0; m < 4; ++m) { const float s = tab[(ui & 1) * 256 + ai * 128 + wr * 64 + m * 16 + fr].x;
#pragma unroll
                for (int bj = 0; bj < 2; ++bj)
#pragma unroll
                    for (int n = 0; n < 2; ++n) acc[ai][bj][m][n] *= s; }
    }
    __device__ __forceinline__ void epi(const Acc& acc, const Unit& u, int ui, int wr, int wc, int fr, int fq) const {
        const float* mod = (const float*)(ws + WS_MOD);
#pragma unroll
        for (int ai = 0; ai < 2; ++ai)
#pragma unroll
            for (int m = 0; m < 4; ++m) {
                const int r = ai * 128 + wr * 64 + m * 16 + fr, row = u.pm * 256 + r, b = row >> 11; const float s = tab[(ui & 1) * 256 + r].y;
#pragma unroll
                for (int bj = 0; bj < 2; ++bj) {
                    const int col = u.pn * 256 + bj * 128 + wc * 32 + 8 * fq;
#pragma unroll
                    for (int n = 0; n < 2; ++n) {
                        const f32x4 gt = *(const f32x4*)(mod + b * 6 * D + 2 * D + col + 4 * n), xv = *(const f32x4*)(x + (size_t)row * D + col + 4 * n);
                        *(f32x4*)(out + (size_t)row * D + col + 4 * n) = xv + gt * (acc[ai][bj][m][n] * s);
                    }
                }
            }
    }
};

__device__ __forceinline__ void moe_table(const Frame& F, LAS int* tb) {
    if (F.tid < 64) {
        const unsigned* cnt = (const unsigned*)(F.ws + WS_CTL) + CW_CNT;
        const int c = (int)__hip_atomic_load(cnt + F.tid, __ATOMIC_RELAXED, __HIP_MEMORY_SCOPE_AGENT);
        const int tl = (c + 255) >> 8; int inc = tl;
#pragma unroll
        for (int o = 1; o < 64; o <<= 1) { const int v = __shfl_up(inc, o); if (F.lane >= o) inc += v; }
        tb[F.tid] = inc - tl; tb[128 + F.tid] = c;
        if (F.tid == 63) { tb[64] = inc; tb[65] = inc + (NTOK >> 8); tb[128 + 64] = NTOK; }
    }
    __syncthreads();
    if (F.tid < 384) {
        int lo = 0, hi = 64; while (lo < hi) { const int mid = (lo + hi + 1) >> 1; if (tb[mid] <= F.tid) lo = mid; else hi = mid - 1; }
        tb[256 + F.tid] = lo;
        const int nv = tb[128 + lo] - (F.tid - tb[lo]) * 256;
        tb[640 + F.tid] = (F.tid < tb[65] && lo < 64 && nv <= 128) ? 1 : 0;
    }
    __syncthreads();
    {
        const int TT = tb[65];
        const unsigned long long bm = __ballot(F.tid < 384 && tb[640 + (F.tid < 384 ? F.tid : 0)] != 0);
        if (F.tid < 384 && F.lane == 0) { tb[1500 + 2 * F.wave] = (int)(unsigned)bm; tb[1501 + 2 * F.wave] = (int)(unsigned)(bm >> 32); }
        __syncthreads();
        if (F.tid < 384) {
            int nhb = 0, nh = 0;
#pragma unroll
            for (int w = 0; w < 6; ++w) { const int c = __popc((unsigned)tb[1500 + 2 * w]) + __popc((unsigned)tb[1501 + 2 * w]); nh += c; if (w < F.wave) nhb += c; }
            nhb += __popcll(bm & ((1ull << F.lane) - 1ull));
            const int nf = TT - nh;
            if (F.tid < TT) tb[1024 + (tb[640 + F.tid] ? nf + nhb : F.tid - nhb)] = F.tid;
            if (F.tid == 0) tb[66] = nf;
        }
    }
    __syncthreads();
}

template <bool HALF> struct MoeUpP {
    LAS unsigned* idtab;
    static constexpr int K = 2048, ESZ = 1, LDB = 2048; static constexpr bool IDLDS = true; static constexpr bool HALFONLY = HALF; static constexpr bool MIDK = false;
    const unsigned char* A; const unsigned char* Bt; int lda; int G, c;
    unsigned char* ws; const LAS int* tb; int c0;
    __device__ __forceinline__ bool next(int i, Unit& u) const {
        const int nf = tb[66]; int k;
        if (!HALF) { const int L = i * G + c; if (L >= nf * 4) return false; k = L >> 2; u.pn = L & 3; }
        else { if (c < c0) return false; const int L = i * (G - c0) + (c - c0); if (L >= (tb[65] - nf) * 4) return false; k = nf + (L >> 2); u.pn = L & 3; }
        const int mt = tb[1024 + k]; u.e = tb[256 + mt]; u.pm = mt; u.aux = mt - tb[u.e]; return true; }
    __device__ __forceinline__ unsigned row_id(const Unit& u, int r) const {
        const int base = u.aux * 256; const int nv = tb[128 + u.e] - base; const int rr = r < nv ? r : 0;
        if (u.e == 64) return (unsigned)(base + rr);
        return (unsigned)((const int*)(ws + WS_LIST))[u.e * 8192 + base + rr];
    }
    __device__ __forceinline__ const char* b_base(const Unit& u) const { return (const char*)(Bt + ((size_t)u.e * 1024 + u.pn * 256) * K); }
    __device__ __forceinline__ void ids_prefetch(const Unit& u, int wid, int lane) const {
        if (u.e == 64) return;
        const int r = 64 * (wid & 3) + lane, base = u.aux * 256, nv = tb[128 + u.e] - base, rr = r < nv ? r : 0;
        __builtin_amdgcn_global_load_lds((const unsigned*)((const int*)(ws + WS_LIST) + u.e * 8192 + base + rr), (LAS unsigned*)(idtab + (wid >> 2) * 256 + 64 * (wid & 3)), 4, 0, 0);
    }
    __device__ __forceinline__ unsigned ids_read(const Unit& u, int r) const {
        if (u.e == 64) { const int base = u.aux * 256, nv = tb[128 + u.e] - base; return (unsigned)(base + (r < nv ? r : 0)); }
        return idtab[r];
    }
    __device__ __forceinline__ void unit_begin(const Unit&, int) const {}
    __device__ __forceinline__ unsigned a_koff(const Unit&) const { return 0u; }
    __device__ __forceinline__ void midk(Acc&, const Unit&, int, int, int) const {}
    __device__ __forceinline__ void epi(const Acc& acc, const Unit& u, int ui, int wr, int wc, int fr, int fq) const {
        unsigned char* O = ws + WS_HID; const float ws_ = 1.0f / W8SCALE;
#pragma unroll
        for (int ai = 0; ai < (HALF ? 1 : 2); ++ai)
#pragma unroll
            for (int m = 0; m < 4; ++m) {
                const size_t row = (size_t)u.pm * 256 + ai * 128 + wr * 64 + m * 16 + fr; float y[8];
#pragma unroll
                for (int n = 0; n < 2; ++n)
#pragma unroll
                    for (int v = 0; v < 4; ++v) y[4 * n + v] = siluf_(acc[ai][0][m][n][v] * ws_) * (acc[ai][1][m][n][v] * (ws_ * H8SCALE));
                u32x2 w; w.x = pk4_fp8(y[0], y[1], y[2], y[3]); w.y = pk4_fp8(y[4], y[5], y[6], y[7]);
                *(u32x2*)(O + row * 512 + u.pn * 128 + wc * 32 + 8 * fq) = w;
            }
    }
};
template <bool HALF> struct MoeDownP {
    static constexpr int K = 512, ESZ = 1, LDB = 512; static constexpr bool IDLDS = false; static constexpr bool HALFONLY = HALF; static constexpr bool MIDK = false;
    const unsigned char* A; const unsigned char* Bt; int lda; int G, c;
    unsigned char* ws; const LAS int* tb; int c0;
    __device__ __forceinline__ bool next(int i, Unit& u) const {
        const int nf = tb[66]; int k;
        if (!HALF) { const int L = i * G + c; if (L >= nf * 8) return false; k = L >> 3; u.pn = L & 7; }
        else { if (c < c0) return false; const int L = i * (G - c0) + (c - c0); if (L >= (tb[65] - nf) * 8) return false; k = nf + (L >> 3); u.pn = L & 7; }
        const int mt = tb[1024 + k]; u.e = tb[256 + mt]; u.pm = mt; u.aux = 0; return true; }
    __device__ __forceinline__ unsigned row_id(const Unit& u, int r) const { return (unsigned)(u.pm * 256 + r); }
    __device__ __forceinline__ const char* b_base(const Unit& u) const { return (const char*)(Bt + ((size_t)u.e * 2048 + u.pn * 256) * K); }
    __device__ __forceinline__ void unit_begin(const Unit&, int) const {}
    __device__ __forceinline__ unsigned a_koff(const Unit&) const { return 0u; }
    __device__ __forceinline__ void midk(Acc&, const Unit&, int, int, int) const {}
    __device__ __forceinline__ void epi(const Acc& acc, const Unit& u, int ui, int wr, int wc, int fr, int fq) const {
        unsigned char* O = ws + WS_PO; const float sc_ = PO8SCALE / (W8SCALE * H8SCALE);
#pragma unroll
        for (int ai = 0; ai < (HALF ? 1 : 2); ++ai)
#pragma unroll
            for (int m = 0; m < 4; ++m) {
                const size_t row = (size_t)u.pm * 256 + ai * 128 + wr * 64 + m * 16 + fr;
                const f32x4 a0 = acc[ai][0][m][0] * sc_, a1 = acc[ai][0][m][1] * sc_, b0 = acc[ai][1][m][0] * sc_, b1 = acc[ai][1][m][1] * sc_;
                u32x4 w; w.x = pk4_fp8(a0.x, a0.y, a0.z, a0.w); w.y = pk4_fp8(a1.x, a1.y, a1.z, a1.w); w.z = pk4_fp8(b0.x, b0.y, b0.z, b0.w); w.w = pk4_fp8(b1.x, b1.y, b1.z, b1.w);
                *(u32x4*)(O + row * 2048 + u.pn * 256 + wc * 64 + 16 * fq) = w;
            }
    }
};

__device__ __forceinline__ void gmlp_unit(const Frame& F, int n) {
    const int b = n >> 7, c = (n >> 3) & 15, g = n & 7;
    constexpr int WP = 136, VP = 160;
    LAS bf16_t* Ws = (LAS bf16_t*)F.lds;
    LAS bf16_t* Vs = (LAS bf16_t*)(F.lds + 34816);
    LAS float* rs = (LAS float*)(F.lds + 75776);
    LAS float* stg = (LAS float*)F.lds + F.wave * 2048;
    const int row0 = b * T + c * 128;
    const int tb = F.wave & 3, dh = F.wave >> 2, r32 = F.lane & 31, hi = F.lane >> 5;
    f32x4 vssv = (f32x4){0.f, 0.f, 0.f, 0.f};
    if (F.tid < 128) vssv = *(const f32x4*)(WSP(float, WS_VSS) + (size_t)(row0 + F.tid) * 32 + g * 4);
    const float* wsp = F.in[I_WSP] + (size_t)g * 128 * 128;
    f32x4 wv[8];
#pragma unroll
    for (int q = 0; q < 8; ++q) { const int idx = F.tid + 512 * q; wv[q] = *(const f32x4*)(wsp + (idx >> 5) * 128 + (idx & 31) * 4); }
    const bf16_t* Vg = WSP(bf16_t, WS_V);
    u32x4 vv[4];
#pragma unroll
    for (int q = 0; q < 4; ++q) { const int ch = F.tid + 512 * q; vv[q] = *(const u32x4*)(Vg + (size_t)(row0 + (ch >> 4)) * 1024 + g * 128 + (ch & 15) * 8); }
    const bf16_t* U = WSP(bf16_t, WS_U);
    u32x4 uv[4];
#pragma unroll
    for (int q = 0; q < 4; ++q) uv[q] = *(const u32x4*)(U + (size_t)(row0 + 32 * tb + q * 8 + (F.lane >> 3)) * 1024 + g * 128 + 64 * dh + (F.lane & 7) * 8);
    f32x4 gv0, gv1; { const float* gvp = F.in[I_GGV] + g * 128 + (F.tid & 15) * 8; gv0 = *(const f32x4*)gvp; gv1 = *(const f32x4*)(gvp + 4); }
    __syncthreads();
    if (F.tid < 128) rs[F.tid] = rsqrtf(((vssv.x + vssv.y) + (vssv.z + vssv.w)) * (1.f / 128.f) + EPS);
#pragma unroll
    for (int q = 0; q < 8; ++q) {
        const int idx = F.tid + 512 * q, t = idx >> 5, s4 = (idx & 31) * 4;
        f32x4 w = wv[q];
        if (s4 + 0 > t) w.x = 0.f; if (s4 + 1 > t) w.y = 0.f; if (s4 + 2 > t) w.z = 0.f; if (s4 + 3 > t) w.w = 0.f;
        u32x2 o; o.x = cvt_pk_bf16(w.x, w.y); o.y = cvt_pk_bf16(w.z, w.w);
        *(LAS u32x2*)(Ws + t * WP + s4) = o;
    }
    __syncthreads();
#pragma unroll
    for (int q = 0; q < 4; ++q) {
        const int ch = F.tid + 512 * q, sidx = ch >> 4, dc = ch & 15;
        const float r = rs[sidx];
        u32x4 o;
        o.x = cvt_pk_bf16(bflo(vv[q].x) * r * gv0.x, bfhi(vv[q].x) * r * gv0.y); o.y = cvt_pk_bf16(bflo(vv[q].y) * r * gv0.z, bfhi(vv[q].y) * r * gv0.w);
        o.z = cvt_pk_bf16(bflo(vv[q].z) * r * gv1.x, bfhi(vv[q].z) * r * gv1.y); o.w = cvt_pk_bf16(bflo(vv[q].w) * r * gv1.z, bfhi(vv[q].w) * r * gv1.w);
        *(LAS u32x4*)(Vs + sidx * VP + dc * 8) = o;
    }
    __syncthreads();
    f32x16 acc[2]; acc[0] = (f32x16)(0.f); acc[1] = (f32x16)(0.f);
    {
        const LAS unsigned char* vbase = (const LAS unsigned char*)Vs + (8 * hi + ((F.lane & 15) >> 2)) * (VP * 2) + (64 * dh + 16 * ((F.lane >> 4) & 1) + 4 * (F.lane & 3)) * 2;
        for (int kc = 0; kc < 2 * tb + 2; ++kc) {
            const bf16x8 a = *(const LAS bf16x8*)(Ws + (32 * tb + r32) * WP + 16 * kc + 8 * hi);
#pragma unroll
            for (int db = 0; db < 2; ++db) {
                const v4i16_t lo4 = __builtin_amdgcn_ds_read_tr16_b64_v4i16((LAS v4i16_t*)(vbase + (16 * kc) * (VP * 2) + 64 * db));
                const v4i16_t hi4 = __builtin_amdgcn_ds_read_tr16_b64_v4i16((LAS v4i16_t*)(vbase + (16 * kc + 4) * (VP * 2) + 64 * db));
                const bf16x8 bq = (bf16x8){lo4[0], lo4[1], lo4[2], lo4[3], hi4[0], hi4[1], hi4[2], hi4[3]};
                acc[db] = __builtin_amdgcn_mfma_f32_32x32x16_bf16(a, bq, acc[db], 0, 0, 0);
            }
        }
    }
    __syncthreads();
    {
        const float* bsp = F.in[I_BSP] + g * 128 + 32 * tb + 4 * hi;
        LAS float* sl = stg + (4 * hi) * 64 + r32;
#pragma unroll
        for (int r = 0; r < 16; ++r) { const int rc = (r & 3) + 8 * (r >> 2); const float bias = bsp[rc]; sl[rc * 64] = acc[0][r] + bias; sl[rc * 64 + 32] = acc[1][r] + bias; }
    }
    bf16_t* O = WSP(bf16_t, WS_OCAT); float* ossg = WSP(float, WS_OSSG);
#pragma unroll
    for (int q = 0; q < 4; ++q) {
        const int rl = q * 8 + (F.lane >> 3), ch = F.lane & 7, row = row0 + 32 * tb + rl;
        const f32x4 m0 = *(const LAS f32x4*)(stg + rl * 64 + ch * 8), m1 = *(const LAS f32x4*)(stg + rl * 64 + ch * 8 + 4);
        const float o0 = bflo(uv[q].x) * m0.x, o1 = bfhi(uv[q].x) * m0.y, o2 = bflo(uv[q].y) * m0.z, o3 = bfhi(uv[q].y) * m0.w;
        const float o4 = bflo(uv[q].z) * m1.x, o5 = bfhi(uv[q].z) * m1.y, o6 = bflo(uv[q].w) * m1.z, o7 = bfhi(uv[q].w) * m1.w;
        u32x4 w; w.x = cvt_pk_bf16(o0, o1); w.y = cvt_pk_bf16(o2, o3); w.z = cvt_pk_bf16(o4, o5); w.w = cvt_pk_bf16(o6, o7);
        *(u32x4*)(O + (size_t)row * 2048 + 1024 + g * 128 + 64 * dh + ch * 8) = w;
        float ss = ((o0 * o0 + o1 * o1) + (o2 * o2 + o3 * o3)) + ((o4 * o4 + o5 * o5) + (o6 * o6 + o7 * o7));
        ss += __shfl_xor(ss, 1); ss += __shfl_xor(ss, 2); ss += __shfl_xor(ss, 4);
        if (ch == 0) ossg[(size_t)row * 16 + 2 * g + dh] = ss;
    }
}

__device__ __forceinline__ void phase2b(const Frame& F) {
    const int gw = F.vcu * 8 + F.wave, NGW = F.G * 8;
    LAS float* hs = (LAS float*)F.lds + F.wave * 256;
    for (int it = gw; it < 4096; it += NGW) {
        const int kv = it >> 11, m = it & 2047, n = m & 127;
        bf16_t* dst = WSP(bf16_t, kv ? WS_VCMP : WS_KCMP) + (size_t)m * 64;
        if (n == 127) { dst[F.lane] = 0; continue; }
        {
            f32x4 a = *(const f32x4*)(WSP(float, WS_BIAS1) + kv * 256 + 4 * F.lane);
#pragma unroll
            for (int ks = 0; ks < 4; ++ks) a += *(const f32x4*)(WSP(float, WS_PO) + ((size_t)(ks * 2 + kv) * 2048 + m) * 256 + 4 * F.lane);
            hs[4 * F.lane + 0] = gelu_tanh(a.x); hs[4 * F.lane + 1] = gelu_tanh(a.y); hs[4 * F.lane + 2] = gelu_tanh(a.z); hs[4 * F.lane + 3] = gelu_tanh(a.w);
        }
        const float* w2 = F.in[kv ? I_CW2V : I_CW2K];
        float y0 = 0.f, y1 = 0.f, y2 = 0.f, y3 = 0.f;
#pragma unroll 8
        for (int k = 0; k < 256; k += 4) {
            const f32x4 h4 = *(const LAS f32x4*)(hs + k);
            y0 += h4.x * w2[k * 64 + F.lane]; y1 += h4.y * w2[(k + 1) * 64 + F.lane]; y2 += h4.z * w2[(k + 2) * 64 + F.lane]; y3 += h4.w * w2[(k + 3) * 64 + F.lane];
        }
        float y = (y0 + y1) + (y2 + y3);
        if (kv == 0) {
            const float rstd = rsqrtf(wave_sum(y * y) * (1.f / 64.f) + EPS);
            const float yn = y * rstd * F.in[I_GK][F.lane];
            const float pr = __shfl_xor(yn, 32);
            float c, s; rope_cs(16.0f * (float)n + 15.5f, F.lane & 31, c, s);
            y = (F.lane < 32) ? yn * c - pr * s : yn * c + pr * s;
        }
        dst[F.lane] = (bf16_t)(cvt_pk_bf16(y, 0.f) & 0xffffu);
    }
}

constexpr int AT_KS = 0, AT_VT = 18432, AT_WSF = 43008, AT_MSK = 45056, AT_FS = 45312, AT_SSQ = 47360, AT_IMP = 48384, AT_G = 56832, AT_L = 90624;
constexpr int KSP = 72, VTP = 96, VTB = 64 * VTP * 2;
constexpr float AT_THR = 20.0f;
struct AttnCtx {
    LAS unsigned char* lds; int tid, lane, wave, r32, hi, g, th, tokl;
    bf16x8 qf[4];
};
__device__ __forceinline__ void at_load(const bf16_t* Kb, const bf16_t* Vb, int tile, int tid, u32x4& kr, u32x4& vr) {
    const size_t off = (size_t)(tile * 64 + (tid >> 3)) * 64 + (tid & 7) * 8;
    kr = *(const u32x4*)(Kb + off); vr = *(const u32x4*)(Vb + off);
}
__device__ __forceinline__ void at_store(LAS unsigned char* lds, int buf, int tid, const u32x4& kr, const u32x4& vr) {
    const int key = tid >> 3, ch = tid & 7;
    *(LAS u32x4*)(lds + AT_KS + buf * 9216 + (key * KSP + ch * 8) * 2) = kr;
    *(LAS u32x4*)(lds + AT_VT + buf * VTB + (key * VTP + ch * 8) * 2) = vr;
}
__device__ __forceinline__ void attn_pass(const int MODE, AttnCtx& C, const bf16_t* Kb, const bf16_t* Vb, int i, int j0, int ntiles, unsigned rowmask, bool want_imp, float gatev, f32x16 (&of)[2],
                                          u32x4& kr, u32x4& vr, const bf16_t* Kn, const bf16_t* Vn, int jn) {
    LAS unsigned char* lds = C.lds;
    LAS float* wsf = (LAS float*)(lds + AT_WSF) + C.wave * 64;
    float mref = 0.f, l = 0.f, m0 = 0.f;
    f32x16 o[2]; o[0] = (f32x16)(0.f); o[1] = (f32x16)(0.f);
    const int vlane = (4 * C.hi + ((C.lane & 15) >> 2)) * (VTP * 2) + (16 * ((C.lane >> 4) & 1) + 4 * (C.lane & 3)) * 2;
    at_store(lds, 0, C.tid, kr, vr);
    __syncthreads();
    for (int tt = 0; tt < ntiles; ++tt) {
        const int buf = tt & 1, j = j0 + tt;
        if (tt + 1 < ntiles) at_load(Kb, Vb, j + 1, C.tid, kr, vr); else if (Kn) at_load(Kn, Vn, jn, C.tid, kr, vr);
        bool active = true;
        if (MODE == 1) active = __any((rowmask >> j) & 1u);
        if (active) {
            f32x16 p0, p1;
            const LAS unsigned char* ks = lds + AT_KS + buf * 9216;
            const bool gen = (MODE == 0) || (j == i) || (MODE == 2 && j == i - 8);
            const bool keeprow = (MODE == 1) ? (((rowmask >> j) & 1u) != 0u) : true;
            bf16x8 kf[8];
#pragma unroll
            for (int d0 = 0; d0 < 4; ++d0) {
                kf[2 * d0] = *(const LAS bf16x8*)(ks + (C.r32 * KSP + 16 * d0 + 8 * C.hi) * 2);
                kf[2 * d0 + 1] = *(const LAS bf16x8*)(ks + ((32 + C.r32) * KSP + 16 * d0 + 8 * C.hi) * 2);
            }
            __builtin_amdgcn_sched_barrier(0);
            const bf16x8 ka0 = kf[0], ka1 = kf[1];
            if (gen) {
                int wlo = 0, whi = 63;
                if (MODE == 0) { const int t = 64 * i + C.tokl; whi = ((t >= 31) ? ((t - 31) >> 4) : -1) - 64 * tt; if (whi > 63) whi = 63; }
                else { if (j == i) whi = C.tokl; if (MODE == 2 && j == i - 8) wlo = C.tokl + 1; }
                const unsigned long long vhi = (whi < 0) ? 0ull : ((2ull << whi) - 1ull), vlo = (wlo >= 64) ? ~0ull : ((1ull << wlo) - 1ull);
                const unsigned long long inv = ~(vhi & ~vlo);
                const int il = (int)((unsigned)inv >> (4 * C.hi)), ih = (int)((unsigned)(inv >> 32) >> (4 * C.hi));
                f32x16 c0, c1;
                const int NEGI = __builtin_bit_cast(int, NEGF);
#pragma unroll
                for (int r = 0; r < 16; ++r) {
                    const int kc = (r & 3) + 8 * (r >> 2);
                    c0[r] = __builtin_bit_cast(float, ((il << (31 - kc)) >> 31) & NEGI);
                    c1[r] = __builtin_bit_cast(float, ((ih << (31 - kc)) >> 31) & NEGI);
                }
                p0 = __builtin_amdgcn_mfma_f32_32x32x16_bf16(ka0, C.qf[0], c0, 0, 0, 0); p1 = __builtin_amdgcn_mfma_f32_32x32x16_bf16(ka1, C.qf[0], c1, 0, 0, 0);
            } else {
                const f32x16 z16 = (f32x16)(0.f);
                p0 = __builtin_amdgcn_mfma_f32_32x32x16_bf16(ka0, C.qf[0], z16, 0, 0, 0); p1 = __builtin_amdgcn_mfma_f32_32x32x16_bf16(ka1, C.qf[0], z16, 0, 0, 0);
            }
#pragma unroll
            for (int d0 = 1; d0 < 4; ++d0) {
                p0 = __builtin_amdgcn_mfma_f32_32x32x16_bf16(kf[2 * d0], C.qf[d0], p0, 0, 0, 0); p1 = __builtin_amdgcn_mfma_f32_32x32x16_bf16(kf[2 * d0 + 1], C.qf[d0], p1, 0, 0, 0);
            }
            const LAS unsigned char* vb = lds + AT_VT + buf * VTB + vlane;
            bf16x8 vf[8];
            __builtin_amdgcn_sched_barrier(0);
#pragma unroll
            for (int c = 0; c < 2; ++c) {
                const int koff = (32 * (c >> 1) + 16 * (c & 1)) * (VTP * 2);
#pragma unroll
                for (int db = 0; db < 2; ++db) {
                    const v4i16_t lo = __builtin_amdgcn_ds_read_tr16_b64_v4i16((LAS v4i16_t*)(vb + koff + 64 * db));
                    const v4i16_t hi4 = __builtin_amdgcn_ds_read_tr16_b64_v4i16((LAS v4i16_t*)(vb + koff + 8 * (VTP * 2) + 64 * db));
                    vf[2 * c + db] = (bf16x8){lo[0], lo[1], lo[2], lo[3], hi4[0], hi4[1], hi4[2], hi4[3]};
                }
            }
            __builtin_amdgcn_sched_barrier(0);
            if (__any(mref != 0.f)) {
#pragma unroll
                for (int r = 0; r < 16; ++r) { p0[r] -= mref; p1[r] -= mref; }
            }
            float mx = fmaxf(p0[0], p1[0]);
#pragma unroll
            for (int r = 1; r < 16; ++r) mx = fmaxf(fmaxf(mx, p0[r]), p1[r]);
            if (__any(mx > AT_THR)) {
                mx = fmaxf(mx, __shfl_xor(mx, 32));
                const float dl = fmaxf(mx, 0.f); mref += dl;
#pragma unroll
                for (int r = 0; r < 16; ++r) { p0[r] -= dl; p1[r] -= dl; }
                const float f = fexp2(-dl); l *= f;
                if (C.hi == 0) wsf[C.r32] = f;
#pragma unroll
                for (int r = 0; r < 16; ++r) { const float ff = wsf[(r & 3) + 8 * (r >> 2) + 4 * C.hi]; o[0][r] *= ff; o[1][r] *= ff; }
            }
            float rsum = 0.f;
#pragma unroll
            for (int r = 0; r < 16; ++r) { p0[r] = fexp2(p0[r]); p1[r] = fexp2(p1[r]); rsum += p0[r] + p1[r]; }
            l += keeprow ? rsum : 0.f;
            if (MODE == 0) {
                if (tt == 0) m0 = mref;
                if (want_imp) {
                    LAS float* Gs = (LAS float*)(lds + AT_G) + (C.g * 64 + C.tokl) * 33; LAS float* Ls = (LAS float*)(lds + AT_L) + (C.g * 64 + C.tokl) * 33;
#pragma unroll
                    for (int rg = 0; rg < 4; ++rg) {
                        const int ml = 16 * tt + 2 * rg + C.hi;
                        Gs[ml] = (p0[4 * rg] + p0[4 * rg + 1]) + (p0[4 * rg + 2] + p0[4 * rg + 3]); Ls[ml] = p0[4 * rg + 3];
                        Gs[ml + 8] = (p1[4 * rg] + p1[4 * rg + 1]) + (p1[4 * rg + 2] + p1[4 * rg + 3]); Ls[ml + 8] = p1[4 * rg + 3];
                    }
                }
            }
            bf16x8 pa[4];
#pragma unroll
            for (int c = 0; c < 4; ++c) {
                u32x4 w;
                if (c < 2) { w.x = cvt_pk_bf16(p0[8 * c], p0[8 * c + 1]); w.y = cvt_pk_bf16(p0[8 * c + 2], p0[8 * c + 3]); w.z = cvt_pk_bf16(p0[8 * c + 4], p0[8 * c + 5]); w.w = cvt_pk_bf16(p0[8 * c + 6], p0[8 * c + 7]); }
                else { const int cc = c - 2; w.x = cvt_pk_bf16(p1[8 * cc], p1[8 * cc + 1]); w.y = cvt_pk_bf16(p1[8 * cc + 2], p1[8 * cc + 3]); w.z = cvt_pk_bf16(p1[8 * cc + 4], p1[8 * cc + 5]); w.w = cvt_pk_bf16(p1[8 * cc + 6], p1[8 * cc + 7]); }
                if (MODE == 1) { const unsigned km = keeprow ? 0xffffffffu : 0u; w.x &= km; w.y &= km; w.z &= km; w.w &= km; }
                pa[c] = __builtin_bit_cast(bf16x8, w);
            }
            __builtin_amdgcn_sched_barrier(0);
#pragma unroll
            for (int c = 2; c < 4; ++c) {
                const int koff = (32 * (c >> 1) + 16 * (c & 1)) * (VTP * 2);
#pragma unroll
                for (int db = 0; db < 2; ++db) {
                    const v4i16_t lo = __builtin_amdgcn_ds_read_tr16_b64_v4i16((LAS v4i16_t*)(vb + koff + 64 * db));
                    const v4i16_t hi4 = __builtin_amdgcn_ds_read_tr16_b64_v4i16((LAS v4i16_t*)(vb + koff + 8 * (VTP * 2) + 64 * db));
                    vf[2 * c + db] = (bf16x8){lo[0], lo[1], lo[2], lo[3], hi4[0], hi4[1], hi4[2], hi4[3]};
                }
            }
            __builtin_amdgcn_sched_barrier(0);
#pragma unroll
            for (int c = 0; c < 4; ++c) {
#pragma unroll
                for (int db = 0; db < 2; ++db) o[db] = __builtin_amdgcn_mfma_f32_32x32x16_bf16(pa[c], vf[2 * c + db], o[db], 0, 0, 0);
            }
        }
        if (tt + 1 < ntiles) at_store(lds, buf ^ 1, C.tid, kr, vr);
        __syncthreads();
    }
    const float lt = l + __shfl_xor(l, 32);
    const float inv = lt > 0.f ? frcp(lt) : 0.f;
    if (MODE == 0 && want_imp && C.hi == 0) {
        LAS float* fs = (LAS float*)(lds + AT_FS) + (C.g * 64 + C.tokl) * 2;
        fs[0] = (ntiles > 1) ? fexp2(m0 - mref) * inv : inv; fs[1] = inv;
    }
    if (C.hi == 0) wsf[C.r32] = inv * gatev;
#pragma unroll
    for (int r = 0; r < 16; ++r) { const float f = wsf[(r & 3) + 8 * (r >> 2) + 4 * C.hi]; of[0][r] += o[0][r] * f; of[1][r] += o[1][r] * f; }
}
__device__ __forceinline__ void attn_unit(const Frame& F, int b, int kvh, int i) {
    AttnCtx C; C.lds = F.lds; C.tid = F.tid; C.lane = F.lane; C.wave = F.wave; C.r32 = F.lane & 31; C.hi = F.lane >> 5; C.g = F.wave >> 1; C.th = F.wave & 1; C.tokl = 32 * C.th + C.r32;
    const int h = 4 * kvh + C.g, t = 64 * i + C.tokl, row = b * T + t;
    const bf16_t* Qp = WSP(bf16_t, WS_Q) + ((size_t)(b * 16 + h) * 2048 + t) * 64;
#pragma unroll
    for (int d0 = 0; d0 < 4; ++d0) C.qf[d0] = *(const bf16x8*)(Qp + 16 * d0 + 8 * C.hi);
    const float* gp = WSP(float, WS_GATE) + (size_t)row * 48 + h * 3;
    const float g0 = gp[0], g1 = gp[1], g2 = gp[2];
    const size_t kvoff = (size_t)(b * 4 + kvh) * 2048 * 64;
    f32x16 of[2]; of[0] = (f32x16)(0.f); of[1] = (f32x16)(0.f);
    const bool want_imp = i >= 16;
    u32x4 kr, vr;
    at_load(WSP(bf16_t, WS_KCMP) + (size_t)(b * 4 + kvh) * 128 * 64, WSP(bf16_t, WS_VCMP) + (size_t)(b * 4 + kvh) * 128 * 64, 0, C.tid, kr, vr);
    __syncthreads();
    LAS unsigned* msk = (LAS unsigned*)(F.lds + AT_MSK);
    unsigned rowmask = 0u;
#pragma unroll 1
    for (int ps = 0; ps < 3; ++ps) {
        const bf16_t* Kb; const bf16_t* Vb; int j0, ntl; float gv;
        if (ps == 0) { Kb = WSP(bf16_t, WS_KCMP) + (size_t)(b * 4 + kvh) * 128 * 64; Vb = WSP(bf16_t, WS_VCMP) + (size_t)(b * 4 + kvh) * 128 * 64; j0 = 0; ntl = want_imp ? 2 : 1; gv = g0; }
        else if (ps == 1) { Kb = WSP(bf16_t, WS_KV + 2 * KV_STRIDE) + kvoff; Vb = WSP(bf16_t, WS_KV + 3 * KV_STRIDE) + kvoff; j0 = 0; ntl = i + 1; gv = g1; }
        else { Kb = WSP(bf16_t, WS_KV + 4 * KV_STRIDE) + kvoff; Vb = WSP(bf16_t, WS_KV + 5 * KV_STRIDE) + kvoff; j0 = i >= 8 ? i - 8 : 0; ntl = i - j0 + 1; gv = g2; }
        const bf16_t* Kn = nullptr; const bf16_t* Vn = nullptr; int jn = 0;
        if (ps == 0) { Kn = WSP(bf16_t, WS_KV + 2 * KV_STRIDE) + kvoff; Vn = WSP(bf16_t, WS_KV + 3 * KV_STRIDE) + kvoff; jn = 0; }
        else if (ps == 1) { Kn = WSP(bf16_t, WS_KV + 4 * KV_STRIDE) + kvoff; Vn = WSP(bf16_t, WS_KV + 5 * KV_STRIDE) + kvoff; jn = i >= 8 ? i - 8 : 0; }
        attn_pass(ps, C, Kb, Vb, i, j0, ntl, rowmask, want_imp, gv, of, kr, vr, Kn, Vn, jn);
        if (ps == 0) {
            if (want_imp) {
                __syncthreads();
                LAS float* Gs = (LAS float*)(F.lds + AT_G); LAS float* Ls = (LAS float*)(F.lds + AT_L); LAS float* fs = (LAS float*)(F.lds + AT_FS); LAS float* imp = (LAS float*)(F.lds + AT_IMP);
#pragma unroll 1
                for (int q = 0; q < 4; ++q) {
                    const int idx = F.tid + 512 * q, tok = idx >> 5, j = idx & 31; float v = 0.f;
#pragma unroll
                    for (int g = 0; g < 4; ++g) {
                        const int base = (g * 64 + tok);
                        v += fs[base * 2 + (j >> 4)] * Gs[base * 33 + j];
                        if (j > 0) v += fs[base * 2 + ((j - 1) >> 4)] * Ls[base * 33 + j - 1];
                    }
                    imp[tok * 33 + j] = v;
                }
                __syncthreads();
                {
                    const int tok = F.tid >> 3, sub = F.tid & 7;
                    const LAS float* im = imp + tok * 33;
                    float cv[4]; int cj[4];
#pragma unroll
                    for (int q = 0; q < 4; ++q) { cj[q] = 1 + sub + 8 * q; cv[q] = (cj[q] <= i - 2) ? im[cj[q]] : -2.f; }
                    unsigned mk = 1u | (1u << i) | (1u << (i - 1));
                    for (int rnd = 0; rnd < 13; ++rnd) {
                        float best = -1.f; int bj = 99;
#pragma unroll
                        for (int q = 0; q < 4; ++q) if (cv[q] > best) { best = cv[q]; bj = cj[q]; }
#pragma unroll
                        for (int o = 1; o < 8; o <<= 1) { const float ov = __shfl_xor(best, o); const int oj = __shfl_xor(bj, o); if (ov > best || (ov == best && oj < bj)) { best = ov; bj = oj; } }
                        mk |= 1u << bj;
#pragma unroll
                        for (int q = 0; q < 4; ++q) if (cj[q] == bj) cv[q] = -2.f;
                    }
                    if (sub == 0) msk[tok] = mk;
                }
            } else {
                if (F.tid < 64) msk[F.tid] = (2u << i) - 1u;
            }
            __syncthreads();
            rowmask = msk[C.tokl];
        }
    }
    bf16_t* O = WSP(bf16_t, WS_OCAT); LAS float* ssq = (LAS float*)(F.lds + AT_SSQ);
    LAS bf16_t* stg = (LAS bf16_t*)(F.lds + AT_G) + C.wave * 2048;
#pragma unroll
    for (int r = 0; r < 16; ++r) {
        const int rl = (r & 3) + 8 * (r >> 2) + 4 * C.hi;
        stg[rl * 64 + C.r32] = (bf16_t)(cvt_pk_bf16(of[0][r], 0.f) & 0xffffu); stg[rl * 64 + 32 + C.r32] = (bf16_t)(cvt_pk_bf16(of[1][r], 0.f) & 0xffffu);
        float ss = of[0][r] * of[0][r] + of[1][r] * of[1][r];
        ss += __shfl_xor(ss, 1); ss += __shfl_xor(ss, 2); ss += __shfl_xor(ss, 4); ss += __shfl_xor(ss, 8); ss += __shfl_xor(ss, 16);
        if (C.r32 == 0) ssq[C.g * 64 + 32 * C.th + rl] = ss;
    }
    {
        bf16_t* ob = O + (size_t)(b * T + 64 * i + 32 * C.th + (C.lane >> 3)) * 2048 + h * 64 + (C.lane & 7) * 8;
#pragma unroll
        for (int q = 0; q < 4; ++q) { const u32x4 v = *(const LAS u32x4*)(stg + (q * 8 + (C.lane >> 3)) * 64 + (C.lane & 7) * 8); *(u32x4*)(ob + (size_t)q * 8 * 2048) = v; }
    }
    __syncthreads();
    if (F.tid < 64) WSP(float, WS_OSSN)[(size_t)(b * T + 64 * i + F.tid) * 4 + kvh] = (ssq[F.tid] + ssq[64 + F.tid]) + (ssq[128 + F.tid] + ssq[192 + F.tid]);
}

__device__ __forceinline__ void split_bf16(const float (&v)[8], bf16x8& hi, bf16x8& lo) {
    u32x4 h, l;
    unsigned* hp = (unsigned*)&h; unsigned* lp = (unsigned*)&l;
#pragma unroll
    for (int e = 0; e < 4; ++e) {
        const unsigned pk = cvt_pk_bf16(v[2 * e], v[2 * e + 1]); hp[e] = pk;
        lp[e] = cvt_pk_bf16(v[2 * e] - bflo(pk), v[2 * e + 1] - bfhi(pk));
    }
    hi = __builtin_bit_cast(bf16x8, h); lo = __builtin_bit_cast(bf16x8, l);
}
__device__ __forceinline__ void router_unit(const Frame& F, int un) {
    LAS float* rstd_s = (LAS float*)F.lds;
    LAS float* part = (LAS float*)(F.lds + 1024);
    LAS float* sc_s = (LAS float*)(F.lds + 1024 + 65536);
    LAS float* sb_s = sc_s + 32 * 65;
    LAS int* lcnt = (LAS int*)(sb_s + 32 * 65);
    LAS int* lbase = lcnt + 64;
    const int row0 = un * 32, b = row0 >> 11;
    const float* x1 = F.out; const float* mod = WSP(float, WS_MOD) + b * 6 * D;
    __syncthreads();
    if (F.tid < 64) lcnt[F.tid] = 0;
    {
        f32x4 xv[4][8];
#pragma unroll
        for (int q = 0; q < 4; ++q) { const f32x4* xr = (const f32x4*)(x1 + (size_t)(row0 + F.wave * 4 + q) * D) + F.lane;
#pragma unroll
            for (int j = 0; j < 8; ++j) xv[q][j] = xr[64 * j]; }
#pragma unroll
        for (int q = 0; q < 4; ++q) { float s = 0.f;
#pragma unroll
            for (int j = 0; j < 8; ++j) { const f32x4 v = xv[q][j]; s += (v.x * v.x + v.y * v.y) + (v.z * v.z + v.w * v.w); }
            s = wave_sum(s); if (F.lane == 0) rstd_s[F.wave * 4 + q] = rsqrtf(s * (1.f / D) + EPS); }
    }
    __syncthreads();
    const int r32 = F.lane & 31, hi = F.lane >> 5;
    const float rs = rstd_s[r32];
    f32x16 acc[2]; acc[0] = (f32x16)(0.f); acc[1] = (f32x16)(0.f);
    const float* wr_ = F.in[I_WR];
#pragma unroll 4
    for (int kc = 0; kc < 16; ++kc) {
        const int kk = F.wave * 256 + kc * 16 + 8 * hi;
        float hv[8];
        {
            const f32x4 xa = *(const f32x4*)(x1 + (size_t)(row0 + r32) * D + kk), xb = *(const f32x4*)(x1 + (size_t)(row0 + r32) * D + kk + 4);
            const f32x4 ga = *(const f32x4*)(F.in[I_GN2] + kk), gb = *(const f32x4*)(F.in[I_GN2] + kk + 4);
            const f32x4 sa = *(const f32x4*)(mod + 4 * D + kk), sb2 = *(const f32x4*)(mod + 4 * D + kk + 4);
            const f32x4 ha = *(const f32x4*)(mod + 3 * D + kk), hb = *(const f32x4*)(mod + 3 * D + kk + 4);
            const f32x4 ra = xa * rs * ga * (sa + 1.0f) + ha, rb = xb * rs * gb * (sb2 + 1.0f) + hb;
            hv[0] = ra.x; hv[1] = ra.y; hv[2] = ra.z; hv[3] = ra.w; hv[4] = rb.x; hv[5] = rb.y; hv[6] = rb.z; hv[7] = rb.w;
        }
        bf16x8 ah, al; split_bf16(hv, ah, al);
        { u32x2 h8; h8.x = pk4_fp8(hv[0], hv[1], hv[2], hv[3]); h8.y = pk4_fp8(hv[4], hv[5], hv[6], hv[7]); *(u32x2*)(WSP(unsigned char, WS_H) + (size_t)(row0 + r32) * D + kk) = h8; }
#pragma unroll
        for (int nb = 0; nb < 2; ++nb) {
            float wv[8];
#pragma unroll
            for (int j = 0; j < 8; ++j) wv[j] = wr_[(size_t)(kk + j) * 64 + 32 * nb + r32];
            bf16x8 bh, bl; split_bf16(wv, bh, bl);
            acc[nb] = __builtin_amdgcn_mfma_f32_32x32x16_bf16(ah, bh, acc[nb], 0, 0, 0);
            acc[nb] = __builtin_amdgcn_mfma_f32_32x32x16_bf16(ah, bl, acc[nb], 0, 0, 0);
            acc[nb] = __builtin_amdgcn_mfma_f32_32x32x16_bf16(al, bh, acc[nb], 0, 0, 0);
        }
    }
#pragma unroll
    for (int nb = 0; nb < 2; ++nb)
#pragma unroll
        for (int r = 0; r < 16; ++r) part[(F.wave * 32 + (r & 3) + 8 * (r >> 2) + 4 * hi) * 64 + 32 * nb + r32] = acc[nb][r];
    __syncthreads();
    int eid[8]; int lp[8]; float wk[8];
    const int tok = F.tid >> 4, sub = F.tid & 15;
    {
        const int e4 = sub * 4; f32x4 sacc = (f32x4){0.f, 0.f, 0.f, 0.f};
#pragma unroll
        for (int w = 0; w < 8; ++w) sacc += *(const LAS f32x4*)(part + (w * 32 + tok) * 64 + e4);
        const f32x4 rb = *(const f32x4*)(F.in[I_RB] + e4);
        float s4[4], sb4[4];
#pragma unroll
        for (int v = 0; v < 4; ++v) { s4[v] = 1.0f / (1.0f + expf(-sacc[v])); sb4[v] = s4[v] + rb[v]; }
        float a1 = -3.0e38f, a2 = -3.0e38f;
#pragma unroll
        for (int v = 0; v < 4; ++v) { if (sb4[v] > a1) { a2 = a1; a1 = sb4[v]; } else if (sb4[v] > a2) a2 = sb4[v]; }
        const float b1 = __shfl_xor(a1, 1), b2 = __shfl_xor(a2, 1);
        const float gs = fmaxf(a1, b1) + fmaxf(fminf(a1, b1), fmaxf(a2, b2));
        int rank = 0; const int g = sub >> 1;
#pragma unroll
        for (int gg = 0; gg < 8; ++gg) { const float v = __shfl(gs, (F.lane & ~15) | (2 * gg)); rank += (v > gs || (v == gs && gg < g)) ? 1 : 0; }
        const bool gsel = rank < 4;
        float cv[4];
#pragma unroll
        for (int v = 0; v < 4; ++v) cv[v] = gsel ? sb4[v] : -3.0e38f;
        float wsum = 0.f;
#pragma unroll 1
        for (int k = 0; k < 8; ++k) {
            float best = -3.9e38f; int be = 99; float bs = 0.f;
#pragma unroll
            for (int v = 0; v < 4; ++v) if (cv[v] > best) { best = cv[v]; be = e4 + v; bs = s4[v]; }
#pragma unroll
            for (int o = 1; o < 16; o <<= 1) { const float ov = __shfl_xor(best, o); const int oe = __shfl_xor(be, o); const float os = __shfl_xor(bs, o);
                if (ov > best || (ov == best && oe < be)) { best = ov; be = oe; bs = os; } }
#pragma unroll
            for (int v = 0; v < 4; ++v) if (e4 + v == be) cv[v] = -3.9e38f;
#pragma unroll
            for (int kk = 0; kk < 8; ++kk) if (kk == k) { eid[kk] = be; wk[kk] = bs; }
            wsum += bs;
        }
        const float sc = 2.5f / wsum;
        if (sub == 0) {
#pragma unroll
            for (int k = 0; k < 8; ++k) { wk[k] *= sc; lp[k] = atomicAdd((int*)(lcnt + eid[k]), 1); }
        }
    }
    __syncthreads();
    if (F.tid < 64) { const int c = lcnt[F.tid]; lbase[F.tid] = c ? (int)atomicAdd((unsigned*)(F.ws + WS_CTL) + CW_CNT + F.tid, (unsigned)c) : 0; }
    __syncthreads();
    if (sub == 0) {
        const int row = row0 + tok;
#pragma unroll
        for (int k = 0; k < 8; ++k) { const int pos = lbase[eid[k]] + lp[k];
            WSP(int, WS_EIDX)[row * 8 + k] = eid[k]; WSP(int, WS_POS)[row * 8 + k] = pos; WSP(float, WS_WTS)[row * 8 + k] = wk[k];
            WSP(int, WS_LIST)[eid[k] * 8192 + pos] = row; }
    }
}

__device__ __forceinline__ void phase8(const Frame& F, const LAS int* tb) {
    const int gw = F.vcu * 8 + F.wave, NGW = F.G * 8;
    const unsigned char* PO = WSP(unsigned char, WS_PO);
    for (int row = gw; row < NTOK; row += NGW) {
        const int b = row >> 11;
        size_t pr[9]; float w[9];
#pragma unroll
        for (int k = 0; k < 8; ++k) { const int e = WSP(int, WS_EIDX)[row * 8 + k], pos = WSP(int, WS_POS)[row * 8 + k]; w[k] = WSP(float, WS_WTS)[row * 8 + k] * (1.0f / PO8SCALE); pr[k] = ((size_t)tb[e] * 256 + pos) * 2048; }
        pr[8] = ((size_t)tb[64] * 256 + row) * 2048; w[8] = 1.0f / PO8SCALE;
        const float* gt2 = WSP(float, WS_MOD) + b * 6 * D + 5 * D;
#pragma unroll
        for (int j = 0; j < 2; ++j) {
            const int col = 16 * F.lane + 1024 * j; float a[16];
#pragma unroll
            for (int e = 0; e < 16; ++e) a[e] = 0.f;
#pragma unroll
            for (int k = 0; k < 9; ++k) {
                const u32x4 v = *(const u32x4*)(PO + pr[k] + col);
                const unsigned vv[4] = {v.x, v.y, v.z, v.w};
#pragma unroll
                for (int q = 0; q < 4; ++q) {
                    const f32x2 lo = __builtin_amdgcn_cvt_pk_f32_fp8((int)vv[q], false), hi = __builtin_amdgcn_cvt_pk_f32_fp8((int)vv[q], true);
                    a[4 * q] += w[k] * lo.x; a[4 * q + 1] += w[k] * lo.y; a[4 * q + 2] += w[k] * hi.x; a[4 * q + 3] += w[k] * hi.y;
                }
            }
            float* op = F.out + (size_t)row * D + col;
#pragma unroll
            for (int q = 0; q < 4; ++q) {
                const f32x4 x0 = *(const f32x4*)(op + 4 * q), g0 = *(const f32x4*)(gt2 + col + 4 * q);
                *(f32x4*)(op + 4 * q) = x0 + g0 * (f32x4){a[4 * q], a[4 * q + 1], a[4 * q + 2], a[4 * q + 3]};
            }
        }
    }
}

constexpr int N_PHASES = 11;
__global__ void __launch_bounds__(512, 2) mk_fwd(Params p) {
    extern __shared__ __attribute__((aligned(16))) unsigned char lds_raw[];
    Frame F;
    F.lds = (LAS unsigned char*)lds_raw; F.ws = p.ws; F.in = p.in; F.out = p.out;
    F.tid = threadIdx.x; F.lane = F.tid & 63; F.wave = __builtin_amdgcn_readfirstlane(F.tid >> 6);
    F.G = gridDim.x; { const int bx = blockIdx.x; F.vcu = (F.G % 8 == 0) ? (bx % 8) * (F.G / 8) + bx / 8 : bx; }
    volatile LAS unsigned* MISC = (volatile LAS unsigned*)(F.lds + MISC_OFF);
    if (F.tid < 64) MISC[F.tid] = 0u;
    __syncthreads();
    const int lo = p.ph_lo, hi = p.ph_hi;
    const bool multi = (hi - lo) > 1;
    XcdBarrier bar; bar.bar = (unsigned*)(p.ws + WS_CTL) + CW_BAR; bar.x = 0; bar.st = nullptr;
    if (multi) bar = xcd_barrier_post((unsigned*)(p.ws + WS_CTL) + CW_BAR, MISC + 8);
#ifndef PH_MASK
#define PH_MASK 0xffff
#endif
#define IN(k) (((PH_MASK >> (k)) & 1) && lo <= (k) && (k) < hi)
#define SEAM(k) do { if (IN(k) && IN((k) + 1)) xcd_barrier(bar); } while (0)
#define REP(k) for (int rep_ = 0; rep_ < ((((PROBE_MASK) >> (k)) & 1) ? 2 : 1); ++rep_)
    LAS int* mtab = (LAS int*)(F.lds + LDSX_OFF + 4096);

    if (IN(0)) REP(0) { phase0a(F); SEAM(0); }
    if (IN(1)) REP(1) { phase0b(F); SEAM(1); }
    if (IN(2)) REP(2) {
        const bool split = (F.G == 256);
        if (!split || (int)blockIdx.x < NG_INPROJ) {
            InProjP P; P.A = WSP(bf16_t, WS_H); P.Bt = WSP(bf16_t, WS_WIN_T); P.lda = D; P.G = split ? NG_INPROJ : F.G; P.c = blockIdx.x; P.ws = p.ws; P.gq = p.in[I_GQ]; P.gk = p.in[I_GK];
            pg8::gemm_phase(F.lds, P);
        } else conv_range3(F, CV_EARLY, CV_NT4 - CV_DEFER2, ((int)blockIdx.x - NG_INPROJ) * 8 + F.wave, (256 - NG_INPROJ) * 8);
        SEAM(2);
    }
    if (IN(3) && DUP(3)) {
        {
            CmpP P; P.A = WSP(bf16_t, WS_KV); P.Bt = WSP(bf16_t, WS_WCMP_T); P.lda = 1024; P.G = F.G; P.c = F.vcu; P.ws = p.ws;
            pg8::gemm_phase(F.lds, P);
        }
        if (F.G >= 128) {
            if (F.vcu < 64) gmlp_unit(F, F.vcu);
            else { for (int n = 64 + (F.vcu - 64); n < 512; n += F.G - 64) gmlp_unit(F, n);
                   __syncthreads(); conv_range(F, CV_NT4 - CV_DEFER - CV_DEFER2, CV_NT4 - CV_DEFER, (F.vcu - 64) * 8 + F.wave, (F.G - 64) * 8); }
        } else { for (int n = F.vcu; n < 512; n += F.G) gmlp_unit(F, n); __syncthreads(); conv_range(F, CV_NT4 - CV_DEFER - CV_DEFER2, CV_NT4 - CV_DEFER, F.vcu * 8 + F.wave, F.G * 8); }
        SEAM(3);
    }
    if (IN(3)) {
        {
            CmpP P; P.A = WSP(bf16_t, WS_KV); P.Bt = WSP(bf16_t, WS_WCMP_T); P.lda = 1024; P.G = F.G; P.c = F.vcu; P.ws = p.ws;
            pg8::gemm_phase(F.lds, P);
        }
        if (F.G >= 128) {
            if (F.vcu < 64) gmlp_unit(F, F.vcu);
            else { for (int n = 64 + (F.vcu - 64); n < 512; n += F.G - 64) gmlp_unit(F, n);
                   __syncthreads(); conv_range(F, CV_NT4 - CV_DEFER - CV_DEFER2, CV_NT4 - CV_DEFER, (F.vcu - 64) * 8 + F.wave, (F.G - 64) * 8); }
        } else { for (int n = F.vcu; n < 512; n += F.G) gmlp_unit(F, n); __syncthreads(); conv_range(F, CV_NT4 - CV_DEFER - CV_DEFER2, CV_NT4 - CV_DEFER, F.vcu * 8 + F.wave, F.G * 8); }
        SEAM(3);
    }
    if (IN(4)) REP(4) { phase2b(F); SEAM(4); }
    if (IN(5)) REP(5) {
        for (int n = F.vcu; n < 512; n += F.G) {
            int combo, i; if (n < 256) { combo = n >> 4; i = 31 - (n & 15); } else { combo = (n - 256) >> 4; i = n & 15; }
            attn_unit(F, combo >> 2, combo & 3, i);
        }
        SEAM(5);
    }
    if (IN(6) && DUP(6)) {
        OutProjP P; P.A = WSP(bf16_t, WS_OCAT); P.Bt = WSP(bf16_t, WS_WOUT_T); P.lda = D; P.G = F.G; P.c = blockIdx.x; P.ws = p.ws; P.x = p.in[I_X]; P.out = p.out; P.tab = (LAS f32x2*)(F.lds + LDSX_OFF);
        pg8::gemm_phase(F.lds, P); SEAM(6);
    }
    if (IN(6)) {
        OutProjP P; P.A = WSP(bf16_t, WS_OCAT); P.Bt = WSP(bf16_t, WS_WOUT_T); P.lda = D; P.G = F.G; P.c = blockIdx.x; P.ws = p.ws; P.x = p.in[I_X]; P.out = p.out; P.tab = (LAS f32x2*)(F.lds + LDSX_OFF);
        pg8::gemm_phase(F.lds, P); SEAM(6);
    }
    if (IN(7)) { for (int un = F.vcu; un < 256; un += F.G) router_unit(F, un); SEAM(7); }
    if (IN(8)) REP(8) {
        moe_table(F, mtab);
        { MoeUpP<false> P; P.A = WSP(unsigned char, WS_H); P.Bt = WSP(unsigned char, WS_WGU_T); P.lda = D; P.G = F.G; P.c = F.vcu; P.ws = p.ws; P.tb = mtab; P.c0 = 0; P.idtab = (LAS unsigned*)(F.lds + LDSX_OFF + 10240);
          pg8::gemm_phase(F.lds, P); }
        { MoeUpP<true> P; P.A = WSP(unsigned char, WS_H); P.Bt = WSP(unsigned char, WS_WGU_T); P.lda = D; P.G = F.G; P.c = F.vcu; P.ws = p.ws; P.tb = mtab; P.c0 = (mtab[66] * 4) % F.G; P.idtab = (LAS unsigned*)(F.lds + LDSX_OFF + 10240);
          pg8::gemm_phase(F.lds, P); }
        SEAM(8);
    }
    if (IN(9) && DUP(9)) {
        moe_table(F, mtab);
        { MoeDownP<false> P; P.A = WSP(unsigned char, WS_HID); P.Bt = WSP(unsigned char, WS_WD_T); P.lda = EDIM; P.G = F.G; P.c = F.vcu; P.ws = p.ws; P.tb = mtab; P.c0 = 0;
          pg8::gemm_phase(F.lds, P); }
        { MoeDownP<true> P; P.A = WSP(unsigned char, WS_HID); P.Bt = WSP(unsigned char, WS_WD_T); P.lda = EDIM; P.G = F.G; P.c = F.vcu; P.ws = p.ws; P.tb = mtab; P.c0 = (mtab[66] * 8) % F.G;
          pg8::gemm_phase(F.lds, P); } SEAM(9);
    }
    if (IN(9)) {
        moe_table(F, mtab);
        { MoeDownP<false> P; P.A = WSP(unsigned char, WS_HID); P.Bt = WSP(unsigned char, WS_WD_T); P.lda = EDIM; P.G = F.G; P.c = F.vcu; P.ws = p.ws; P.tb = mtab; P.c0 = 0;
          pg8::gemm_phase(F.lds, P); }
        { MoeDownP<true> P; P.A = WSP(unsigned char, WS_HID); P.Bt = WSP(unsigned char, WS_WD_T); P.lda = EDIM; P.G = F.G; P.c = F.vcu; P.ws = p.ws; P.tb = mtab; P.c0 = (mtab[66] * 8) % F.G;
          pg8::gemm_phase(F.lds, P); } SEAM(9);
    }
    if (IN(10)) { moe_table(F, mtab); phase8(F, mtab); }
#undef IN
#undef SEAM
}

extern "C" void kernel_launch(void* const* d_in, const int* in_sizes, int n_in, void* d_out, int out_size, void* d_ws, size_t ws_size, hipStream_t stream) {
    static int grid = 0;
    if (grid == 0) {
        if (n_in != 29 || out_size != NTOK * D || ws_size < WS_END) { fprintf(stderr, "kernel_launch: unexpected shapes (n_in %d out %d ws %zu)\n", n_in, out_size, ws_size); grid = -1; return; }
        int dev = 0, cus = 0, per_cu = 0;
        hipGetDevice(&dev); hipDeviceGetAttribute(&cus, hipDeviceAttributeMultiprocessorCount, dev);
        if (hipFuncSetAttribute((const void*)mk_fwd, hipFuncAttributeMaxDynamicSharedMemorySize, LDS_BYTES) != hipSuccess) { fprintf(stderr, "kernel_launch: hipFuncSetAttribute failed\n"); grid = -1; return; }
        if (hipOccupancyMaxActiveBlocksPerMultiprocessor(&per_cu, (const void*)mk_fwd, 512, LDS_BYTES) != hipSuccess || per_cu < 1) { fprintf(stderr, "kernel_launch: occupancy query says %d\n", per_cu); per_cu = 1; }
        (void)hipGetLastError();
        grid = cus;
    }
    if (grid < 0) return;
    hipMemsetAsync((char*)d_ws + WS_CTL, 0, CTL_BYTES, stream);
    Params p{};
    for (int i = 0; i < 29; ++i) p.in[i] = (const float*)d_in[i];
    p.out = (float*)d_out; p.ws = (unsigned char*)d_ws;
#if MK_N_LAUNCHES == 1
    p.ph_lo = 0; p.ph_hi = N_PHASES;
    void* args[] = {&p};
    hipError_t e = hipLaunchCooperativeKernel((const void*)mk_fwd, dim3(grid), dim3(512), args, LDS_BYTES, stream);
    if (e != hipSuccess) fprintf(stderr, "kernel_launch: cooperative launch failed: %s (grid %d)\n", hipGetErrorString(e), grid);
#else
    for (int ph = 0; ph < N_PHASES; ++ph) { p.ph_lo = ph; p.ph_hi = ph + 1; hipLaunchKernelGGL(mk_fwd, dim3(grid), dim3(512), LDS_BYTES, stream, p); }
#endif
}
```
